# Optimizing an MI355X kernel written in HIP

```python
import jax, jax.numpy as jnp
from jax import lax
import numpy as np

D_MODEL = 4096
BATCH = 2
SEQ = 4096
DEPTH = 2
DEC_BATCH = 8
DEC_SEQ = 32
PAST_LEN = 4096

CHUNK = 64
N_A_LAYERS = DEPTH // 2
N_B_LAYERS = DEPTH - N_A_LAYERS
SGU_CHUNK = 128
SGU_GROUPS = 8
SGU_WIDTH = D_MODEL
SGU_GROUP_WIDTH = SGU_WIDTH // SGU_GROUPS
HEAD_DIM = 64
N_HEADS = D_MODEL // HEAD_DIM
N_KV_HEADS = 8
GQA = N_HEADS // N_KV_HEADS
WINDOW = 128
WINDOW_CHUNKS = WINDOW // CHUNK
D_FF = ((8 * D_MODEL // 3 + 255) // 256) * 256
NEG = -1e30

kernel_name = "yoco_gmlp_swa_sink_stream_step"


def rmsnorm(x, g, eps=1e-6):
    xf = x.astype(jnp.float32)
    y = xf * lax.rsqrt(jnp.mean(xf * xf, axis=-1, keepdims=True) + eps)
    return (y * g.astype(jnp.float32)).astype(x.dtype)


def layernorm(x, g, b, eps=1e-5):
    xf = x.astype(jnp.float32)
    mu = jnp.mean(xf, axis=-1, keepdims=True)
    xc = xf - mu
    y = xc * lax.rsqrt(jnp.mean(xc * xc, axis=-1, keepdims=True) + eps)
    return (y * g.astype(jnp.float32) + b.astype(jnp.float32)).astype(x.dtype)


def swiglu(x, w_gate, w_up, w_down):
    return (jax.nn.silu(x @ w_gate) * (x @ w_up)) @ w_down


def chunk_causal_mask(n):
    idx = jnp.arange(n) // CHUNK
    return idx[:, None] >= idx[None, :]


def sgu_mixer(x, w_in, ln_g, ln_b, w_s, b_s, w_out, prompt):
    B, S, _ = x.shape
    u, v = jnp.split(jax.nn.gelu(x @ w_in, approximate=False), 2, axis=-1)
    v = layernorm(v, ln_g, ln_b)
    ws = jnp.where(chunk_causal_mask(SGU_CHUNK)[None], w_s, 0.0)
    if prompt:
        vb = v.reshape(B, S // SGU_CHUNK, SGU_CHUNK, SGU_GROUPS, SGU_GROUP_WIDTH)
        mixed = jnp.einsum('gij,bnjgc->bnigc', ws, vb) + b_s.T[:, :, None]
    else:
        vb = v.reshape(B, S, SGU_GROUPS, SGU_GROUP_WIDTH)
        mixed = jnp.einsum('gij,bjgc->bigc', ws[:, :S, :S], vb) + b_s[:, :S].T[:, :, None]
    mixed = mixed.reshape(B, S, SGU_WIDTH)
    return (u * mixed) @ w_out, v


def shared_kv(h, norm_kv, w_kv, k_norm):
    B, S, _ = h.shape
    kv = rmsnorm(h, norm_kv) @ w_kv
    k, v = jnp.split(kv, 2, axis=-1)
    k = rmsnorm(k.reshape(B, S, N_KV_HEADS, HEAD_DIM), k_norm)
    v = v.reshape(B, S, N_KV_HEADS, HEAD_DIM)
    return k, v


def sink_softmax(s, sinks):
    col = jnp.broadcast_to(sinks.astype(jnp.float32).reshape(N_KV_HEADS, GQA, 1, 1),
                           s.shape[:-1] + (1,))
    return jax.nn.softmax(jnp.concatenate([s, col], axis=-1), axis=-1)[..., :-1]


def project_q(hn, w_q, q_norm):
    B, S, _ = hn.shape
    q = (hn @ w_q).reshape(B, S, N_KV_HEADS, GQA, HEAD_DIM)
    return rmsnorm(q, q_norm)


def swa_prompt(hn, w_q, q_norm, sinks, w_o, k, v):
    B, S, _ = hn.shape
    nc = S // CHUNK
    nkb = (WINDOW_CHUNKS + 1) * CHUNK
    q = project_q(hn, w_q, q_norm).reshape(B, nc, CHUNK, N_KV_HEADS, GQA, HEAD_DIM)
    pad = ((0, 0), (WINDOW_CHUNKS * CHUNK, 0), (0, 0), (0, 0))
    kp = jnp.pad(k, pad).reshape(B, nc + WINDOW_CHUNKS, CHUNK, N_KV_HEADS, HEAD_DIM)
    vp = jnp.pad(v, pad).reshape(B, nc + WINDOW_CHUNKS, CHUNK, N_KV_HEADS, HEAD_DIM)
    kb = jnp.concatenate([kp[:, j:j + nc] for j in range(WINDOW_CHUNKS + 1)], axis=2)
    vb = jnp.concatenate([vp[:, j:j + nc] for j in range(WINDOW_CHUNKS + 1)], axis=2)
    s = jnp.einsum('bcqkgd,bcskd->bckgqs', q, kb,
                   preferred_element_type=jnp.float32) * (HEAD_DIM ** -0.5)
    valid = (jnp.arange(nc)[:, None] + jnp.arange(nkb)[None, :] // CHUNK - WINDOW_CHUNKS) >= 0
    s = jnp.where(valid[None, :, None, None, None, :], s, NEG)
    p = sink_softmax(s, sinks).astype(v.dtype)
    o = jnp.einsum('bckgqs,bcskd->bcqkgd', p, vb).reshape(B, S, N_HEADS * HEAD_DIM)
    return o @ w_o


def swa_sample(hn, w_q, q_norm, sinks, w_o, k_all, v_all):
    B, T, _ = hn.shape
    q = project_q(hn, w_q, q_norm)
    s = jnp.einsum('btkgd,bskd->bkgts', q, k_all,
                   preferred_element_type=jnp.float32) * (HEAD_DIM ** -0.5)
    p = sink_softmax(s, sinks).astype(v_all.dtype)
    o = jnp.einsum('bkgts,bskd->btkgd', p, v_all).reshape(B, T, N_HEADS * HEAD_DIM)
    return o @ w_o


def trunk(x, cache_k, cache_v, norm_a, w_sgu_in, sgu_ln_g, sgu_ln_b, w_sgu_s, b_sgu_s,
          w_sgu_out, norm_kv, w_kv, k_norm, norm_b, w_q, q_norm, sinks, w_o,
          norm_ffn, w_ffn_gate, w_ffn_up, w_ffn_down):
    prompt = cache_k is None
    h = x
    v_rows = []
    k = v = None
    for l in range(DEPTH):
        if l < N_A_LAYERS:
            a = l
            out, vr = sgu_mixer(rmsnorm(h, norm_a[a]), w_sgu_in[a], sgu_ln_g[a], sgu_ln_b[a],
                                w_sgu_s[a], b_sgu_s[a], w_sgu_out[a], prompt)
            h = h + out
            if not prompt:
                v_rows.append(vr)
        else:
            if l == N_A_LAYERS:
                k, v = shared_kv(h, norm_kv, w_kv, k_norm)
            b = l - N_A_LAYERS
            hn = rmsnorm(h, norm_b[b])
            if prompt:
                out = swa_prompt(hn, w_q[b], q_norm[b], sinks[b], w_o[b], k, v)
            else:
                k_all = jnp.concatenate([cache_k, k], axis=1)
                v_all = jnp.concatenate([cache_v, v], axis=1)
                out = swa_sample(hn, w_q[b], q_norm[b], sinks[b], w_o[b], k_all, v_all)
            h = h + out
        h = h + swiglu(rmsnorm(h, norm_ffn[l]), w_ffn_gate[l], w_ffn_up[l], w_ffn_down[l])
    return h, k, v, v_rows


def setup_inputs(seed: int = 0) -> dict:
    key = jax.random.key(seed)
    ks = jax.random.split(key, 32)
    f32 = jnp.float32

    def nrm(k, shape, scale):
        return jax.random.normal(k, shape, f32) * scale

    def gain(k, shape):
        return 1.0 + 0.02 * jax.random.normal(k, shape, f32)

    return {
        "x_prompt": nrm(ks[0], (BATCH, SEQ, D_MODEL), 1.0),
        "x_sample": nrm(ks[1], (DEC_BATCH, DEC_SEQ, D_MODEL), 1.0),
        "cache_k": nrm(ks[2], (DEC_BATCH, WINDOW, N_KV_HEADS, HEAD_DIM), 1.0),
        "cache_v": nrm(ks[3], (DEC_BATCH, WINDOW, N_KV_HEADS, HEAD_DIM), 1.0),
        "norm_a": gain(ks[4], (N_A_LAYERS, D_MODEL)),
        "w_sgu_in": nrm(ks[5], (N_A_LAYERS, D_MODEL, 2 * SGU_WIDTH), D_MODEL ** -0.5),
        "sgu_ln_g": gain(ks[6], (N_A_LAYERS, SGU_WIDTH)),
        "sgu_ln_b": nrm(ks[7], (N_A_LAYERS, SGU_WIDTH), 0.02),
        "w_sgu_s": nrm(ks[8], (N_A_LAYERS, SGU_GROUPS, SGU_CHUNK, SGU_CHUNK), SGU_CHUNK ** -0.5),
        "b_sgu_s": gain(ks[9], (N_A_LAYERS, SGU_GROUPS, SGU_CHUNK)),
        "w_sgu_out": nrm(ks[10], (N_A_LAYERS, SGU_WIDTH, D_MODEL), SGU_WIDTH ** -0.5),
        "norm_kv": gain(ks[11], (D_MODEL,)),
        "w_kv": nrm(ks[12], (D_MODEL, 2 * N_KV_HEADS * HEAD_DIM), D_MODEL ** -0.5),
        "k_norm": gain(ks[13], (HEAD_DIM,)),
        "norm_b": gain(ks[14], (N_B_LAYERS, D_MODEL)),
        "w_q": nrm(ks[15], (N_B_LAYERS, D_MODEL, N_HEADS * HEAD_DIM), D_MODEL ** -0.5),
        "q_norm": gain(ks[16], (N_B_LAYERS, HEAD_DIM)),
        "sinks": nrm(ks[17], (N_B_LAYERS, N_HEADS), 0.5),
        "w_o": nrm(ks[18], (N_B_LAYERS, N_HEADS * HEAD_DIM, D_MODEL), (N_HEADS * HEAD_DIM) ** -0.5),
        "norm_ffn": gain(ks[19], (DEPTH, D_MODEL)),
        "w_ffn_gate": nrm(ks[20], (DEPTH, D_MODEL, D_FF), D_MODEL ** -0.5),
        "w_ffn_up": nrm(ks[21], (DEPTH, D_MODEL, D_FF), D_MODEL ** -0.5),
        "w_ffn_down": nrm(ks[22], (DEPTH, D_FF, D_MODEL), D_FF ** -0.5),
    }


def reference(x_prompt, x_sample, cache_k, cache_v, norm_a, w_sgu_in, sgu_ln_g, sgu_ln_b,
              w_sgu_s, b_sgu_s, w_sgu_out, norm_kv, w_kv, k_norm, norm_b, w_q, q_norm,
              sinks, w_o, norm_ffn, w_ffn_gate, w_ffn_up, w_ffn_down):
    weights = (norm_a, w_sgu_in, sgu_ln_g, sgu_ln_b, w_sgu_s, b_sgu_s, w_sgu_out,
               norm_kv, w_kv, k_norm, norm_b, w_q, q_norm, sinks, w_o,
               norm_ffn, w_ffn_gate, w_ffn_up, w_ffn_down)
    y_prompt, k_p, v_p, _ = trunk(x_prompt, None, None, *weights)
    new_k_prompt = k_p[:, -WINDOW:]
    new_v_prompt = v_p[:, -WINDOW:]
    y_sample, new_k_sample, new_v_sample, v_rows = trunk(x_sample, cache_k, cache_v, *weights)
    new_sgu_v_sample = jnp.stack(v_rows, axis=0)
    return (y_prompt, y_sample, new_k_prompt, new_v_prompt, new_k_sample, new_v_sample,
            new_sgu_v_sample)
```

```cpp
#include <hip/hip_runtime.h>
#include <cstdio>
#include <cstdint>
#define MK_ONE_LAUNCH 1
namespace pg8 {
#define PG8_LAS __attribute__((address_space(3)))
typedef unsigned short bf16_t;
typedef short bf16x8 __attribute__((ext_vector_type(8)));
typedef float f32x4 __attribute__((ext_vector_type(4)));
typedef unsigned u32x4 __attribute__((ext_vector_type(4)));
constexpr int BM = 256, BK = 64, HALF = 128, HTB = HALF * BK * 2  , STAGE_BYTES = 8 * HTB, NXCD = 8, WGM = 8;

__host__ __device__ __forceinline__ int lds_byte(int r, int c) { const int st = (r >> 4) * 2 + (c >> 5), rr = r & 15, cc = c & 31, ob = rr * 64 + cc * 2; return st * 1024 + (ob ^ (((ob >> 9) & 1) << 5)); }
__host__ __device__ __forceinline__ void stage_rc(int b, int& R, int& C) { const int st = b / 1024, sb = b % 1024, swz = sb ^ (((sb >> 9) & 1) << 5); R = (st >> 1) * 16 + swz / 64; C = (st & 1) * 32 + (swz % 64) / 2; }
__host__ __device__ __forceinline__ int perm32(int rho) { const int n = rho >> 4, i = rho & 15; return 8 * (i >> 2) + 4 * n + (i & 3); }

struct Unit { int pm, pn; };
struct Gemm { const bf16_t* A; const bf16_t* Bt; int M, N, K; };

struct StaticOrder {
    int nM, nN, nwg, G, c;
    __host__ __device__ void init(int M, int N, int G_, int c_) { nM = M / BM; nN = N / BM; nwg = nM * nN; G = G_; c = c_; }
    __host__ __device__ bool next(int i, Unit& u) const {
        const long L = (long)i * G + c; if (L >= nwg) return false;
        int wgid = (int)L; { const int q = nwg / NXCD, r = nwg % NXCD, xcd = wgid % NXCD, off = wgid / NXCD; wgid = (xcd < r ? xcd * (q + 1) : r * (q + 1) + (xcd - r) * q) + off; }
        const int nig = WGM * nN, gid = wgid / nig, fm = gid * WGM, gsz = (nM - fm) < WGM ? (nM - fm) : WGM;
        u.pm = fm + ((wgid % nig) % gsz); u.pn = (wgid % nig) / gsz; return true;
    }
    __device__ __forceinline__ void a_ready(const Unit&) const {}
    __device__ __forceinline__ void done(const Unit&) const {}
};

__device__ __forceinline__ unsigned cvt_pk_bf16(float lo, float hi) { unsigned r; asm volatile("v_cvt_pk_bf16_f32 %0, %1, %2" : "=v"(r) : "v"(lo), "v"(hi)); return r; }
typedef float f32x2 __attribute__((ext_vector_type(2)));
__device__ __forceinline__ f32x2 gelu_pk(f32x2 v) {
    const f32x2 av = __builtin_elementwise_abs(v), d = av * 0.2316418882f + 1.0f;
    f32x2 t; t.x = __builtin_amdgcn_rcpf(d.x); t.y = __builtin_amdgcn_rcpf(d.y);
    f32x2 q = t * 0.5307027145f + (-0.7265760135f); q = q * t + 0.7107068705f; q = q * t + (-0.142248368f); q = q * t + 0.127414796f; q = q * t;
    const f32x2 s = (v * v) * (-0.72134752044f);
    f32x2 e; e.x = __builtin_amdgcn_exp2f(s.x); e.y = __builtin_amdgcn_exp2f(s.y);
    const f32x2 m = v * (q * e), r = v - m;
    f32x2 o; o.x = v.x < 0.f ? m.x : r.x; o.y = v.y < 0.f ? m.y : r.y; return o;
}


struct SplitOrder : StaticOrder {
    int nblk; int nhalf;
    __device__ bool next(int i, Unit& u) const {
        if (c >= nblk) return false;
        const long L = (long)i * nblk + c; if (L >= nwg) return false;
        int wgid = (int)L; { const int q = nwg / NXCD, r = nwg % NXCD, xcd = wgid % NXCD, off = wgid / NXCD; wgid = (xcd < r ? xcd * (q + 1) : r * (q + 1) + (xcd - r) * q) + off; }
        const int nig = WGM * nN, gid = wgid / nig, fm = gid * WGM, gsz = (nM - fm) < WGM ? (nM - fm) : WGM;
        u.pm = fm + ((wgid % nig) % gsz); u.pn = (wgid % nig) / gsz; if (nhalf) u.pn = (u.pn & 1) * nhalf + (u.pn >> 1); return true;
    }
};
struct PanelOrder : StaticOrder {
    __device__ bool next(int i, Unit& u) const {
        if (G != 256 || nM != 32 || nN != 16) return StaticOrder::next(i, u);
        if (i >= 2) return false;
        const int x = c & 7, j = c >> 3;
        u.pm = 4 * x + 2 * i + (j & 1); u.pn = j >> 1; return true;
    }
};
struct ExtOrder : StaticOrder {
    int nextra;
    __device__ bool next(int i, Unit& u) const {
        const long L = (long)i * G + c;
        if (L < nwg) return StaticOrder::next(i, u);
        if (L < nwg + nextra) { u.pm = 32; u.pn = (int)(L - nwg); return true; }
        return false;
    }
};
typedef unsigned long long u64;
constexpr float FIX_SCALE = 16777216.0f, FIX_INV = 1.0f / 16777216.0f;
__device__ __forceinline__ u64 f2fixu(float v) { return (u64)(v * FIX_SCALE); }
__device__ __forceinline__ u64 f2fixs(float v) { return (u64)(long long)(v * FIX_SCALE); }
__device__ __forceinline__ void fix_add(u64* p, u64 v) { (void)__hip_atomic_fetch_add(p, v, __ATOMIC_RELAXED, __HIP_MEMORY_SCOPE_AGENT); }
__device__ __forceinline__ float rstd_of(const u64* ssq, int row) { return rsqrtf((float)ssq[row] * (FIX_INV * (1.0f / 4096.0f)) + 1e-6f); }
__device__ __forceinline__ float sum4(const f32x4& v) { return (v[0] + v[1]) + (v[2] + v[3]); }
__device__ __forceinline__ float ssq4(const f32x4& v) { return (v[0] * v[0] + v[1] * v[1]) + (v[2] * v[2] + v[3] * v[3]); }
__device__ __forceinline__ u32x4 pack8(const f32x4& a, const f32x4& b) { u32x4 w; w.x = cvt_pk_bf16(a[0], a[1]); w.y = cvt_pk_bf16(a[2], a[3]); w.z = cvt_pk_bf16(b[0], b[1]); w.w = cvt_pk_bf16(b[2], b[3]); return w; }

struct EpiSguIn {
    static constexpr bool PERM = true, AFTER_DRAIN = false;
    bf16_t* UV; const u64* ssq; u64* lnsum; u64* lnssq;
    __device__ __forceinline__ void operator()(const f32x4 (&acc)[2][2][4][2], const Unit& u, int wr, int wc, int fr, int fq) const {
        const int row0 = u.pm * BM + wr * 64 + fr, col0 = u.pn * BM + wc * 32 + 8 * fq;
        const bool isv = u.pn >= 16;
        float rs[2][4];
#pragma unroll
        for (int ai = 0; ai < 2; ++ai)
#pragma unroll
            for (int m = 0; m < 4; ++m) rs[ai][m] = rstd_of(ssq, row0 + ai * HALF + m * 16);
#pragma unroll
        for (int ai = 0; ai < 2; ++ai)
#pragma unroll
            for (int m = 0; m < 4; ++m) {
                const int row = row0 + ai * HALF + m * 16;
                float s1 = 0.f, s2 = 0.f;
                bf16_t* rowp = UV + (size_t)row * 8192 + col0;
#pragma unroll
                for (int bj = 0; bj < 2; ++bj) {
                    f32x4 v0 = acc[ai][bj][m][0] * rs[ai][m], v1 = acc[ai][bj][m][1] * rs[ai][m];
                    if (isv) {
                        const f32x2 a = gelu_pk((f32x2){v0[0], v0[1]}), b = gelu_pk((f32x2){v0[2], v0[3]}), c = gelu_pk((f32x2){v1[0], v1[1]}), d = gelu_pk((f32x2){v1[2], v1[3]});
                        v0 = (f32x4){a.x, a.y, b.x, b.y}; v1 = (f32x4){c.x, c.y, d.x, d.y};
                        s1 += sum4(v0) + sum4(v1); s2 += ssq4(v0) + ssq4(v1); }
                    *(u32x4*)(rowp + bj * HALF) = pack8(v0, v1);
                }
                if (isv) {
                    s1 += __shfl_xor(s1, 16); s1 += __shfl_xor(s1, 32); s2 += __shfl_xor(s2, 16); s2 += __shfl_xor(s2, 32);
                    if (fq == 0) { fix_add(lnsum + row, f2fixs(s1)); fix_add(lnssq + row, f2fixu(s2)); }
                }
            }
    }
    static constexpr bool TAIL_SPLIT = false;
    __device__ __forceinline__ void tail(int row, int cg, int pn, int q, f32x4 v0, f32x4 v1) const {
        const int col = pn * BM + (cg >> 2) * HALF + q * 32 + 8 * (cg & 3);
        const float rs = rstd_of(ssq, row);
        v0 = v0 * rs; v1 = v1 * rs;
        if (pn >= 16) { const f32x2 a = gelu_pk((f32x2){v0[0], v0[1]}), b = gelu_pk((f32x2){v0[2], v0[3]}), c = gelu_pk((f32x2){v1[0], v1[1]}), d = gelu_pk((f32x2){v1[2], v1[3]});
            v0 = (f32x4){a.x, a.y, b.x, b.y}; v1 = (f32x4){c.x, c.y, d.x, d.y}; }
        *(u32x4*)(UV + (size_t)row * 8192 + col) = pack8(v0, v1);
        if (pn >= 16) {
            float s1 = sum4(v0) + sum4(v1), s2 = ssq4(v0) + ssq4(v1);
            s1 += __shfl_xor(s1, 1); s1 += __shfl_xor(s1, 2); s1 += __shfl_xor(s1, 4); s2 += __shfl_xor(s2, 1); s2 += __shfl_xor(s2, 2); s2 += __shfl_xor(s2, 4);
            if (cg == 0) { fix_add(lnsum + row, f2fixs(s1)); fix_add(lnssq + row, f2fixu(s2)); }
        }
    }
};
template <bool RES_F32, bool XBOUT, bool OUT_F32> struct EpiRes {
    static constexpr bool PERM = true, AFTER_DRAIN = false;
    const float* res; const float* res_hi; float* out; bf16_t* XB; u64* ssq_out;
    __device__ __forceinline__ static f32x4 lo4(const u32x4& w) { return (f32x4){__builtin_bit_cast(float, w.x << 16), __builtin_bit_cast(float, w.x & 0xffff0000u), __builtin_bit_cast(float, w.y << 16), __builtin_bit_cast(float, w.y & 0xffff0000u)}; }
    __device__ __forceinline__ static f32x4 hi4(const u32x4& w) { return (f32x4){__builtin_bit_cast(float, w.z << 16), __builtin_bit_cast(float, w.z & 0xffff0000u), __builtin_bit_cast(float, w.w << 16), __builtin_bit_cast(float, w.w & 0xffff0000u)}; }
    __device__ __forceinline__ void operator()(const f32x4 (&acc)[2][2][4][2], const Unit& u, int wr, int wc, int fr, int fq) const {
        const int row0 = u.pm * BM + wr * 64 + fr, col0 = u.pn * BM + wc * 32 + 8 * fq;
        const float* rbase = u.pm < 32 ? res : res_hi;
#pragma unroll
        for (int ai = 0; ai < 2; ++ai) {
            f32x4 r[4][2][2];
#pragma unroll
            for (int m = 0; m < 4; ++m) { const size_t off = (size_t)(row0 + ai * HALF + m * 16) * 4096 + col0;
#pragma unroll
                for (int bj = 0; bj < 2; ++bj) {
                    if (RES_F32) { r[m][bj][0] = *(const f32x4*)(rbase + off + bj * HALF); r[m][bj][1] = *(const f32x4*)(rbase + off + bj * HALF + 4); }
                    else { const u32x4 w = *(const u32x4*)(XB + off + bj * HALF); r[m][bj][0] = lo4(w); r[m][bj][1] = hi4(w); } } }
#pragma unroll
            for (int m = 0; m < 4; ++m) { const int row = row0 + ai * HALF + m * 16; const size_t off = (size_t)row * 4096 + col0; float ss = 0.f;
#pragma unroll
                for (int bj = 0; bj < 2; ++bj) { const f32x4 o0 = r[m][bj][0] + acc[ai][bj][m][0], o1 = r[m][bj][1] + acc[ai][bj][m][1];
                    if (OUT_F32) { *(f32x4*)(out + off + bj * HALF) = o0; *(f32x4*)(out + off + bj * HALF + 4) = o1; }
                    if (XBOUT) { *(u32x4*)(XB + off + bj * HALF) = pack8(o0, o1); ss += ssq4(o0) + ssq4(o1); } }
                if (XBOUT) { ss += __shfl_xor(ss, 16); ss += __shfl_xor(ss, 32); if (fq == 0) fix_add(ssq_out + row, f2fixu(ss)); } }
            asm volatile("" ::: "memory");
        }
    }
    static constexpr bool TAIL_SPLIT = false;
    __device__ __forceinline__ void tail(int row, int cg, int pn, int q, f32x4 v0, f32x4 v1) const {
        const size_t off = (size_t)row * 4096 + pn * BM + (cg >> 2) * HALF + q * 32 + 8 * (cg & 3);
        f32x4 r0, r1;
        if (RES_F32) { r0 = *(const f32x4*)(res_hi + off); r1 = *(const f32x4*)(res_hi + off + 4); }
        else { const u32x4 w = *(const u32x4*)(XB + off); r0 = lo4(w); r1 = hi4(w); }
        const f32x4 o0 = r0 + v0, o1 = r1 + v1;
        if (OUT_F32) { *(f32x4*)(out + off) = o0; *(f32x4*)(out + off + 4) = o1; }
        if (XBOUT) {
            *(u32x4*)(XB + off) = pack8(o0, o1);
            float ss = ssq4(o0) + ssq4(o1); ss += __shfl_xor(ss, 1); ss += __shfl_xor(ss, 2); ss += __shfl_xor(ss, 4);
            if (cg == 0) fix_add(ssq_out + row, f2fixu(ss));
        }
    }
};
struct EpiSwiglu {
    static constexpr bool PERM = true, AFTER_DRAIN = false;
    bf16_t* ACT; const u64* ssq;
    __device__ __forceinline__ void operator()(const f32x4 (&acc)[2][2][4][2], const Unit& u, int wr, int wc, int fr, int fq) const {
        const int row0 = u.pm * BM + wr * 64 + fr, col0 = u.pn * HALF + wc * 32 + 8 * fq;
        float rs[2][4];
#pragma unroll
        for (int ai = 0; ai < 2; ++ai)
#pragma unroll
            for (int m = 0; m < 4; ++m) rs[ai][m] = rstd_of(ssq, row0 + ai * HALF + m * 16);
#pragma unroll
        for (int ai = 0; ai < 2; ++ai)
#pragma unroll
            for (int m = 0; m < 4; ++m) {
                const int row = row0 + ai * HALF + m * 16; f32x4 o[2];
#pragma unroll
                for (int n = 0; n < 2; ++n) { const f32x4 g = acc[ai][0][m][n] * rs[ai][m], up = acc[ai][1][m][n] * rs[ai][m];
#pragma unroll
                    for (int j = 0; j < 4; ++j) o[n][j] = g[j] * __builtin_amdgcn_rcpf(1.0f + __builtin_amdgcn_exp2f(-1.44269504f * g[j])) * up[j]; }
                *(u32x4*)(ACT + (size_t)row * 11008 + col0) = pack8(o[0], o[1]);
            }
    }
    static constexpr bool TAIL_SPLIT = true;
    __device__ __forceinline__ void tail(int row, int cg, int pn, int q, f32x4 g, f32x4 up) const {
        const float rs = rstd_of(ssq, row);
        g = g * rs; up = up * rs; f32x4 o;
#pragma unroll
        for (int j = 0; j < 4; ++j) o[j] = g[j] * __builtin_amdgcn_rcpf(1.0f + __builtin_amdgcn_exp2f(-1.44269504f * g[j])) * up[j];
        typedef unsigned u32x2t __attribute__((ext_vector_type(2)));
        u32x2t w; w.x = cvt_pk_bf16(o[0], o[1]); w.y = cvt_pk_bf16(o[2], o[3]);
        *(u32x2t*)(ACT + (size_t)row * 11008 + pn * HALF + q * 32 + 4 * cg) = w;
    }
};
constexpr size_t OUT_KP = 34603008, OUT_VP = 34734080, OUT_KS = 34865152, OUT_VS = 34996224, OUT_SGUV = 35127296;
struct EpiQKV {
    static constexpr bool PERM = true, AFTER_DRAIN = false;
    bf16_t *KB, *VB, *QB; float* out; const u64* ssq; const float* kg; const float* qg;
    __device__ __forceinline__ void operator()(const f32x4 (&acc)[2][2][4][2], const Unit& u, int wr, int wc, int fr, int fq) const {
        const int row0 = u.pm * BM + wr * 64 + fr;
        const bool isk = u.pn < 2, isq = u.pn >= 4, isv = !isk && !isq;
        const int hidx = (isk ? u.pn : (isq ? u.pn - 4 : u.pn - 2)) * 4 + wc;
        bf16_t* const kvb = isk ? KB : VB; const size_t o_s = isk ? OUT_KS : OUT_VS, o_p = isk ? OUT_KP : OUT_VP;
        const float* gp = (u.pn < 2) ? kg : qg;
        f32x4 gv[2][2];
#pragma unroll
        for (int bj = 0; bj < 2; ++bj)
#pragma unroll
            for (int n = 0; n < 2; ++n) gv[bj][n] = *(const f32x4*)(gp + 32 * bj + 8 * fq + 4 * n);
        const float gs = isq ? 0.125f : 1.0f;
        float rs[2][4];
#pragma unroll
        for (int ai = 0; ai < 2; ++ai)
#pragma unroll
            for (int m = 0; m < 4; ++m) rs[ai][m] = rstd_of(ssq, row0 + ai * HALF + m * 16);
#pragma unroll
        for (int ai = 0; ai < 2; ++ai)
#pragma unroll
            for (int m = 0; m < 4; ++m) {
                const int row = row0 + ai * HALF + m * 16;
                f32x4 t[2][2]; float ss = 0.f;
#pragma unroll
                for (int bj = 0; bj < 2; ++bj)
#pragma unroll
                    for (int n = 0; n < 2; ++n) { t[bj][n] = acc[ai][bj][m][n] * rs[ai][m]; ss += ssq4(t[bj][n]); }
                if (!isv) {
                    ss += __shfl_xor(ss, 16); ss += __shfl_xor(ss, 32);
                    const float r = rsqrtf(ss * (1.0f / 64.0f) + 1e-6f) * gs;
#pragma unroll
                    for (int bj = 0; bj < 2; ++bj)
#pragma unroll
                        for (int n = 0; n < 2; ++n) t[bj][n] = t[bj][n] * r * gv[bj][n];
                }
                if (isq) {
                    bf16_t* p = QB + (size_t)row * 4096 + hidx * 64 + 8 * fq;
#pragma unroll
                    for (int bj = 0; bj < 2; ++bj) *(u32x4*)(p + 32 * bj) = pack8(t[bj][0], t[bj][1]);
                } else {
                    const int kr = row < 8192 ? row : 8192 + 160 * ((row - 8192) >> 5) + 128 + ((row - 8192) & 31);
                    bf16_t* p = kvb + (size_t)kr * 512 + hidx * 64 + 8 * fq;
#pragma unroll
                    for (int bj = 0; bj < 2; ++bj) *(u32x4*)(p + 32 * bj) = pack8(t[bj][0], t[bj][1]);
                    float* op = nullptr;
                    if (row >= 8192) op = out + o_s + (size_t)(row - 8192) * 512 + hidx * 64 + 8 * fq;
                    else { const int tt = row & 4095; if (tt >= 3968) op = out + o_p + (size_t)((row >> 12) * 128 + tt - 3968) * 512 + hidx * 64 + 8 * fq; }
                    if (op) {
#pragma unroll
                        for (int bj = 0; bj < 2; ++bj) { *(f32x4*)(op + 32 * bj) = t[bj][0]; *(f32x4*)(op + 32 * bj + 4) = t[bj][1]; }
                    }
                }
            }
    }
    static constexpr bool TAIL_SPLIT = false;
    __device__ __forceinline__ void tail(int row, int cg, int pn, int q, f32x4 v0, f32x4 v1) const {
        const bool isk = pn < 2, isq = pn >= 4, isv = !isk && !isq;
        const int hidx = (isk ? pn : (isq ? pn - 4 : pn - 2)) * 4 + q;
        const float rs = rstd_of(ssq, row);
        v0 = v0 * rs; v1 = v1 * rs;
        if (!isv) {
            const float* gp = isk ? kg : qg;
            const f32x4 g0 = *(const f32x4*)(gp + 8 * cg), g1 = *(const f32x4*)(gp + 8 * cg + 4);
            float ss = ssq4(v0) + ssq4(v1); ss += __shfl_xor(ss, 1); ss += __shfl_xor(ss, 2); ss += __shfl_xor(ss, 4);
            const float r = rsqrtf(ss * (1.0f / 64.0f) + 1e-6f) * (isq ? 0.125f : 1.0f);
            v0 = v0 * r * g0; v1 = v1 * r * g1;
        }
        if (isq) { *(u32x4*)(QB + (size_t)row * 4096 + hidx * 64 + 8 * cg) = pack8(v0, v1); }
        else {
            const int kr = 8192 + 160 * ((row - 8192) >> 5) + 128 + ((row - 8192) & 31);
            *(u32x4*)((isk ? KB : VB) + (size_t)kr * 512 + hidx * 64 + 8 * cg) = pack8(v0, v1);
            float* op = out + (isk ? OUT_KS : OUT_VS) + (size_t)(row - 8192) * 512 + hidx * 64 + 8 * cg;
            *(f32x4*)op = v0; *(f32x4*)(op + 4) = v1;
        }
    }
};
template <class Epi, class Sched, bool ALIGN_EPI = false, bool SP2 = false>
__device__ __forceinline__ void gemm_phase(PG8_LAS unsigned char* lds, const Gemm g, const Sched& S, const Epi& E) {
    const int tid = threadIdx.x, wid = __builtin_amdgcn_readfirstlane(tid >> 6), lane = tid & 63, wr = wid >> 2, wc = wid & 3, fr = lane & 15, fq = lane >> 4;
    const int K = g.K, nt = K / BK;
    unsigned voffA[2], voffB[2];
#pragma unroll
    for (int i = 0; i < 2; ++i) { int R, C; stage_rc(tid * 16 + i * 8192, R, C); const int Rb = Epi::PERM ? ((R & ~31) + perm32(R & 31)) : R;
        voffA[i] = (unsigned)(R * K + C) * 2u; voffB[i] = (unsigned)(Rb * K + C) * 2u; }
    const size_t kstep = (size_t)(BK * 2);
    const size_t hstep = (size_t)HALF * K * 2;
    const size_t tstep = 2 * hstep;
    const unsigned ldsw = (unsigned)wid * 1024u;
    const int aoff = lds_byte(wr * 64 + fr, fq * 8), boff = lds_byte(wc * 32 + fr, fq * 8);
#define PG8_SA(b, h) (((b) * 2 + (h)) * HTB)
#define PG8_SB(b, h) ((4 + (b) * 2 + (h)) * HTB)
#define PG8_STAGE(bufoff, gbase, voff) do { _Pragma("unroll") for (int _i = 0; _i < 2; ++_i) \
        __builtin_amdgcn_global_load_lds((const unsigned*)((const char*)(gbase) + (voff)[_i]), (PG8_LAS unsigned*)(lds + (bufoff) + ldsw + _i * 8192), 16, 0, 0); } while (0)
#define PG8_LDA(dst, b, h) do { _Pragma("unroll") for (int m = 0; m < 4; ++m) _Pragma("unroll") for (int k = 0; k < 2; ++k) dst[m][k] = *(const PG8_LAS bf16x8*)(lds + PG8_SA(b, h) + aoff + m * 2048 + k * 1024); } while (0)
#define PG8_LDB(dst, b, h) do { _Pragma("unroll") for (int n = 0; n < 2; ++n) _Pragma("unroll") for (int k = 0; k < 2; ++k) dst[n][k] = *(const PG8_LAS bf16x8*)(lds + PG8_SB(b, h) + boff + n * 2048 + k * 1024); } while (0)
#define PG8_MMA(ai, bj, At, Bt) do { __builtin_amdgcn_s_setprio(1); _Pragma("unroll") for (int m = 0; m < 4; ++m) _Pragma("unroll") for (int n = 0; n < 2; ++n) _Pragma("unroll") for (int k = 0; k < 2; ++k) \
        acc[ai][bj][m][n] = __builtin_amdgcn_mfma_f32_16x16x32_bf16(Bt[n][k], At[m][k], acc[ai][bj][m][n], 0, 0, 0); __builtin_amdgcn_s_setprio(0); } while (0)
#define PG8_WAIT_V(n) asm volatile("s_waitcnt vmcnt(" #n ")" ::: "memory")
#define PG8_WAIT_L(n) asm volatile("s_waitcnt lgkmcnt(" #n ")" ::: "memory")
#define PG8_BAR __builtin_amdgcn_s_barrier()
#define PG8_SCHED __builtin_amdgcn_sched_barrier(0)
    Unit cur, nxt; int ui = 0;
    if (!S.next(0, cur)) return;
    f32x4 acc[2][2][4][2];
#pragma unroll
    for (int a = 0; a < 2; ++a)
#pragma unroll
        for (int b = 0; b < 2; ++b)
#pragma unroll
            for (int m = 0; m < 4; ++m)
#pragma unroll
                for (int n = 0; n < 2; ++n) acc[a][b][m][n] = (f32x4){0.f, 0.f, 0.f, 0.f};
    bf16x8 At[4][2], B0[2][2], B1[2][2];
    const char* cA = (const char*)g.A + (size_t)cur.pm * tstep; const char* cB = (const char*)g.Bt + (size_t)cur.pn * tstep;
    S.a_ready(cur);
    if constexpr (SP2) {
        PG8_STAGE(PG8_SB(0, 0), cB, voffB); PG8_STAGE(PG8_SB(0, 1), cB + hstep, voffB); PG8_STAGE(PG8_SA(0, 0), cA, voffA); PG8_STAGE(PG8_SA(0, 1), cA + hstep, voffA);
        if (wr == 1) PG8_BAR;
        PG8_WAIT_V(2); PG8_BAR;
        PG8_STAGE(PG8_SB(1, 0), cB + kstep, voffB); PG8_STAGE(PG8_SA(1, 0), cA + kstep, voffA); PG8_STAGE(PG8_SB(1, 1), cB + hstep + kstep, voffB);
        PG8_WAIT_V(6); PG8_BAR;
    } else {
        PG8_STAGE(PG8_SB(0, 0), cB, voffB); PG8_STAGE(PG8_SA(0, 0), cA, voffA); PG8_STAGE(PG8_SB(0, 1), cB + hstep, voffB); PG8_STAGE(PG8_SA(0, 1), cA + hstep, voffA);
        if (wr == 1) PG8_BAR;
        PG8_WAIT_V(4); PG8_BAR;
        PG8_STAGE(PG8_SB(1, 0), cB + kstep, voffB); PG8_STAGE(PG8_SA(1, 0), cA + kstep, voffA); PG8_STAGE(PG8_SB(1, 1), cB + hstep + kstep, voffB);
        PG8_WAIT_V(6); PG8_BAR;
    }
    for (;;) {
        const bool has_next = S.next(ui + 1, nxt);
        const char* nA = has_next ? (const char*)g.A + (size_t)nxt.pm * tstep : cA; const char* nB = has_next ? (const char*)g.Bt + (size_t)nxt.pn * tstep : cB;
        for (int t = 0; t < nt; t += 2) {
            const bool last = (t == nt - 2);
            const char* a1 = cA + (size_t)(t + 1) * kstep;
            const char* a2 = last ? nA : cA + (size_t)(t + 2) * kstep; const char* b2 = last ? nB : cB + (size_t)(t + 2) * kstep;
            const char* a3 = a2 + kstep; const char* b3 = b2 + kstep;
            if (last && has_next) S.a_ready(nxt);
            if constexpr (SP2) {
            PG8_LDB(B0, 0, 0); PG8_LDB(B1, 0, 1); PG8_SCHED; PG8_LDA(At, 0, 0); PG8_STAGE(PG8_SA(1, 1), a1 + hstep, voffA);
            PG8_WAIT_V(8); PG8_WAIT_L(0); PG8_BAR; PG8_MMA(0, 0, At, B0); PG8_MMA(0, 1, At, B1); PG8_BAR; PG8_SCHED;
            PG8_LDA(At, 0, 1); PG8_STAGE(PG8_SB(0, 0), b2, voffB); PG8_STAGE(PG8_SB(0, 1), b2 + hstep, voffB); PG8_STAGE(PG8_SA(0, 0), a2, voffA);
            PG8_WAIT_V(8); PG8_WAIT_L(0); PG8_BAR; PG8_MMA(1, 0, At, B0); PG8_MMA(1, 1, At, B1); PG8_BAR; PG8_SCHED;
            PG8_LDB(B0, 1, 0); PG8_LDB(B1, 1, 1); PG8_SCHED; PG8_LDA(At, 1, 0); PG8_STAGE(PG8_SA(0, 1), a2 + hstep, voffA);
            PG8_WAIT_V(8); PG8_WAIT_L(0); PG8_BAR; PG8_MMA(0, 0, At, B0); PG8_MMA(0, 1, At, B1); PG8_BAR; PG8_SCHED;
            PG8_LDA(At, 1, 1); PG8_STAGE(PG8_SB(1, 0), b3, voffB); PG8_STAGE(PG8_SB(1, 1), b3 + hstep, voffB); PG8_STAGE(PG8_SA(1, 0), a3, voffA);
            PG8_WAIT_V(8); PG8_WAIT_L(0); PG8_BAR; PG8_MMA(1, 0, At, B0); PG8_MMA(1, 1, At, B1); PG8_BAR; PG8_SCHED;
            } else {
            PG8_LDB(B0, 0, 0); PG8_SCHED; PG8_LDA(At, 0, 0); PG8_STAGE(PG8_SA(1, 1), a1 + hstep, voffA);
            PG8_WAIT_L(8); PG8_BAR; PG8_WAIT_L(0); PG8_MMA(0, 0, At, B0); PG8_BAR; PG8_SCHED;
            PG8_LDB(B1, 0, 1); PG8_STAGE(PG8_SB(0, 0), b2, voffB);
            PG8_BAR; PG8_WAIT_L(0); PG8_MMA(0, 1, At, B1); PG8_BAR;
            PG8_LDA(At, 0, 1); PG8_STAGE(PG8_SA(0, 0), a2, voffA);
            PG8_BAR; PG8_WAIT_L(0); PG8_MMA(1, 0, At, B0); PG8_BAR; PG8_SCHED;
            PG8_STAGE(PG8_SB(0, 1), b2 + hstep, voffB);
            PG8_WAIT_V(6); PG8_BAR; PG8_MMA(1, 1, At, B1); PG8_BAR;
            PG8_LDB(B0, 1, 0); PG8_SCHED; PG8_LDA(At, 1, 0); PG8_STAGE(PG8_SA(0, 1), a2 + hstep, voffA);
            PG8_WAIT_L(8); PG8_BAR; PG8_WAIT_L(0); PG8_MMA(0, 0, At, B0); PG8_BAR; PG8_SCHED;
            PG8_LDB(B1, 1, 1); PG8_STAGE(PG8_SB(1, 0), b3, voffB);
            PG8_BAR; PG8_WAIT_L(0); PG8_MMA(0, 1, At, B1); PG8_BAR;
            PG8_LDA(At, 1, 1); PG8_STAGE(PG8_SA(1, 0), a3, voffA);
            PG8_BAR; PG8_WAIT_L(0); PG8_MMA(1, 0, At, B0); PG8_BAR; PG8_SCHED;
            PG8_STAGE(PG8_SB(1, 1), b3 + hstep, voffB);
            PG8_WAIT_V(6); PG8_BAR; PG8_MMA(1, 1, At, B1); PG8_BAR;
            }
        }
        if constexpr (ALIGN_EPI) { if (wr == 0) PG8_BAR; }
        if constexpr (!Epi::AFTER_DRAIN) { E(acc, cur, wr, wc, fr, fq); S.done(cur); }
        if (!has_next) break;
#pragma unroll
        for (int a = 0; a < 2; ++a)
#pragma unroll
            for (int b = 0; b < 2; ++b)
#pragma unroll
                for (int m = 0; m < 4; ++m)
#pragma unroll
                    for (int n = 0; n < 2; ++n) acc[a][b][m][n] = (f32x4){0.f, 0.f, 0.f, 0.f};
        cur = nxt; cA = nA; cB = nB; ++ui;
        if constexpr (ALIGN_EPI) { if (wr == 1) PG8_BAR; }
    }
    PG8_WAIT_V(0);
    if constexpr (!ALIGN_EPI) { if (wr == 0) PG8_BAR; }
    PG8_BAR;
    if constexpr (Epi::AFTER_DRAIN) { E.fused(acc, cur, wr, wc, fr, fq, lds, wid, lane); S.done(cur); }
#undef PG8_SA
#undef PG8_SB
#undef PG8_STAGE
#undef PG8_LDA
#undef PG8_LDB
#undef PG8_MMA
#undef PG8_WAIT_V
#undef PG8_WAIT_L
#undef PG8_BAR
#undef PG8_SCHED
}
}

#ifndef PG8_SP2
#define PG8_SP2 true
#endif
#ifndef PG8_ALIGN
#define PG8_ALIGN true
#endif
#ifndef MK_ONE_LAUNCH
#define MK_ONE_LAUNCH 1
#endif
constexpr int NWAVES = 8, NPHASES = 11;
constexpr int D = 4096, MP = 8192, MS = 256, M = MP + MS, DFF = 11008, NGU = 2 * DFF, NQKV = 5120, NSGU = 8192;
constexpr int KV_ROWS = 8192 + 8 * 160;
constexpr size_t MiB = 1u << 20;
constexpr size_t WS_CTL = 0, CTL_ZERO_BYTES = 1 * MiB;
constexpr int CW_BAR = 4096, CW_Q = 8192;
constexpr size_t ST_OFF = 65536, ST_STRIDE = 67584;
static_assert(ST_STRIDE == (size_t)M * 8 && ST_OFF + 6 * ST_STRIDE <= CTL_ZERO_BYTES, "stat arrays inside the memset region");
constexpr size_t WS_WSB = 1 * MiB;
constexpr size_t WS_W1T = 2 * MiB, WS_W2T = 66 * MiB, WS_WGU0 = 98 * MiB, WS_WD0 = 270 * MiB, WS_WQKV = 356 * MiB, WS_WOT = 396 * MiB, WS_WGU1 = 428 * MiB, WS_WD1 = 600 * MiB;
constexpr size_t WS_XB = 686 * MiB, WS_H = 752 * MiB, WS_ACT = 884 * MiB, WS_ZQ = 1062 * MiB, WS_O = 1128 * MiB, WS_KB = 1194 * MiB, WS_VB = 1204 * MiB, WS_END = 1214 * MiB;
static_assert(WS_W1T + (size_t)NSGU * D * 2 <= WS_W2T && WS_W2T + (size_t)D * D * 2 <= WS_WGU0 && WS_WGU0 + (size_t)NGU * D * 2 <= WS_WD0 && WS_WD0 + (size_t)D * DFF * 2 <= WS_WQKV &&
              WS_WQKV + (size_t)NQKV * D * 2 <= WS_WOT && WS_WOT + (size_t)D * D * 2 <= WS_WGU1 && WS_WGU1 + (size_t)NGU * D * 2 <= WS_WD1 && WS_WD1 + (size_t)D * DFF * 2 <= WS_XB, "weight map");
static_assert(WS_XB + (size_t)M * D * 2 <= WS_H && WS_H + (size_t)M * D * 4 <= WS_ACT && WS_ACT + (size_t)M * DFF * 2 <= WS_ZQ && WS_ACT + (size_t)M * NSGU * 2 <= WS_ZQ &&
              WS_ZQ + (size_t)M * D * 2 <= WS_O && WS_O + (size_t)M * D * 2 <= WS_KB && WS_KB + (size_t)KV_ROWS * 512 * 2 <= WS_VB && WS_VB + (size_t)KV_ROWS * 512 * 2 <= WS_END, "activation map");
constexpr int SCR_BYTES = 139264;
constexpr int LDSCTL_OFF = SCR_BYTES, MISC_OFF = LDSCTL_OFF + 320;
constexpr int LDS_BYTES = 147456;
static_assert(MISC_OFF + 128 <= LDS_BYTES && pg8::STAGE_BYTES <= SCR_BYTES, "LDS map");

#define GAS __attribute__((address_space(1)))
#define LAS __attribute__((address_space(3)))
typedef unsigned short bf16;
typedef unsigned v4u __attribute__((ext_vector_type(4)));
typedef unsigned v2u __attribute__((ext_vector_type(2)));
typedef float f32x4 __attribute__((ext_vector_type(4)));
typedef short bf16x8 __attribute__((ext_vector_type(8)));
typedef unsigned long long u64;
#define LDS_WAIT() asm volatile("s_waitcnt lgkmcnt(0)" ::: "memory")
#define VM_WAIT() asm volatile("s_waitcnt vmcnt(0)" ::: "memory")
__device__ __forceinline__ unsigned f2bf(float f) { unsigned u = __builtin_bit_cast(unsigned, f); return (u + 0x7fffu + ((u >> 16) & 1u)) >> 16; }
typedef float f32x2_t __attribute__((ext_vector_type(2)));
typedef __bf16 bf16x2_t __attribute__((ext_vector_type(2)));
__device__ __forceinline__ unsigned pk2(float lo, float hi) { const f32x2_t v = {lo, hi}; const bf16x2_t b = __builtin_convertvector(v, bf16x2_t); return __builtin_bit_cast(unsigned, b); }
__device__ __forceinline__ float bflo(unsigned w) { return __builtin_bit_cast(float, w << 16); }
__device__ __forceinline__ float bfhi(unsigned w) { return __builtin_bit_cast(float, w & 0xffff0000u); }

#define XB_TMO      128
#define XB_XCNT(j)  (256  + 64 * (j))
#define XB_XSUB(j)  (1280 + 64 * (j))
#define XB_XGEN(j)  (2304 + 64 * (j))
#define XB_TOP      3328
#define XB_TOPGEN   3392
#define XCD_BAR_WORDS 3456
#define XB_SPIN_CAP (1u << 18)

__device__ __forceinline__ unsigned xb_ld(unsigned* p)              { return __hip_atomic_load(p, __ATOMIC_RELAXED, __HIP_MEMORY_SCOPE_AGENT); }
__device__ __forceinline__ unsigned xb_add(unsigned* p, unsigned v) { return __hip_atomic_fetch_add(p, v, __ATOMIC_RELAXED, __HIP_MEMORY_SCOPE_AGENT); }
__device__ __forceinline__ unsigned xb_xcc_id() { return (unsigned)__builtin_amdgcn_s_getreg((3 << 11) | 20) & 0xFu; }
#define XB_SPIN(cond, bar) do { unsigned _sp = 0; while (cond) { __builtin_amdgcn_s_sleep(1); \
    if ((++_sp & 255u) == 0u) { if (xb_ld(&(bar)[XB_TMO])) break; if (_sp > XB_SPIN_CAP) { atomicAdd(&(bar)[XB_TMO], 1u); break; } } } } while (0)

struct XcdBarrier {
    unsigned* bar; unsigned x;
    volatile LAS unsigned* st;
};

__device__ __forceinline__ XcdBarrier xcd_barrier_post(unsigned* bar, volatile LAS unsigned* st) {
    XcdBarrier b; b.bar = bar; b.x = xb_xcc_id(); b.st = st;
    if (threadIdx.x == 0) (void)xb_add(&bar[XB_XCNT(b.x)], 1u);
    return b;
}
__device__ __forceinline__ void xcd_barrier_complete(unsigned* bar, unsigned x, unsigned& nloc, unsigned& nx) {
    const unsigned G = gridDim.x * gridDim.y * gridDim.z;
    unsigned sum, cnt, mine, sp = 0u;
    for (;;) {
        sum = 0u; cnt = 0u; mine = 0u;
#pragma unroll
        for (unsigned j = 0; j < 16; ++j) { const unsigned c = xb_ld(&bar[XB_XCNT(j)]); sum += c; cnt += (c > 0u) ? 1u : 0u; mine = (j == x) ? c : mine; }
        if (sum == G) break;
        __builtin_amdgcn_s_sleep(1);
        if ((++sp & 255u) == 0u) { if (xb_ld(&bar[XB_TMO])) break; if (sp > XB_SPIN_CAP) { atomicAdd(&bar[XB_TMO], 1u); break; } }
    }
    nloc = mine > 0u ? mine : 1u; nx = cnt > 0u ? cnt : 1u;
}

__device__ __forceinline__ void xcd_barrier(const XcdBarrier& b) {
    asm volatile("s_waitcnt vmcnt(0)" ::: "memory");
    __syncthreads();
    if (threadIdx.x == 0) {
        unsigned* bar = b.bar;
        __builtin_amdgcn_s_waitcnt(0);
        unsigned nloc = b.st[0], nx = b.st[1];
        if (nloc == 0u) { xcd_barrier_complete(bar, b.x, nloc, nx); b.st[0] = nloc; b.st[1] = nx; }
        const unsigned old = xb_add(&bar[XB_XSUB(b.x)], 1u);
        const unsigned gen = old / nloc;
        if (old + 1u == (gen + 1u) * nloc) {
            __builtin_amdgcn_fence(__ATOMIC_RELEASE, "agent");
            asm volatile("s_waitcnt vmcnt(0)" ::: "memory");
            const unsigned og = xb_add(&bar[XB_TOP], 1u);
            const unsigned tg = og / nx;
            if (og + 1u == (tg + 1u) * nx) xb_add(&bar[XB_TOPGEN], 1u);
            else XB_SPIN(xb_ld(&bar[XB_TOPGEN]) == tg, bar);
            __builtin_amdgcn_fence(__ATOMIC_ACQUIRE, "agent");
            xb_add(&bar[XB_XGEN(b.x)], 1u);
            asm volatile("s_waitcnt vmcnt(0)" ::: "memory");
        } else {
            XB_SPIN(xb_ld(&bar[XB_XGEN(b.x)]) == gen, bar);
            __builtin_amdgcn_fence(__ATOMIC_ACQUIRE, "agent");
            asm volatile("s_waitcnt vmcnt(0)" ::: "memory");
        }
    }
    __syncthreads();
}


using pg8::FIX_INV;
__device__ __forceinline__ float wave_sum(float v) {
#pragma unroll
    for (int o = 1; o < 64; o <<= 1) v += __shfl_xor(v, o);
    return v;
}
__device__ __forceinline__ int maprow(int map, int n) {
    const int r12 = ((n >> 7) << 8) + (n & 127) + (map == 2 ? 128 : 0);
    const int r3 = (n & ~255) + (((n >> 5) & 1) << 7) + (((n >> 6) & 3) << 5) + (n & 31);
    return map == 0 ? n : (map == 3 ? r3 : r12);
}
struct TItem { const float* W; const float* gain; bf16* WT; int K, N, map, coff, k0, n0; };
struct TRegs { f32x4 v[16]; f32x4 g0, g1; };
__device__ __forceinline__ void titem_load(const TItem& t, TRegs& R, const float* dummy, int lane) {
    const float* p = t.W + (size_t)(t.k0 + (lane >> 4)) * t.N + t.n0 + 4 * (lane & 15);
#pragma unroll
    for (int i = 0; i < 16; ++i) R.v[i] = __builtin_nontemporal_load((const f32x4*)(p + (size_t)(4 * i) * t.N));
    const float* gp = (t.gain ? t.gain + t.k0 : dummy + (t.k0 & 4095)) + 8 * (lane & 7);
    R.g0 = *(const f32x4*)gp; R.g1 = *(const f32x4*)(gp + 4);
}
__device__ __forceinline__ void titem_lds_write(const TRegs& R, LAS float* scr, int lane) {
#pragma unroll
    for (int i = 0; i < 16; ++i) { const int kk = 4 * i + (lane >> 4), c4 = (lane & 15) ^ (((kk >> 3) & 3) << 1); *(LAS f32x4*)(scr + kk * 64 + 4 * c4) = R.v[i]; }
}
__device__ __forceinline__ void titem_emit(const TItem& t, f32x4 g0, f32x4 g1, LAS float* scr, int lane) {
    LDS_WAIT(); asm volatile("" ::: "memory");
    const int c = lane & 7, nn = lane >> 3;
    const bool hg = t.gain != nullptr; const f32x4 one = {1.f, 1.f, 1.f, 1.f};
    g0 = hg ? g0 : one; g1 = hg ? g1 : one;
    const int sw = (c & 3) << 1;
#pragma unroll
    for (int j = 0; j < 8; ++j) { const int n = 8 * j + nn; const LAS float* sp = scr + (8 * c) * 64 + ((((n >> 2) ^ sw) << 2) | (n & 3));
        v4u o; o.x = pk2(sp[0 * 64] * g0.x, sp[1 * 64] * g0.y); o.y = pk2(sp[2 * 64] * g0.z, sp[3 * 64] * g0.w); o.z = pk2(sp[4 * 64] * g1.x, sp[5 * 64] * g1.y); o.w = pk2(sp[6 * 64] * g1.z, sp[7 * 64] * g1.w);
        __builtin_nontemporal_store(o, (GAS v4u*)(t.WT + (size_t)maprow(t.map, t.n0 + n + t.coff) * t.K + t.k0 + 8 * c)); }
    LDS_WAIT(); asm volatile("" ::: "memory");
}
struct Args { const float* in[23]; float* out; unsigned char* ws; int ph_lo, ph_hi; };
constexpr int P0_ITEMS_A = 64 * 128;
constexpr int P0_ITEMS_ALL = 64 * 128 + 64 * 64 + 2 * 64 * 172 + 172 * 64 + 64 * 16 + 64 * 64 + 64 * 64 + 2 * 64 * 172 + 172 * 64;
__device__ __forceinline__ void p0_prologue(const Args& a, unsigned char* ws, LAS unsigned char* lds, int gw, int NGW, int it_lo, int it_hi, int misc, int wave, int lane) {
    LAS float* scr = (LAS float*)(lds + wave * 16384);
    constexpr int IT_1 = 64 * 128, IT_SQ = 64 * 64, IT_G = 64 * 172, IT_D = 172 * 64, IT_KV = 64 * 16;
    constexpr int NITEMS = IT_1 + IT_SQ + 2 * IT_G + IT_D + IT_KV + IT_SQ + IT_SQ + 2 * IT_G + IT_D;
    auto describe = [&](int it) -> TItem {
        TItem t; int r = it; t.gain = nullptr; t.K = 4096; t.N = 4096; t.map = 0; t.coff = 0;
        if (r < IT_1) { t.W = a.in[5]; t.gain = a.in[4]; t.WT = (bf16*)(ws + WS_W1T); t.N = 8192; }
        else if ((r -= IT_1) < IT_SQ) { t.W = a.in[10]; t.WT = (bf16*)(ws + WS_W2T); }
        else if ((r -= IT_SQ) < IT_G) { t.W = a.in[20]; t.gain = a.in[19]; t.WT = (bf16*)(ws + WS_WGU0); t.N = DFF; t.map = 1; }
        else if ((r -= IT_G) < IT_G) { t.W = a.in[21]; t.gain = a.in[19]; t.WT = (bf16*)(ws + WS_WGU0); t.N = DFF; t.map = 2; }
        else if ((r -= IT_G) < IT_D) { t.W = a.in[22]; t.WT = (bf16*)(ws + WS_WD0); t.K = DFF; }
        else if ((r -= IT_D) < IT_KV) { t.W = a.in[12]; t.gain = a.in[11]; t.WT = (bf16*)(ws + WS_WQKV); t.N = 1024; t.map = 3; }
        else if ((r -= IT_KV) < IT_SQ) { t.W = a.in[15]; t.gain = a.in[14]; t.WT = (bf16*)(ws + WS_WQKV); t.map = 3; t.coff = 1024; }
        else if ((r -= IT_SQ) < IT_SQ) { t.W = a.in[18]; t.WT = (bf16*)(ws + WS_WOT); }
        else if ((r -= IT_SQ) < IT_G) { t.W = a.in[20] + (size_t)D * DFF; t.gain = a.in[19] + D; t.WT = (bf16*)(ws + WS_WGU1); t.N = DFF; t.map = 1; }
        else if ((r -= IT_G) < IT_G) { t.W = a.in[21] + (size_t)D * DFF; t.gain = a.in[19] + D; t.WT = (bf16*)(ws + WS_WGU1); t.N = DFF; t.map = 2; }
        else { r -= IT_G; t.W = a.in[22] + (size_t)D * DFF; t.WT = (bf16*)(ws + WS_WD1); t.K = DFF; }
        const int nblk = t.N >> 6, kb = r / nblk; t.k0 = 64 * kb; t.n0 = 64 * (r - kb * nblk);
        return t;
    };
    static_assert(NITEMS == P0_ITEMS_ALL && IT_1 == P0_ITEMS_A, "item counts");
    if (it_lo + gw < it_hi) {
        const int first = it_lo + gw, last = first + ((it_hi - 1 - first) / NGW) * NGW, count = (last - first) / NGW + 1;
        TRegs ra, rb; const float* dummy = a.in[4];
        TItem ta = describe(first), tb = describe(first + NGW <= last ? first + NGW : last);
        titem_load(ta, ra, dummy, lane); titem_load(tb, rb, dummy, lane);
        for (int j = 0; j < count; j += 2) {
            const int i2 = first + (j + 2) * NGW, i3 = first + (j + 3) * NGW;
            const TItem tc = describe(i2 <= last ? i2 : last), td = describe(i3 <= last ? i3 : last);
            { titem_lds_write(ra, scr, lane); const f32x4 g0 = ra.g0, g1 = ra.g1; titem_load(tc, ra, dummy, lane); titem_emit(ta, g0, g1, scr, lane); }
            { titem_lds_write(rb, scr, lane); const f32x4 g0 = rb.g0, g1 = rb.g1; titem_load(td, rb, dummy, lane); titem_emit(tb, g0, g1, scr, lane); }
            ta = tc; tb = td;
        }
        asm volatile("s_waitcnt vmcnt(0)" ::: "memory");
    }
    if (!misc) return;
    bf16* XB = (bf16*)(ws + WS_XB); u64* ssq_x = (u64*)(ws + ST_OFF);
    for (int m = gw; m < M; m += NGW) {
        const float* xrow = m < MP ? a.in[0] + (size_t)m * D : a.in[1] + (size_t)(m - MP) * D;
        const GAS f32x4* xr = (const GAS f32x4*)xrow + lane; GAS v2u* o8 = (GAS v2u*)(XB + (size_t)m * D) + lane; float ss = 0.f;
#pragma unroll 4
        for (int j = 0; j < 16; ++j) { const f32x4 v = xr[64 * j]; ss += (v.x * v.x + v.y * v.y) + (v.z * v.z + v.w * v.w); v2u o; o.x = pk2(v.x, v.y); o.y = pk2(v.z, v.w); o8[64 * j] = o; }
        ss = wave_sum(ss);
        if (lane == 0) ssq_x[m] = (u64)(ss * pg8::FIX_SCALE);
    }
    const int gt = gw * 64 + lane, NT = NGW * 64;
    bf16* KB = (bf16*)(ws + WS_KB); bf16* VB = (bf16*)(ws + WS_VB); bf16* WSB = (bf16*)(ws + WS_WSB);
    for (int i = gt; i < 65536; i += NT) {
        const int e = i * 8, b = e >> 16, t = (e >> 9) & 127, c = e & 511; const size_t dst = (size_t)(8192 + 160 * b + t) * 512 + c;
        { const f32x4 v0 = *(const f32x4*)(a.in[2] + e), v1 = *(const f32x4*)(a.in[2] + e + 4); v4u o; o.x = pk2(v0.x, v0.y); o.y = pk2(v0.z, v0.w); o.z = pk2(v1.x, v1.y); o.w = pk2(v1.z, v1.w); *(v4u*)(KB + dst) = o; }
        { const f32x4 v0 = *(const f32x4*)(a.in[3] + e), v1 = *(const f32x4*)(a.in[3] + e + 4); v4u o; o.x = pk2(v0.x, v0.y); o.y = pk2(v0.z, v0.w); o.z = pk2(v1.x, v1.y); o.w = pk2(v1.z, v1.w); *(v4u*)(VB + dst) = o; }
    }
    for (int i = gt; i < 16384; i += NT) {
        const int e = i * 8, ii = (e >> 7) & 127, j = e & 127; const bool keep = (ii >> 6) >= (j >> 6);
        const f32x4 v0 = *(const f32x4*)(a.in[8] + e), v1 = *(const f32x4*)(a.in[8] + e + 4); v4u o = {0u, 0u, 0u, 0u};
        if (keep) { o.x = pk2(v0.x, v0.y); o.y = pk2(v0.z, v0.w); o.z = pk2(v1.x, v1.y); o.w = pk2(v1.z, v1.w); }
        *(v4u*)(WSB + e) = o;
    }
}

__device__ __forceinline__ void sgu_phase(LAS unsigned char* lds, const bf16* UV, const bf16* WSB, const u64* lnsum, const u64* lnssq, const float* ln_g, const float* ln_b,
                                          const float* b_s, bf16* Z, float* out_sguv, int wave, int lane) {
    const int fr = lane & 15, fq = lane >> 4;
    LAS unsigned char* img = lds + wave * 17408;
    for (int uidx = blockIdx.x; uidx < 576; uidx += gridDim.x) {
        const bool samp = uidx >= 512;
        const int g = uidx & 7, chunk = samp ? ((uidx - 512) >> 3) : (uidx >> 3);
        const int row_base = samp ? MP + 32 * chunk : 128 * chunk, nrows = samp ? 32 : 128;
        const int cw = 512 * g + 64 * wave;
        {
            const int cp = lane & 7, c = cw + 8 * cp;
            const f32x4 g0 = *(const f32x4*)(ln_g + c), g1 = *(const f32x4*)(ln_g + c + 4), b0 = *(const f32x4*)(ln_b + c), b1 = *(const f32x4*)(ln_b + c + 4);
            for (int it = 0; it < nrows / 8; ++it) {
                const int j = it * 8 + (lane >> 3), row = row_base + j;
                const v4u raw = *(const v4u*)(UV + (size_t)row * NSGU + D + c);
                const float mean = (float)(long long)lnsum[row] * (FIX_INV / 4096.0f), ex2 = (float)lnssq[row] * (FIX_INV / 4096.0f);
                const float rstd = rsqrtf(fmaxf(ex2 - mean * mean, 0.f) + 1e-5f);
                f32x4 x0 = {bflo(raw.x), bfhi(raw.x), bflo(raw.y), bfhi(raw.y)}, x1 = {bflo(raw.z), bfhi(raw.z), bflo(raw.w), bfhi(raw.w)};
                x0 = (x0 - mean) * rstd * g0 + b0; x1 = (x1 - mean) * rstd * g1 + b1;
                if (samp) { float* op = out_sguv + (size_t)(row - MP) * D + c; *(f32x4*)op = x0; *(f32x4*)(op + 4) = x1; }
                LAS unsigned short* wp = (LAS unsigned short*)(img + (8 * cp) * 272 + j * 2);
#pragma unroll
                for (int i = 0; i < 4; ++i) { wp[i * 136] = (unsigned short)f2bf(x0[i]); wp[(4 + i) * 136] = (unsigned short)f2bf(x1[i]); }
            }
        }
        LDS_WAIT(); asm volatile("" ::: "memory");
        const int nmt = nrows >> 4, kmax = nrows >> 5;
        bf16x8 bfr[4][4];
#pragma unroll
        for (int nt = 0; nt < 4; ++nt)
#pragma unroll
            for (int ks = 0; ks < 4; ++ks) bfr[nt][ks] = (ks < kmax) ? *(const LAS bf16x8*)(img + (16 * nt + fr) * 272 + (32 * ks + 8 * fq) * 2) : (bf16x8){0, 0, 0, 0, 0, 0, 0, 0};
        const bf16* Wg = WSB + g * 16384;
        for (int mt = 0; mt < nmt; ++mt) {
            bf16x8 af[4];
#pragma unroll
            for (int ks = 0; ks < 4; ++ks) af[ks] = (ks < kmax) ? *(const bf16x8*)(Wg + (16 * mt + fr) * 128 + 32 * ks + 8 * fq) : (bf16x8){0, 0, 0, 0, 0, 0, 0, 0};
            f32x4 acc[4];
#pragma unroll
            for (int nt = 0; nt < 4; ++nt) acc[nt] = (f32x4){0.f, 0.f, 0.f, 0.f};
#pragma unroll
            for (int ks = 0; ks < 4; ++ks)
                if (ks < kmax) {
#pragma unroll
                    for (int nt = 0; nt < 4; ++nt) acc[nt] = __builtin_amdgcn_mfma_f32_16x16x32_bf16(bfr[nt][ks], af[ks], acc[nt], 0, 0, 0);
                }
            const int i = 16 * mt + fr; const float bias = b_s[g * 128 + i]; const size_t ro = (size_t)(row_base + i);
#pragma unroll
            for (int nt = 0; nt < 4; ++nt) {
                const int c = cw + 16 * nt + 4 * fq; const v2u uu = *(const v2u*)(UV + ro * NSGU + c);
                f32x4 z = {bflo(uu.x), bfhi(uu.x), bflo(uu.y), bfhi(uu.y)};
                { const pg8::f32x2 ga = pg8::gelu_pk((pg8::f32x2){z[0], z[1]}), gb = pg8::gelu_pk((pg8::f32x2){z[2], z[3]}); z = (f32x4){ga.x, ga.y, gb.x, gb.y}; }
                z = z * (acc[nt] + bias);
                v2u o; o.x = pk2(z[0], z[1]); o.y = pk2(z[2], z[3]); *(v2u*)(Z + ro * D + c) = o;
            }
        }
        LDS_WAIT(); asm volatile("" ::: "memory");
    }
}

__device__ __forceinline__ void attn_phase(LAS unsigned char* lds, const bf16* Q, const bf16* KB, const bf16* VB, const float* sinks, bf16* O, int tid, int wave, int lane) {
    const int fr = lane & 15, fq = lane >> 4;
    LAS unsigned char* Ks = lds; LAS unsigned char* Vt = lds + 27648;
    constexpr float LOG2E = 1.4426950408889634f;
    for (int uidx = blockIdx.x; uidx < 1088; uidx += gridDim.x) {
        int kvh, qbase, kbase, klo, khi, nmt;
        if (uidx < 1024) { kvh = uidx & 7; const int bc = uidx >> 3, c = bc & 63; qbase = bc * 64; kbase = qbase - 128; klo = c >= 2 ? 0 : (2 - c) * 64; khi = 192; nmt = 4; }
        else { const int s = uidx - 1024; kvh = s & 7; const int b = s >> 3; qbase = MP + 32 * b; kbase = MP + 160 * b; klo = 0; khi = 160; nmt = 2; }
        __syncthreads();
#pragma unroll
        for (int it = 0; it < 3; ++it) {
            const int p = tid + 512 * it, key = p >> 3, ch = p & 7;
            v4u kk = {0u, 0u, 0u, 0u}, vv = {0u, 0u, 0u, 0u};
            if (key >= klo && key < khi) { const size_t off = (size_t)(kbase + key) * 512 + kvh * 64 + ch * 8; kk = *(const v4u*)(KB + off); vv = *(const v4u*)(VB + off); }
            *(LAS v4u*)(Ks + key * 144 + ch * 16) = kk;
            LAS unsigned short* vp = (LAS unsigned short*)(Vt + (ch * 8) * 392 + key * 2);
            vp[0 * 196] = (unsigned short)(vv.x & 0xffffu); vp[1 * 196] = (unsigned short)(vv.x >> 16); vp[2 * 196] = (unsigned short)(vv.y & 0xffffu); vp[3 * 196] = (unsigned short)(vv.y >> 16);
            vp[4 * 196] = (unsigned short)(vv.z & 0xffffu); vp[5 * 196] = (unsigned short)(vv.z >> 16); vp[6 * 196] = (unsigned short)(vv.w & 0xffffu); vp[7 * 196] = (unsigned short)(vv.w >> 16);
        }
        __syncthreads();
        const int head = kvh * 8 + wave; const float sink = sinks[head];
        for (int mt = 0; mt < nmt; ++mt) {
            const int qrow = qbase + 16 * mt + fr;
            const bf16* qp = Q + (size_t)qrow * D + head * 64 + 8 * fq;
            const bf16x8 q0 = *(const bf16x8*)qp, q1 = *(const bf16x8*)(qp + 32);
            f32x4 s[12]; float mx = sink;
#pragma unroll
            for (int nt = 0; nt < 12; ++nt) {
                const LAS unsigned char* kp = Ks + (16 * nt + fr) * 144 + fq * 16;
                const bf16x8 k0 = *(const LAS bf16x8*)kp, k1 = *(const LAS bf16x8*)(kp + 64);
                f32x4 a = {0.f, 0.f, 0.f, 0.f};
                a = __builtin_amdgcn_mfma_f32_16x16x32_bf16(k0, q0, a, 0, 0, 0);
                a = __builtin_amdgcn_mfma_f32_16x16x32_bf16(k1, q1, a, 0, 0, 0);
                if (16 * nt < klo || 16 * nt >= khi) a = (f32x4){-1e30f, -1e30f, -1e30f, -1e30f};
                s[nt] = a; mx = fmaxf(mx, fmaxf(fmaxf(a[0], a[1]), fmaxf(a[2], a[3])));
            }
            mx = fmaxf(mx, __shfl_xor(mx, 16)); mx = fmaxf(mx, __shfl_xor(mx, 32));
            float l = 0.f;
#pragma unroll
            for (int nt = 0; nt < 12; ++nt) {
#pragma unroll
                for (int i = 0; i < 4; ++i) { const float e = __builtin_amdgcn_exp2f((s[nt][i] - mx) * LOG2E); s[nt][i] = e; l += e; }
            }
            l += __shfl_xor(l, 16); l += __shfl_xor(l, 32); l += __builtin_amdgcn_exp2f((sink - mx) * LOG2E);
            f32x4 o[4];
#pragma unroll
            for (int dt = 0; dt < 4; ++dt) o[dt] = (f32x4){0.f, 0.f, 0.f, 0.f};
#pragma unroll
            for (int s6 = 0; s6 < 6; ++s6) {
                const pg8::u32x4 pw = pg8::pack8(s[2 * s6], s[2 * s6 + 1]); const bf16x8 pf = __builtin_bit_cast(bf16x8, pw);
#pragma unroll
                for (int dt = 0; dt < 4; ++dt) {
                    const LAS unsigned char* vp = Vt + (16 * dt + fr) * 392 + (32 * s6 + 4 * fq) * 2;
                    const v2u lo = *(const LAS v2u*)vp, hi = *(const LAS v2u*)(vp + 32);
                    const v4u vw = {lo.x, lo.y, hi.x, hi.y};
                    o[dt] = __builtin_amdgcn_mfma_f32_16x16x32_bf16(__builtin_bit_cast(bf16x8, vw), pf, o[dt], 0, 0, 0);
                }
            }
            const float inv = 1.0f / l; bf16* op = O + (size_t)qrow * D + head * 64 + 4 * fq;
#pragma unroll
            for (int dt = 0; dt < 4; ++dt) { v2u w; w.x = pg8::cvt_pk_bf16(o[dt][0] * inv, o[dt][1] * inv); w.y = pg8::cvt_pk_bf16(o[dt][2] * inv, o[dt][3] * inv); *(v2u*)(op + 16 * dt) = w; }
        }
    }
}

template <class Epi>
__device__ __forceinline__ void tail_phase(LAS unsigned char* lds, const bf16* A, const bf16* Bt, int K, int nN, int pn_off, unsigned* qhead, const Epi& E, int tid, int wave, int lane) {
    constexpr int PITCH = 528, OPB = 64 * PITCH, BUFB = 2 * OPB;
    const int fr = lane & 15, fq = lane >> 4;
    const int nc = K >> 8;
    LAS float* part = (LAS float*)(lds + wave * 17408);
    const int row_l = tid >> 3, cg = tid & 7;
    const int colA = Epi::TAIL_SPLIT ? 4 * cg : 8 * cg, colB = Epi::TAIL_SPLIT ? 32 + 4 * cg : 8 * cg + 4;
    const int lr = tid >> 5, lc = tid & 31;
    volatile LAS unsigned* tick = (volatile LAS unsigned*)(lds + MISC_OFF + 64);
    const int cnt = nN * 2;
    int xq = (int)(xb_xcc_id() & 7u), tries = 0;
    unsigned nextj = 0u;
    if (tid == 0) nextj = __hip_atomic_fetch_add(qhead + 16 * xq, 1u, __ATOMIC_RELAXED, __HIP_MEMORY_SCOPE_AGENT);
    for (;;) {
        if (tid == 0) tick[0] = nextj;
        __syncthreads();
        const int j = (int)tick[0];
        __syncthreads();
        if (j >= cnt) { if (++tries == 8) break; xq = (xq + 1) & 7; if (tid == 0) nextj = __hip_atomic_fetch_add(qhead + 16 * xq, 1u, __ATOMIC_RELAXED, __HIP_MEMORY_SCOPE_AGENT); continue; }
        tries = 0;
        if (tid == 0) nextj = __hip_atomic_fetch_add(qhead + 16 * xq, 1u, __ATOMIC_RELAXED, __HIP_MEMORY_SCOPE_AGENT);
        const int p = ((8 * (j >> 2) + xq) << 2) + (j & 3) + 16 * pn_off;
        const int rq = p & 3, q = (p >> 2) & 3, pn = p >> 4;
        pg8::f32x4 acc[4][4];
#pragma unroll
        for (int nb = 0; nb < 4; ++nb)
#pragma unroll
            for (int mb = 0; mb < 4; ++mb) acc[nb][mb] = (pg8::f32x4){0.f, 0.f, 0.f, 0.f};
        const bf16* ag = A + (size_t)(MP + 64 * rq + lr) * K + 8 * lc;
        const bf16* bg = Bt + (size_t)(256 * pn + 32 * q + (lr & 31)) * K + 8 * lc;
        v4u a0[4], b0[4], a1[4], b1[4];
#define TL_LOAD(ra, rb, c) do { const int cc_ = (c) < nc ? (c) : nc - 1; const size_t ko_ = (size_t)256 * cc_; _Pragma("unroll") for (int i = 0; i < 4; ++i) { \
            ra[i] = *(const v4u*)(ag + (size_t)(16 * i) * K + ko_); rb[i] = *(const v4u*)(bg + (size_t)(16 * (i & 1) + 128 * (i >> 1)) * K + ko_); } } while (0)
#define TL_WRITE(ra, rb, b) do { LAS unsigned char* d_ = lds + (b) * BUFB + lr * PITCH + lc * 16; _Pragma("unroll") for (int i = 0; i < 4; ++i) { \
            *(LAS v4u*)(d_ + 16 * i * PITCH) = ra[i]; *(LAS v4u*)(d_ + OPB + 16 * i * PITCH) = rb[i]; } } while (0)
#define TL_BAR() do { asm volatile("s_waitcnt lgkmcnt(0)" ::: "memory"); __builtin_amdgcn_s_barrier(); asm volatile("" ::: "memory"); } while (0)
#define TL_STEP(c, la, lb, wa, wb) do { TL_LOAD(la, lb, (c) + 2); TL_BAR(); \
            const LAS unsigned char* fb = lds + ((c) & 1) * BUFB + fr * PITCH + (32 * wave + 8 * fq) * 2; bf16x8 fa[4], fbv[4]; \
            _Pragma("unroll") for (int i = 0; i < 4; ++i) { fa[i] = *(const LAS bf16x8*)(fb + 16 * i * PITCH); fbv[i] = *(const LAS bf16x8*)(fb + OPB + 16 * i * PITCH); } \
            _Pragma("unroll") for (int nb = 0; nb < 4; ++nb) _Pragma("unroll") for (int mb = 0; mb < 4; ++mb) acc[nb][mb] = __builtin_amdgcn_mfma_f32_16x16x32_bf16(fbv[nb], fa[mb], acc[nb][mb], 0, 0, 0); \
            TL_WRITE(wa, wb, ((c) + 1) & 1); } while (0)
        TL_LOAD(a0, b0, 0); TL_LOAD(a1, b1, 1); TL_WRITE(a0, b0, 0);
        int c = 0;
        for (; c + 1 < nc; c += 2) { TL_STEP(c, a0, b0, a1, b1); TL_STEP(c + 1, a1, b1, a0, b0); }
        if (c < nc) TL_STEP(c, a0, b0, a1, b1);
#undef TL_STEP
#undef TL_BAR
#undef TL_LOAD
#undef TL_WRITE
        asm volatile("s_waitcnt vmcnt(0)" ::: "memory"); __syncthreads();
#pragma unroll
        for (int nb = 0; nb < 4; ++nb)
#pragma unroll
            for (int mb = 0; mb < 4; ++mb) *(LAS pg8::f32x4*)(part + (16 * mb + fr) * 68 + 16 * nb + 4 * fq) = acc[nb][mb];
        __syncthreads();
        pg8::f32x4 v0 = {0.f, 0.f, 0.f, 0.f}, v1 = {0.f, 0.f, 0.f, 0.f};
#pragma unroll
        for (int w = 0; w < 8; ++w) { const LAS float* t = (const LAS float*)(lds + w * 17408) + row_l * 68; v0 += *(const LAS pg8::f32x4*)(t + colA); v1 += *(const LAS pg8::f32x4*)(t + colB); }
        E.tail(MP + 64 * rq + row_l, cg, pn, q, v0, v1);
        __syncthreads();
    }
}

#ifndef NCONV
#define NCONV 80
#endif
#ifndef SAMPLE_MAIN_GU
#define SAMPLE_MAIN_GU 64
#endif
__global__ void __launch_bounds__(NWAVES * 64, 2) yoco_fwd(Args args) {
    extern __shared__ __attribute__((aligned(16))) unsigned char lds_raw[];
    LAS unsigned char* lds = (LAS unsigned char*)lds_raw;
    const int tid = threadIdx.x, lane = tid & 63, wave = __builtin_amdgcn_readfirstlane(tid >> 6);
    const int G = gridDim.x, bx = blockIdx.x, vcu = (G % 8 == 0) ? (bx % 8) * (G / 8) + bx / 8 : bx;
    unsigned char* ws = args.ws;
    for (int u = tid; u < (LDS_BYTES - LDSCTL_OFF) / 4; u += NWAVES * 64) ((LAS unsigned*)(lds + LDSCTL_OFF))[u] = 0u;
    __syncthreads();
    volatile LAS unsigned* MISC = (volatile LAS unsigned*)(lds + MISC_OFF);
    XcdBarrier bar; bar.bar = (unsigned*)ws + CW_BAR; bar.x = 0; bar.st = nullptr;
    if (MK_ONE_LAUNCH) bar = xcd_barrier_post((unsigned*)ws + CW_BAR, MISC + 8);
    const int lo = args.ph_lo, hi = args.ph_hi;
#define IN(k) (lo <= (k) && (k) < hi)
#define SEAM(k) do { if (MK_ONE_LAUNCH && IN((k) + 1)) xcd_barrier(bar); } while (0)
    bf16* const W1T = (bf16*)(ws + WS_W1T); bf16* const W2T = (bf16*)(ws + WS_W2T); bf16* const WGU0 = (bf16*)(ws + WS_WGU0); bf16* const WD0 = (bf16*)(ws + WS_WD0);
    bf16* const WQKV = (bf16*)(ws + WS_WQKV); bf16* const WOT = (bf16*)(ws + WS_WOT); bf16* const WGU1 = (bf16*)(ws + WS_WGU1); bf16* const WD1 = (bf16*)(ws + WS_WD1);
    bf16* const XB = (bf16*)(ws + WS_XB); bf16* const ACT = (bf16*)(ws + WS_ACT); bf16* const UV = (bf16*)(ws + WS_ACT);
    bf16* const ZQ = (bf16*)(ws + WS_ZQ); bf16* const OB = (bf16*)(ws + WS_O); bf16* const KB = (bf16*)(ws + WS_KB); bf16* const VB = (bf16*)(ws + WS_VB); bf16* const WSB = (bf16*)(ws + WS_WSB);
    unsigned* const qheads = (unsigned*)ws + CW_Q;
    u64* const ssq_x = (u64*)(ws + ST_OFF); u64* const lnsum = (u64*)(ws + ST_OFF + ST_STRIDE); u64* const lnssq = (u64*)(ws + ST_OFF + 2 * ST_STRIDE);
    u64* const ssq_h1 = (u64*)(ws + ST_OFF + 3 * ST_STRIDE); u64* const ssq_h2 = (u64*)(ws + ST_OFF + 4 * ST_STRIDE); u64* const ssq_h3 = (u64*)(ws + ST_OFF + 5 * ST_STRIDE);

    const bool split = (G == 256) && (NCONV > 0);
    const int nconv = split ? NCONV : 0, ncomp = G - nconv;
    if (IN(0)) { p0_prologue(args, ws, lds, vcu * NWAVES + wave, G * NWAVES, 0, split ? P0_ITEMS_A : P0_ITEMS_ALL, 1, wave, lane); SEAM(0); }
    if (IN(1)) {
        if (bx >= ncomp) { p0_prologue(args, ws, lds, (bx - ncomp) * NWAVES + wave, nconv * NWAVES, P0_ITEMS_A, P0_ITEMS_ALL, 0, wave, lane); __syncthreads(); }
        pg8::Gemm g{XB, W1T, MP, NSGU, D}; pg8::SplitOrder S; S.init(MP, NSGU, G, bx); S.nblk = ncomp; S.nhalf = 16;
        pg8::EpiSguIn E{UV, ssq_x, lnsum, lnssq};
        pg8::gemm_phase<pg8::EpiSguIn, pg8::SplitOrder, PG8_ALIGN, PG8_SP2>(lds, g, S, E);
        tail_phase(lds, XB, W1T, D, 32, 0, qheads + 0 * 128, E, tid, wave, lane);
        SEAM(1);
    }
    if (IN(2)) { sgu_phase(lds, UV, WSB, lnsum, lnssq, args.in[6], args.in[7], args.in[9], ZQ, args.out + pg8::OUT_SGUV, wave, lane); SEAM(2); }
    if (IN(3)) {
        pg8::Gemm g{ZQ, W2T, MP, D, D}; pg8::StaticOrder S; S.init(MP, D, G, bx);
        pg8::EpiRes<false, true, false> E{nullptr, nullptr, nullptr, XB, ssq_h1};
        pg8::gemm_phase<pg8::EpiRes<false, true, false>, pg8::StaticOrder, PG8_ALIGN, PG8_SP2>(lds, g, S, E);
        tail_phase(lds, ZQ, W2T, D, 16, 0, qheads + 1 * 128, E, tid, wave, lane);
        SEAM(3);
    }
    if (IN(4)) {
        pg8::Gemm g{XB, WGU0, M, NGU, D}; pg8::ExtOrder S; S.init(MP, NGU, G, bx); S.nextra = SAMPLE_MAIN_GU;
        pg8::EpiSwiglu E{ACT, ssq_h1};
        pg8::gemm_phase<pg8::EpiSwiglu, pg8::ExtOrder, PG8_ALIGN, PG8_SP2>(lds, g, S, E);
        tail_phase(lds, XB, WGU0, D, 86 - SAMPLE_MAIN_GU, SAMPLE_MAIN_GU, qheads + 2 * 128, E, tid, wave, lane);
        SEAM(4);
    }
    if (IN(5)) {
        pg8::Gemm g{ACT, WD0, MP, D, DFF}; pg8::PanelOrder S; S.init(MP, D, G, bx);
        pg8::EpiRes<false, true, false> E{nullptr, nullptr, nullptr, XB, ssq_h2};
        pg8::gemm_phase<pg8::EpiRes<false, true, false>, pg8::PanelOrder, PG8_ALIGN, PG8_SP2>(lds, g, S, E);
        tail_phase(lds, ACT, WD0, DFF, 16, 0, qheads + 3 * 128, E, tid, wave, lane);
        SEAM(5);
    }
    if (IN(6)) {
        pg8::Gemm g{XB, WQKV, MP, NQKV, D}; pg8::StaticOrder S; S.init(MP, NQKV, G, bx);
        pg8::EpiQKV E{KB, VB, ZQ, args.out, ssq_h2, args.in[13], args.in[16]};
        pg8::gemm_phase<pg8::EpiQKV, pg8::StaticOrder, PG8_ALIGN, PG8_SP2>(lds, g, S, E);
        tail_phase(lds, XB, WQKV, D, 20, 0, qheads + 4 * 128, E, tid, wave, lane);
        SEAM(6);
    }
    if (IN(7)) { attn_phase(lds, ZQ, KB, VB, args.in[17], OB, tid, wave, lane); SEAM(7); }
    if (IN(8)) {
        pg8::Gemm g{OB, WOT, MP, D, D}; pg8::StaticOrder S; S.init(MP, D, G, bx);
        pg8::EpiRes<false, true, false> E{nullptr, nullptr, nullptr, XB, ssq_h3};
        pg8::gemm_phase<pg8::EpiRes<false, true, false>, pg8::StaticOrder, PG8_ALIGN, PG8_SP2>(lds, g, S, E);
        tail_phase(lds, OB, WOT, D, 16, 0, qheads + 5 * 128, E, tid, wave, lane);
        SEAM(8);
    }
    if (IN(9)) {
        pg8::Gemm g{XB, WGU1, M, NGU, D}; pg8::ExtOrder S; S.init(MP, NGU, G, bx); S.nextra = SAMPLE_MAIN_GU;
        pg8::EpiSwiglu E{ACT, ssq_h3};
        pg8::gemm_phase<pg8::EpiSwiglu, pg8::ExtOrder, PG8_ALIGN, PG8_SP2>(lds, g, S, E);
        tail_phase(lds, XB, WGU1, D, 86 - SAMPLE_MAIN_GU, SAMPLE_MAIN_GU, qheads + 6 * 128, E, tid, wave, lane);
        SEAM(9);
    }
    if (IN(10)) {
        pg8::Gemm g{ACT, WD1, MP, D, DFF}; pg8::PanelOrder S; S.init(MP, D, G, bx);
        pg8::EpiRes<false, false, true> E{nullptr, nullptr, args.out, XB, nullptr};
        pg8::gemm_phase<pg8::EpiRes<false, false, true>, pg8::PanelOrder, PG8_ALIGN, PG8_SP2>(lds, g, S, E);
        tail_phase(lds, ACT, WD1, DFF, 16, 0, qheads + 7 * 128, E, tid, wave, lane);
    }
#undef IN
#undef SEAM
}

extern "C" void kernel_launch(void* const* d_in, const int* in_sizes, int n_in, void* d_out, int out_size, void* d_ws, size_t ws_size, hipStream_t stream) {
    static int grid = 0;
    if (grid == 0) {
        if (n_in != 23 || in_sizes[0] != MP * D || out_size != 36175872 || ws_size < WS_END) {
            fprintf(stderr, "kernel_launch: unexpected shapes (n_in %d, in0 %d, out %d, ws %zu); nothing launched\n", n_in, n_in > 0 ? in_sizes[0] : -1, out_size, ws_size); grid = -1; return; }
        int dev = 0, cus = 0, per_cu = 0;
        if (hipGetDevice(&dev) != hipSuccess || hipDeviceGetAttribute(&cus, hipDeviceAttributeMultiprocessorCount, dev) != hipSuccess) { fprintf(stderr, "kernel_launch: device query failed\n"); grid = -1; return; }
        if (hipFuncSetAttribute((const void*)yoco_fwd, hipFuncAttributeMaxDynamicSharedMemorySize, LDS_BYTES) != hipSuccess) { fprintf(stderr, "kernel_launch: hipFuncSetAttribute failed\n"); grid = -1; return; }
        if (hipOccupancyMaxActiveBlocksPerMultiprocessor(&per_cu, (const void*)yoco_fwd, NWAVES * 64, LDS_BYTES) != hipSuccess || per_cu < 1)
            fprintf(stderr, "kernel_launch: note: occupancy query reports %d workgroups per CU\n", per_cu);
        (void)hipGetLastError();
        grid = cus;
    }
    if (grid < 0) return;
    if (hipMemsetAsync((char*)d_ws + WS_CTL, 0, CTL_ZERO_BYTES, stream) != hipSuccess) { fprintf(stderr, "kernel_launch: memset failed\n"); return; }
    Args a{};
    for (int i = 0; i < 23; ++i) a.in[i] = (const float*)d_in[i];
    a.out = (float*)d_out; a.ws = (unsigned char*)d_ws;
#if MK_ONE_LAUNCH
    a.ph_lo = 0; a.ph_hi = NPHASES;
    hipLaunchKernelGGL(yoco_fwd, dim3(grid), dim3(NWAVES * 64), LDS_BYTES, stream, a);
#else
    for (int p = 0; p < NPHASES; ++p) { a.ph_lo = p; a.ph_hi = p + 1; hipLaunchKernelGGL(yoco_fwd, dim3(grid), dim3(NWAVES * 64), LDS_BYTES, stream, a); }
#endif
    const hipError_t le = hipPeekAtLastError();
    if (le != hipSuccess) fprintf(stderr, "kernel_launch: launch failed: %s\n", hipGetErrorName(le));
}
```

```cpp
#include <hip/hip_runtime.h>
#include <cstdio>
#include <cstdint>
#define MK_ONE_LAUNCH 1
namespace pg8 {
#define PG8_LAS __attribute__((address_space(3)))
typedef unsigned short bf16_t;
typedef short bf16x8 __attribute__((ext_vector_type(8)));
typedef float f32x4 __attribute__((ext_vector_type(4)));
typedef unsigned u32x4 __attribute__((ext_vector_type(4)));
constexpr int BM = 256, BK = 64, HALF = 128, HTB = HALF * BK * 2  , STAGE_BYTES = 8 * HTB, NXCD = 8, WGM = 8;

__host__ __device__ __forceinline__ int lds_byte(int r, int c) { const int st = (r >> 4) * 2 + (c >> 5), rr = r & 15, cc = c & 31, ob = rr * 64 + cc * 2; return st * 1024 + (ob ^ (((ob >> 9) & 1) << 5)); }
__host__ __device__ __forceinline__ void stage_rc(int b, int& R, int& C) { const int st = b / 1024, sb = b % 1024, swz = sb ^ (((sb >> 9) & 1) << 5); R = (st >> 1) * 16 + swz / 64; C = (st & 1) * 32 + (swz % 64) / 2; }
__host__ __device__ __forceinline__ int perm32(int rho) { const int n = rho >> 4, i = rho & 15; return 8 * (i >> 2) + 4 * n + (i & 3); }

struct Unit { int pm, pn; };
struct Gemm { const bf16_t* A; const bf16_t* Bt; int M, N, K; };

struct StaticOrder {
    int nM, nN, nwg, G, c;
    __host__ __device__ void init(int M, int N, int G_, int c_) { nM = M / BM; nN = N / BM; nwg = nM * nN; G = G_; c = c_; }
    __host__ __device__ bool next(int i, Unit& u) const {
        const long L = (long)i * G + c; if (L >= nwg) return false;
        int wgid = (int)L; { const int q = nwg / NXCD, r = nwg % NXCD, xcd = wgid % NXCD, off = wgid / NXCD; wgid = (xcd < r ? xcd * (q + 1) : r * (q + 1) + (xcd - r) * q) + off; }
        const int nig = WGM * nN, gid = wgid / nig, fm = gid * WGM, gsz = (nM - fm) < WGM ? (nM - fm) : WGM;
        u.pm = fm + ((wgid % nig) % gsz); u.pn = (wgid % nig) / gsz; return true;
    }
    __device__ __forceinline__ void a_ready(const Unit&) const {}
    __device__ __forceinline__ void done(const Unit&) const {}
};

__device__ __forceinline__ unsigned cvt_pk_bf16(float lo, float hi) { unsigned r; asm volatile("v_cvt_pk_bf16_f32 %0, %1, %2" : "=v"(r) : "v"(lo), "v"(hi)); return r; }
typedef float f32x2 __attribute__((ext_vector_type(2)));
__device__ __forceinline__ f32x2 gelu_pk(f32x2 v) {
    const f32x2 av = __builtin_elementwise_abs(v), d = av * 0.2316418882f + 1.0f;
    f32x2 t; t.x = __builtin_amdgcn_rcpf(d.x); t.y = __builtin_amdgcn_rcpf(d.y);
    f32x2 q = t * 0.5307027145f + (-0.7265760135f); q = q * t + 0.7107068705f; q = q * t + (-0.142248368f); q = q * t + 0.127414796f; q = q * t;
    const f32x2 s = (v * v) * (-0.72134752044f);
    f32x2 e; e.x = __builtin_amdgcn_exp2f(s.x); e.y = __builtin_amdgcn_exp2f(s.y);
    const f32x2 m = v * (q * e), r = v - m;
    f32x2 o; o.x = v.x < 0.f ? m.x : r.x; o.y = v.y < 0.f ? m.y : r.y; return o;
}


struct SplitOrder : StaticOrder {
    int nblk; int nhalf;
    __device__ bool next(int i, Unit& u) const {
        if (c >= nblk) return false;
        const long L = (long)i * nblk + c; if (L >= nwg) return false;
        int wgid = (int)L; { const int q = nwg / NXCD, r = nwg % NXCD, xcd = wgid % NXCD, off = wgid / NXCD; wgid = (xcd < r ? xcd * (q + 1) : r * (q + 1) + (xcd - r) * q) + off; }
        const int nig = WGM * nN, gid = wgid / nig, fm = gid * WGM, gsz = (nM - fm) < WGM ? (nM - fm) : WGM;
        u.pm = fm + ((wgid % nig) % gsz); u.pn = (wgid % nig) / gsz; if (nhalf) u.pn = (u.pn & 1) * nhalf + (u.pn >> 1); return true;
    }
};
struct ExtOrder : StaticOrder {
    int nextra;
    __device__ bool next(int i, Unit& u) const {
        const long L = (long)i * G + c;
        if (L < nwg) return StaticOrder::next(i, u);
        if (L < nwg + nextra) { u.pm = 32; u.pn = (int)(L - nwg); return true; }
        return false;
    }
};
typedef unsigned long long u64;
constexpr float FIX_SCALE = 16777216.0f, FIX_INV = 1.0f / 16777216.0f;
__device__ __forceinline__ u64 f2fixu(float v) { return (u64)(v * FIX_SCALE); }
__device__ __forceinline__ u64 f2fixs(float v) { return (u64)(long long)(v * FIX_SCALE); }
__device__ __forceinline__ void fix_add(u64* p, u64 v) { (void)__hip_atomic_fetch_add(p, v, __ATOMIC_RELAXED, __HIP_MEMORY_SCOPE_AGENT); }
__device__ __forceinline__ float rstd_of(const u64* ssq, int row) { return rsqrtf((float)ssq[row] * (FIX_INV * (1.0f / 4096.0f)) + 1e-6f); }
__device__ __forceinline__ float sum4(const f32x4& v) { return (v[0] + v[1]) + (v[2] + v[3]); }
__device__ __forceinline__ float ssq4(const f32x4& v) { return (v[0] * v[0] + v[1] * v[1]) + (v[2] * v[2] + v[3] * v[3]); }
__device__ __forceinline__ u32x4 pack8(const f32x4& a, const f32x4& b) { u32x4 w; w.x = cvt_pk_bf16(a[0], a[1]); w.y = cvt_pk_bf16(a[2], a[3]); w.z = cvt_pk_bf16(b[0], b[1]); w.w = cvt_pk_bf16(b[2], b[3]); return w; }

struct EpiSguIn {
    typedef f32x4 AccT;
    static constexpr bool PERM = true, AFTER_DRAIN = false;
    bf16_t* UV; const u64* ssq; u64* lnsum; u64* lnssq;
    __device__ __forceinline__ void operator()(const f32x4 (&acc)[2][2][4][2], const Unit& u, int wr, int wc, int fr, int fq) const {
        const int row0 = u.pm * BM + wr * 64 + fr, col0 = u.pn * BM + wc * 32 + 8 * fq;
        const bool isv = u.pn >= 16;
        float rs[2][4];
#pragma unroll
        for (int ai = 0; ai < 2; ++ai)
#pragma unroll
            for (int m = 0; m < 4; ++m) rs[ai][m] = rstd_of(ssq, row0 + ai * HALF + m * 16);
#pragma unroll
        for (int ai = 0; ai < 2; ++ai)
#pragma unroll
            for (int m = 0; m < 4; ++m) {
                const int row = row0 + ai * HALF + m * 16;
                float s1 = 0.f, s2 = 0.f;
                bf16_t* rowp = UV + (size_t)row * 8192 + col0;
#pragma unroll
                for (int bj = 0; bj < 2; ++bj) {
                    f32x4 v0 = acc[ai][bj][m][0] * rs[ai][m], v1 = acc[ai][bj][m][1] * rs[ai][m];
                    if (isv) {
                        const f32x2 a = gelu_pk((f32x2){v0[0], v0[1]}), b = gelu_pk((f32x2){v0[2], v0[3]}), c = gelu_pk((f32x2){v1[0], v1[1]}), d = gelu_pk((f32x2){v1[2], v1[3]});
                        v0 = (f32x4){a.x, a.y, b.x, b.y}; v1 = (f32x4){c.x, c.y, d.x, d.y};
                        s1 += sum4(v0) + sum4(v1); s2 += ssq4(v0) + ssq4(v1); }
                    *(u32x4*)(rowp + bj * HALF) = pack8(v0, v1);
                }
                if (isv) {
                    s1 += __shfl_xor(s1, 16); s1 += __shfl_xor(s1, 32); s2 += __shfl_xor(s2, 16); s2 += __shfl_xor(s2, 32);
                    if (fq == 0) { fix_add(lnsum + row, f2fixs(s1)); fix_add(lnssq + row, f2fixu(s2)); }
                }
            }
    }
    static constexpr bool TAIL_SPLIT = false;
    __device__ __forceinline__ void tail(int row, int cg, int pn, int q, f32x4 v0, f32x4 v1) const {
        const int col = pn * BM + (cg >> 2) * HALF + q * 32 + 8 * (cg & 3);
        const float rs = rstd_of(ssq, row);
        v0 = v0 * rs; v1 = v1 * rs;
        if (pn >= 16) { const f32x2 a = gelu_pk((f32x2){v0[0], v0[1]}), b = gelu_pk((f32x2){v0[2], v0[3]}), c = gelu_pk((f32x2){v1[0], v1[1]}), d = gelu_pk((f32x2){v1[2], v1[3]});
            v0 = (f32x4){a.x, a.y, b.x, b.y}; v1 = (f32x4){c.x, c.y, d.x, d.y}; }
        *(u32x4*)(UV + (size_t)row * 8192 + col) = pack8(v0, v1);
        if (pn >= 16) {
            float s1 = sum4(v0) + sum4(v1), s2 = ssq4(v0) + ssq4(v1);
            s1 += __shfl_xor(s1, 1); s1 += __shfl_xor(s1, 2); s1 += __shfl_xor(s1, 4); s2 += __shfl_xor(s2, 1); s2 += __shfl_xor(s2, 2); s2 += __shfl_xor(s2, 4);
            if (cg == 0) { fix_add(lnsum + row, f2fixs(s1)); fix_add(lnssq + row, f2fixu(s2)); }
        }
    }
};
template <bool RES_F32, bool XBOUT, bool OUT_F32> struct EpiRes {
    typedef f32x4 AccT;
    static constexpr bool PERM = true, AFTER_DRAIN = false;
    const float* res; const float* res_hi; float* out; bf16_t* XB; u64* ssq_out;
    __device__ __forceinline__ static f32x4 lo4(const u32x4& w) { return (f32x4){__builtin_bit_cast(float, w.x << 16), __builtin_bit_cast(float, w.x & 0xffff0000u), __builtin_bit_cast(float, w.y << 16), __builtin_bit_cast(float, w.y & 0xffff0000u)}; }
    __device__ __forceinline__ static f32x4 hi4(const u32x4& w) { return (f32x4){__builtin_bit_cast(float, w.z << 16), __builtin_bit_cast(float, w.z & 0xffff0000u), __builtin_bit_cast(float, w.w << 16), __builtin_bit_cast(float, w.w & 0xffff0000u)}; }
    __device__ __forceinline__ void operator()(const f32x4 (&acc)[2][2][4][2], const Unit& u, int wr, int wc, int fr, int fq) const {
        const int row0 = u.pm * BM + wr * 64 + fr, col0 = u.pn * BM + wc * 32 + 8 * fq;
        const float* rbase = u.pm < 32 ? res : res_hi;
#pragma unroll
        for (int ai = 0; ai < 2; ++ai) {
            f32x4 r[4][2][2];
#pragma unroll
            for (int m = 0; m < 4; ++m) { const size_t off = (size_t)(row0 + ai * HALF + m * 16) * 4096 + col0;
#pragma unroll
                for (int bj = 0; bj < 2; ++bj) {
                    if (RES_F32) { r[m][bj][0] = *(const f32x4*)(rbase + off + bj * HALF); r[m][bj][1] = *(const f32x4*)(rbase + off + bj * HALF + 4); }
                    else { const u32x4 w = *(const u32x4*)(XB + off + bj * HALF); r[m][bj][0] = lo4(w); r[m][bj][1] = hi4(w); } } }
#pragma unroll
            for (int m = 0; m < 4; ++m) { const int row = row0 + ai * HALF + m * 16; const size_t off = (size_t)row * 4096 + col0; float ss = 0.f;
#pragma unroll
                for (int bj = 0; bj < 2; ++bj) { const f32x4 o0 = r[m][bj][0] + acc[ai][bj][m][0], o1 = r[m][bj][1] + acc[ai][bj][m][1];
                    if (OUT_F32) { *(f32x4*)(out + off + bj * HALF) = o0; *(f32x4*)(out + off + bj * HALF + 4) = o1; }
                    if (XBOUT) { *(u32x4*)(XB + off + bj * HALF) = pack8(o0, o1); ss += ssq4(o0) + ssq4(o1); } }
                if (XBOUT) { ss += __shfl_xor(ss, 16); ss += __shfl_xor(ss, 32); if (fq == 0) fix_add(ssq_out + row, f2fixu(ss)); } }
            asm volatile("" ::: "memory");
        }
    }
    static constexpr bool TAIL_SPLIT = false;
    __device__ __forceinline__ void tail(int row, int cg, int pn, int q, f32x4 v0, f32x4 v1) const {
        const size_t off = (size_t)row * 4096 + pn * BM + (cg >> 2) * HALF + q * 32 + 8 * (cg & 3);
        f32x4 r0, r1;
        if (RES_F32) { r0 = *(const f32x4*)(res_hi + off); r1 = *(const f32x4*)(res_hi + off + 4); }
        else { const u32x4 w = *(const u32x4*)(XB + off); r0 = lo4(w); r1 = hi4(w); }
        const f32x4 o0 = r0 + v0, o1 = r1 + v1;
        if (OUT_F32) { *(f32x4*)(out + off) = o0; *(f32x4*)(out + off + 4) = o1; }
        if (XBOUT) {
            *(u32x4*)(XB + off) = pack8(o0, o1);
            float ss = ssq4(o0) + ssq4(o1); ss += __shfl_xor(ss, 1); ss += __shfl_xor(ss, 2); ss += __shfl_xor(ss, 4);
            if (cg == 0) fix_add(ssq_out + row, f2fixu(ss));
        }
    }
};
struct EpiSwiglu {
    typedef f32x4 AccT;
    static constexpr bool PERM = true, AFTER_DRAIN = false;
    bf16_t* ACT; const u64* ssq;
    __device__ __forceinline__ void operator()(const f32x4 (&acc)[2][2][4][2], const Unit& u, int wr, int wc, int fr, int fq) const {
        const int row0 = u.pm * BM + wr * 64 + fr, col0 = u.pn * HALF + wc * 32 + 8 * fq;
        float rs[2][4];
#pragma unroll
        for (int ai = 0; ai < 2; ++ai)
#pragma unroll
            for (int m = 0; m < 4; ++m) rs[ai][m] = rstd_of(ssq, row0 + ai * HALF + m * 16);
#pragma unroll
        for (int ai = 0; ai < 2; ++ai)
#pragma unroll
            for (int m = 0; m < 4; ++m) {
                const int row = row0 + ai * HALF + m * 16; f32x4 o[2];
#pragma unroll
                for (int n = 0; n < 2; ++n) { const f32x4 g = acc[ai][0][m][n] * rs[ai][m], up = acc[ai][1][m][n] * rs[ai][m];
#pragma unroll
                    for (int j = 0; j < 4; ++j) o[n][j] = g[j] * __builtin_amdgcn_rcpf(1.0f + __builtin_amdgcn_exp2f(-1.44269504f * g[j])) * up[j]; }
                *(u32x4*)(ACT + (size_t)row * 11008 + col0) = pack8(o[0], o[1]);
            }
    }
    static constexpr bool TAIL_SPLIT = true;
    __device__ __forceinline__ void tail(int row, int cg, int pn, int q, f32x4 g, f32x4 up) const {
        const float rs = rstd_of(ssq, row);
        g = g * rs; up = up * rs; f32x4 o;
#pragma unroll
        for (int j = 0; j < 4; ++j) o[j] = g[j] * __builtin_amdgcn_rcpf(1.0f + __builtin_amdgcn_exp2f(-1.44269504f * g[j])) * up[j];
        typedef unsigned u32x2t __attribute__((ext_vector_type(2)));
        u32x2t w; w.x = cvt_pk_bf16(o[0], o[1]); w.y = cvt_pk_bf16(o[2], o[3]);
        *(u32x2t*)(ACT + (size_t)row * 11008 + pn * HALF + q * 32 + 4 * cg) = w;
    }
};

struct EpiSwigluI8 {
    typedef int i32x4 __attribute__((ext_vector_type(4)));
    typedef i32x4 AccT;
    static constexpr bool PERM = true, AFTER_DRAIN = false, TAIL_SPLIT = true;
    bf16_t* ACT; const float* rowscale; const float* colmax;
    __device__ __forceinline__ void operator()(const i32x4 (&acc)[2][2][4][2], const Unit& u, int wr, int wc, int fr, int fq) const {
        const int row0 = u.pm * BM + wr * 64 + fr, col0 = u.pn * HALF + wc * 32 + 8 * fq, bcol = u.pn * BM + wc * 32 + 8 * fq;
        f32x4 cw[2][2];
#pragma unroll
        for (int bj = 0; bj < 2; ++bj)
#pragma unroll
            for (int n = 0; n < 2; ++n) cw[bj][n] = *(const f32x4*)(colmax + bcol + bj * HALF + 4 * n) * (1.0f / 127.0f);
        float rs[2][4];
#pragma unroll
        for (int ai = 0; ai < 2; ++ai)
#pragma unroll
            for (int m = 0; m < 4; ++m) rs[ai][m] = rowscale[row0 + ai * HALF + m * 16];
#pragma unroll
        for (int ai = 0; ai < 2; ++ai)
#pragma unroll
            for (int m = 0; m < 4; ++m) {
                const int row = row0 + ai * HALF + m * 16; f32x4 o[2];
#pragma unroll
                for (int n = 0; n < 2; ++n) {
#pragma unroll
                    for (int j = 0; j < 4; ++j) { const float g = (float)acc[ai][0][m][n][j] * rs[ai][m] * cw[0][n][j], up = (float)acc[ai][1][m][n][j] * rs[ai][m] * cw[1][n][j];
                        o[n][j] = g * __builtin_amdgcn_rcpf(1.0f + __builtin_amdgcn_exp2f(-1.44269504f * g)) * up; } }
                *(u32x4*)(ACT + (size_t)row * 11008 + col0) = pack8(o[0], o[1]);
            }
    }
    __device__ __forceinline__ void tail(int, int, int, int, f32x4, f32x4) const {}
};
constexpr size_t OUT_KP = 34603008, OUT_VP = 34734080, OUT_KS = 34865152, OUT_VS = 34996224, OUT_SGUV = 35127296;
struct EpiQKV {
    typedef f32x4 AccT;
    static constexpr bool PERM = true, AFTER_DRAIN = false;
    bf16_t *KB, *VB, *QB; float* out; const u64* ssq; const float* kg; const float* qg;
    __device__ __forceinline__ void operator()(const f32x4 (&acc)[2][2][4][2], const Unit& u, int wr, int wc, int fr, int fq) const {
        const int row0 = u.pm * BM + wr * 64 + fr;
        const bool isk = u.pn < 2, isq = u.pn >= 4, isv = !isk && !isq;
        const int hidx = (isk ? u.pn : (isq ? u.pn - 4 : u.pn - 2)) * 4 + wc;
        bf16_t* const kvb = isk ? KB : VB; const size_t o_s = isk ? OUT_KS : OUT_VS, o_p = isk ? OUT_KP : OUT_VP;
        const float* gp = (u.pn < 2) ? kg : qg;
        f32x4 gv[2][2];
#pragma unroll
        for (int bj = 0; bj < 2; ++bj)
#pragma unroll
            for (int n = 0; n < 2; ++n) gv[bj][n] = *(const f32x4*)(gp + 32 * bj + 8 * fq + 4 * n);
        const float gs = isq ? 0.125f : 1.0f;
        float rs[2][4];
#pragma unroll
        for (int ai = 0; ai < 2; ++ai)
#pragma unroll
            for (int m = 0; m < 4; ++m) rs[ai][m] = rstd_of(ssq, row0 + ai * HALF + m * 16);
#pragma unroll
        for (int ai = 0; ai < 2; ++ai)
#pragma unroll
            for (int m = 0; m < 4; ++m) {
                const int row = row0 + ai * HALF + m * 16;
                f32x4 t[2][2]; float ss = 0.f;
#pragma unroll
                for (int bj = 0; bj < 2; ++bj)
#pragma unroll
                    for (int n = 0; n < 2; ++n) { t[bj][n] = acc[ai][bj][m][n] * rs[ai][m]; ss += ssq4(t[bj][n]); }
                if (!isv) {
                    ss += __shfl_xor(ss, 16); ss += __shfl_xor(ss, 32);
                    const float r = rsqrtf(ss * (1.0f / 64.0f) + 1e-6f) * gs;
#pragma unroll
                    for (int bj = 0; bj < 2; ++bj)
#pragma unroll
                        for (int n = 0; n < 2; ++n) t[bj][n] = t[bj][n] * r * gv[bj][n];
                }
                if (isq) {
                    bf16_t* p = QB + (size_t)row * 4096 + hidx * 64 + 8 * fq;
#pragma unroll
                    for (int bj = 0; bj < 2; ++bj) *(u32x4*)(p + 32 * bj) = pack8(t[bj][0], t[bj][1]);
                } else {
                    const int kr = row < 8192 ? row : 8192 + 160 * ((row - 8192) >> 5) + 128 + ((row - 8192) & 31);
                    bf16_t* p = kvb + (size_t)kr * 512 + hidx * 64 + 8 * fq;
#pragma unroll
                    for (int bj = 0; bj < 2; ++bj) *(u32x4*)(p + 32 * bj) = pack8(t[bj][0], t[bj][1]);
                    float* op = nullptr;
                    if (row >= 8192) op = out + o_s + (size_t)(row - 8192) * 512 + hidx * 64 + 8 * fq;
                    else { const int tt = row & 4095; if (tt >= 3968) op = out + o_p + (size_t)((row >> 12) * 128 + tt - 3968) * 512 + hidx * 64 + 8 * fq; }
                    if (op) {
#pragma unroll
                        for (int bj = 0; bj < 2; ++bj) { *(f32x4*)(op + 32 * bj) = t[bj][0]; *(f32x4*)(op + 32 * bj + 4) = t[bj][1]; }
                    }
                }
            }
    }
    static constexpr bool TAIL_SPLIT = false;
    __device__ __forceinline__ void tail(int row, int cg, int pn, int q, f32x4 v0, f32x4 v1) const {
        const bool isk = pn < 2, isq = pn >= 4, isv = !isk && !isq;
        const int hidx = (isk ? pn : (isq ? pn - 4 : pn - 2)) * 4 + q;
        const float rs = rstd_of(ssq, row);
        v0 = v0 * rs; v1 = v1 * rs;
        if (!isv) {
            const float* gp = isk ? kg : qg;
            const f32x4 g0 = *(const f32x4*)(gp + 8 * cg), g1 = *(const f32x4*)(gp + 8 * cg + 4);
            float ss = ssq4(v0) + ssq4(v1); ss += __shfl_xor(ss, 1); ss += __shfl_xor(ss, 2); ss += __shfl_xor(ss, 4);
            const float r = rsqrtf(ss * (1.0f / 64.0f) + 1e-6f) * (isq ? 0.125f : 1.0f);
            v0 = v0 * r * g0; v1 = v1 * r * g1;
        }
        if (isq) { *(u32x4*)(QB + (size_t)row * 4096 + hidx * 64 + 8 * cg) = pack8(v0, v1); }
        else {
            const int kr = 8192 + 160 * ((row - 8192) >> 5) + 128 + ((row - 8192) & 31);
            *(u32x4*)((isk ? KB : VB) + (size_t)kr * 512 + hidx * 64 + 8 * cg) = pack8(v0, v1);
            float* op = out + (isk ? OUT_KS : OUT_VS) + (size_t)(row - 8192) * 512 + hidx * 64 + 8 * cg;
            *(f32x4*)op = v0; *(f32x4*)(op + 4) = v1;
        }
    }
};
typedef int i32x4 __attribute__((ext_vector_type(4)));
__device__ __forceinline__ f32x4 mma16(bf16x8 a, bf16x8 b, f32x4 c) { return __builtin_amdgcn_mfma_f32_16x16x32_bf16(a, b, c, 0, 0, 0); }
__device__ __forceinline__ i32x4 mma16(bf16x8 a, bf16x8 b, i32x4 c) { return __builtin_amdgcn_mfma_i32_16x16x64_i8(__builtin_bit_cast(i32x4, a), __builtin_bit_cast(i32x4, b), c, 0, 0, 0); }
template <class Epi, class Sched, bool ALIGN_EPI = false, bool SP2 = false>
__device__ __forceinline__ void gemm_phase(PG8_LAS unsigned char* lds, const Gemm g, const Sched& S, const Epi& E) {
    const int tid = threadIdx.x, wid = __builtin_amdgcn_readfirstlane(tid >> 6), lane = tid & 63, wr = wid >> 2, wc = wid & 3, fr = lane & 15, fq = lane >> 4;
    const int K = g.K, nt = K / BK;
    unsigned voffA[2], voffB[2];
#pragma unroll
    for (int i = 0; i < 2; ++i) { int R, C; stage_rc(tid * 16 + i * 8192, R, C); const int Rb = Epi::PERM ? ((R & ~31) + perm32(R & 31)) : R;
        voffA[i] = (unsigned)(R * K + C) * 2u; voffB[i] = (unsigned)(Rb * K + C) * 2u; }
    const size_t kstep = (size_t)(BK * 2);
    const size_t hstep = (size_t)HALF * K * 2;
    const size_t tstep = 2 * hstep;
    const unsigned ldsw = (unsigned)wid * 1024u;
    const int aoff = lds_byte(wr * 64 + fr, fq * 8), boff = lds_byte(wc * 32 + fr, fq * 8);
#define PG8_SA(b, h) (((b) * 2 + (h)) * HTB)
#define PG8_SB(b, h) ((4 + (b) * 2 + (h)) * HTB)
#define PG8_STAGE(bufoff, gbase, voff) do { _Pragma("unroll") for (int _i = 0; _i < 2; ++_i) \
        __builtin_amdgcn_global_load_lds((const unsigned*)((const char*)(gbase) + (voff)[_i]), (PG8_LAS unsigned*)(lds + (bufoff) + ldsw + _i * 8192), 16, 0, 0); } while (0)
#define PG8_LDA(dst, b, h) do { _Pragma("unroll") for (int m = 0; m < 4; ++m) _Pragma("unroll") for (int k = 0; k < 2; ++k) dst[m][k] = *(const PG8_LAS bf16x8*)(lds + PG8_SA(b, h) + aoff + m * 2048 + k * 1024); } while (0)
#define PG8_LDB(dst, b, h) do { _Pragma("unroll") for (int n = 0; n < 2; ++n) _Pragma("unroll") for (int k = 0; k < 2; ++k) dst[n][k] = *(const PG8_LAS bf16x8*)(lds + PG8_SB(b, h) + boff + n * 2048 + k * 1024); } while (0)
#define PG8_MMA(ai, bj, At, Bt) do { __builtin_amdgcn_s_setprio(1); _Pragma("unroll") for (int m = 0; m < 4; ++m) _Pragma("unroll") for (int n = 0; n < 2; ++n) _Pragma("unroll") for (int k = 0; k < 2; ++k) \
        acc[ai][bj][m][n] = mma16(Bt[n][k], At[m][k], acc[ai][bj][m][n]); __builtin_amdgcn_s_setprio(0); } while (0)
#define PG8_WAIT_V(n) asm volatile("s_waitcnt vmcnt(" #n ")" ::: "memory")
#define PG8_WAIT_L(n) asm volatile("s_waitcnt lgkmcnt(" #n ")" ::: "memory")
#define PG8_BAR __builtin_amdgcn_s_barrier()
#define PG8_SCHED __builtin_amdgcn_sched_barrier(0)
    Unit cur, nxt; int ui = 0;
    if (!S.next(0, cur)) return;
    typedef typename Epi::AccT AccT;
    AccT acc[2][2][4][2];
#pragma unroll
    for (int a = 0; a < 2; ++a)
#pragma unroll
        for (int b = 0; b < 2; ++b)
#pragma unroll
            for (int m = 0; m < 4; ++m)
#pragma unroll
                for (int n = 0; n < 2; ++n) acc[a][b][m][n] = (AccT){0, 0, 0, 0};
    bf16x8 At[4][2], B0[2][2], B1[2][2];
    const char* cA = (const char*)g.A + (size_t)cur.pm * tstep; const char* cB = (const char*)g.Bt + (size_t)cur.pn * tstep;
    S.a_ready(cur);
    if constexpr (SP2) {
        PG8_STAGE(PG8_SB(0, 0), cB, voffB); PG8_STAGE(PG8_SB(0, 1), cB + hstep, voffB); PG8_STAGE(PG8_SA(0, 0), cA, voffA); PG8_STAGE(PG8_SA(0, 1), cA + hstep, voffA);
        if (wr == 1) PG8_BAR;
        PG8_WAIT_V(2); PG8_BAR;
        PG8_STAGE(PG8_SB(1, 0), cB + kstep, voffB); PG8_STAGE(PG8_SA(1, 0), cA + kstep, voffA); PG8_STAGE(PG8_SB(1, 1), cB + hstep + kstep, voffB);
        PG8_WAIT_V(6); PG8_BAR;
    } else {
        PG8_STAGE(PG8_SB(0, 0), cB, voffB); PG8_STAGE(PG8_SA(0, 0), cA, voffA); PG8_STAGE(PG8_SB(0, 1), cB + hstep, voffB); PG8_STAGE(PG8_SA(0, 1), cA + hstep, voffA);
        if (wr == 1) PG8_BAR;
        PG8_WAIT_V(4); PG8_BAR;
        PG8_STAGE(PG8_SB(1, 0), cB + kstep, voffB); PG8_STAGE(PG8_SA(1, 0), cA + kstep, voffA); PG8_STAGE(PG8_SB(1, 1), cB + hstep + kstep, voffB);
        PG8_WAIT_V(6); PG8_BAR;
    }
    for (;;) {
        const bool has_next = S.next(ui + 1, nxt);
        const char* nA = has_next ? (const char*)g.A + (size_t)nxt.pm * tstep : cA; const char* nB = has_next ? (const char*)g.Bt + (size_t)nxt.pn * tstep : cB;
        for (int t = 0; t < nt; t += 2) {
            const bool last = (t == nt - 2);
            const char* a1 = cA + (size_t)(t + 1) * kstep;
            const char* a2 = last ? nA : cA + (size_t)(t + 2) * kstep; const char* b2 = last ? nB : cB + (size_t)(t + 2) * kstep;
            const char* a3 = a2 + kstep; const char* b3 = b2 + kstep;
            if (last && has_next) S.a_ready(nxt);
            if constexpr (SP2) {
            PG8_LDB(B0, 0, 0); PG8_LDB(B1, 0, 1); PG8_SCHED; PG8_LDA(At, 0, 0); PG8_STAGE(PG8_SA(1, 1), a1 + hstep, voffA);
            PG8_WAIT_V(8); PG8_WAIT_L(0); PG8_BAR; PG8_MMA(0, 0, At, B0); PG8_MMA(0, 1, At, B1); PG8_BAR; PG8_SCHED;
            PG8_LDA(At, 0, 1); PG8_STAGE(PG8_SB(0, 0), b2, voffB); PG8_STAGE(PG8_SB(0, 1), b2 + hstep, voffB); PG8_STAGE(PG8_SA(0, 0), a2, voffA);
            PG8_WAIT_V(8); PG8_WAIT_L(0); PG8_BAR; PG8_MMA(1, 0, At, B0); PG8_MMA(1, 1, At, B1); PG8_BAR; PG8_SCHED;
            PG8_LDB(B0, 1, 0); PG8_LDB(B1, 1, 1); PG8_SCHED; PG8_LDA(At, 1, 0); PG8_STAGE(PG8_SA(0, 1), a2 + hstep, voffA);
            PG8_WAIT_V(8); PG8_WAIT_L(0); PG8_BAR; PG8_MMA(0, 0, At, B0); PG8_MMA(0, 1, At, B1); PG8_BAR; PG8_SCHED;
            PG8_LDA(At, 1, 1); PG8_STAGE(PG8_SB(1, 0), b3, voffB); PG8_STAGE(PG8_SB(1, 1), b3 + hstep, voffB); PG8_STAGE(PG8_SA(1, 0), a3, voffA);
            PG8_WAIT_V(8); PG8_WAIT_L(0); PG8_BAR; PG8_MMA(1, 0, At, B0); PG8_MMA(1, 1, At, B1); PG8_BAR; PG8_SCHED;
            } else {
            PG8_LDB(B0, 0, 0); PG8_SCHED; PG8_LDA(At, 0, 0); PG8_STAGE(PG8_SA(1, 1), a1 + hstep, voffA);
            PG8_WAIT_L(8); PG8_BAR; PG8_WAIT_L(0); PG8_MMA(0, 0, At, B0); PG8_BAR; PG8_SCHED;
            PG8_LDB(B1, 0, 1); PG8_STAGE(PG8_SB(0, 0), b2, voffB);
            PG8_BAR; PG8_WAIT_L(0); PG8_MMA(0, 1, At, B1); PG8_BAR;
            PG8_LDA(At, 0, 1); PG8_STAGE(PG8_SA(0, 0), a2, voffA);
            PG8_BAR; PG8_WAIT_L(0); PG8_MMA(1, 0, At, B0); PG8_BAR; PG8_SCHED;
            PG8_STAGE(PG8_SB(0, 1), b2 + hstep, voffB);
            PG8_WAIT_V(6); PG8_BAR; PG8_MMA(1, 1, At, B1); PG8_BAR;
            PG8_LDB(B0, 1, 0); PG8_SCHED; PG8_LDA(At, 1, 0); PG8_STAGE(PG8_SA(0, 1), a2 + hstep, voffA);
            PG8_WAIT_L(8); PG8_BAR; PG8_WAIT_L(0); PG8_MMA(0, 0, At, B0); PG8_BAR; PG8_SCHED;
            PG8_LDB(B1, 1, 1); PG8_STAGE(PG8_SB(1, 0), b3, voffB);
            PG8_BAR; PG8_WAIT_L(0); PG8_MMA(0, 1, At, B1); PG8_BAR;
            PG8_LDA(At, 1, 1); PG8_STAGE(PG8_SA(1, 0), a3, voffA);
            PG8_BAR; PG8_WAIT_L(0); PG8_MMA(1, 0, At, B0); PG8_BAR; PG8_SCHED;
            PG8_STAGE(PG8_SB(1, 1), b3 + hstep, voffB);
            PG8_WAIT_V(6); PG8_BAR; PG8_MMA(1, 1, At, B1); PG8_BAR;
            }
        }
        if constexpr (ALIGN_EPI) { if (wr == 0) PG8_BAR; }
        if constexpr (!Epi::AFTER_DRAIN) { E(acc, cur, wr, wc, fr, fq); S.done(cur); }
        if (!has_next) break;
#pragma unroll
        for (int a = 0; a < 2; ++a)
#pragma unroll
            for (int b = 0; b < 2; ++b)
#pragma unroll
                for (int m = 0; m < 4; ++m)
#pragma unroll
                    for (int n = 0; n < 2; ++n) acc[a][b][m][n] = (AccT){0, 0, 0, 0};
        cur = nxt; cA = nA; cB = nB; ++ui;
        if constexpr (ALIGN_EPI) { if (wr == 1) PG8_BAR; }
    }
    PG8_WAIT_V(0);
    if constexpr (!ALIGN_EPI) { if (wr == 0) PG8_BAR; }
    PG8_BAR;
    if constexpr (Epi::AFTER_DRAIN) { E.fused(acc, cur, wr, wc, fr, fq, lds, wid, lane); S.done(cur); }
#undef PG8_SA
#undef PG8_SB
#undef PG8_STAGE
#undef PG8_LDA
#undef PG8_LDB
#undef PG8_MMA
#undef PG8_WAIT_V
#undef PG8_WAIT_L
#undef PG8_BAR
#undef PG8_SCHED
}
}

#ifndef PG8_SP2
#define PG8_SP2 true
#endif
#ifndef PG8_ALIGN
#define PG8_ALIGN true
#endif
#ifndef MK_ONE_LAUNCH
#define MK_ONE_LAUNCH 1
#endif
constexpr int NWAVES = 8, NPHASES = 13;
constexpr int D = 4096, MP = 8192, MS = 256, M = MP + MS, DFF = 11008, NGU = 2 * DFF, NQKV = 5120, NSGU = 8192;
constexpr int KV_ROWS = 8192 + 8 * 160;
constexpr size_t MiB = 1u << 20;
constexpr size_t WS_CTL = 0, CTL_ZERO_BYTES = 1 * MiB;
constexpr int CW_BAR = 4096, CW_Q = 8192;
constexpr size_t ST_OFF = 65536, ST_STRIDE = 67584;
static_assert(ST_STRIDE == (size_t)M * 8 && ST_OFF + 6 * ST_STRIDE <= CTL_ZERO_BYTES, "stat arrays inside the memset region");
constexpr size_t CM_OFF = 524288, CM_STRIDE = 88064;
constexpr size_t RS_OFF = 720896;
static_assert(ST_OFF + 6 * ST_STRIDE <= CM_OFF && CM_OFF + 2 * CM_STRIDE <= RS_OFF && RS_OFF + (size_t)M * 4 <= CTL_ZERO_BYTES, "control region map");
constexpr size_t WS_WSB = 1 * MiB;
constexpr size_t WS_W1T = 2 * MiB, WS_W2T = 66 * MiB, WS_WGU0 = 98 * MiB, WS_WD0 = 270 * MiB, WS_WQKV = 356 * MiB, WS_WOT = 396 * MiB, WS_WGU1 = 428 * MiB, WS_WD1 = 600 * MiB;
constexpr size_t WS_XB = 686 * MiB, WS_H = 752 * MiB  , WS_ACT = 884 * MiB, WS_ZQ = 1062 * MiB, WS_O = 1128 * MiB, WS_KB = 1194 * MiB, WS_VB = 1204 * MiB, WS_END = 1214 * MiB;
static_assert(WS_W1T + (size_t)NSGU * D * 2 <= WS_W2T && WS_W2T + (size_t)D * D * 2 <= WS_WGU0 && WS_WGU0 + (size_t)NGU * D * 2 <= WS_WD0 && WS_WD0 + (size_t)D * DFF * 2 <= WS_WQKV &&
              WS_WQKV + (size_t)NQKV * D * 2 <= WS_WOT && WS_WOT + (size_t)D * D * 2 <= WS_WGU1 && WS_WGU1 + (size_t)NGU * D * 2 <= WS_WD1 && WS_WD1 + (size_t)D * DFF * 2 <= WS_XB, "weight map");
static_assert(WS_XB + (size_t)M * D * 2 <= WS_H && WS_H + (size_t)M * D * 4 <= WS_ACT && WS_ACT + (size_t)M * DFF * 2 <= WS_ZQ && WS_ACT + (size_t)M * NSGU * 2 <= WS_ZQ &&
              WS_ZQ + (size_t)M * D * 2 <= WS_O && WS_O + (size_t)M * D * 2 <= WS_KB && WS_KB + (size_t)KV_ROWS * 512 * 2 <= WS_VB && WS_VB + (size_t)KV_ROWS * 512 * 2 <= WS_END, "activation map");
constexpr int SCR_BYTES = 139264;
constexpr int LDSCTL_OFF = SCR_BYTES, MISC_OFF = LDSCTL_OFF + 320;
constexpr int LDS_BYTES = 147456;
static_assert(MISC_OFF + 128 <= LDS_BYTES && pg8::STAGE_BYTES <= SCR_BYTES, "LDS map");

#define GAS __attribute__((address_space(1)))
#define LAS __attribute__((address_space(3)))
typedef unsigned short bf16;
typedef unsigned v4u __attribute__((ext_vector_type(4)));
typedef unsigned v2u __attribute__((ext_vector_type(2)));
typedef float f32x4 __attribute__((ext_vector_type(4)));
typedef short bf16x8 __attribute__((ext_vector_type(8)));
typedef unsigned long long u64;
#define LDS_WAIT() asm volatile("s_waitcnt lgkmcnt(0)" ::: "memory")
#define VM_WAIT() asm volatile("s_waitcnt vmcnt(0)" ::: "memory")
__device__ __forceinline__ unsigned f2bf(float f) { unsigned u = __builtin_bit_cast(unsigned, f); return (u + 0x7fffu + ((u >> 16) & 1u)) >> 16; }
typedef float f32x2_t __attribute__((ext_vector_type(2)));
typedef __bf16 bf16x2_t __attribute__((ext_vector_type(2)));
__device__ __forceinline__ unsigned pk2(float lo, float hi) { const f32x2_t v = {lo, hi}; const bf16x2_t b = __builtin_convertvector(v, bf16x2_t); return __builtin_bit_cast(unsigned, b); }
__device__ __forceinline__ float bflo(unsigned w) { return __builtin_bit_cast(float, w << 16); }
__device__ __forceinline__ float bfhi(unsigned w) { return __builtin_bit_cast(float, w & 0xffff0000u); }

#define XB_TMO      128
#define XB_XCNT(j)  (256  + 64 * (j))
#define XB_XSUB(j)  (1280 + 64 * (j))
#define XB_XGEN(j)  (2304 + 64 * (j))
#define XB_TOP      3328
#define XB_TOPGEN   3392
#define XCD_BAR_WORDS 3456
#define XB_SPIN_CAP (1u << 18)

__device__ __forceinline__ unsigned xb_ld(unsigned* p)              { return __hip_atomic_load(p, __ATOMIC_RELAXED, __HIP_MEMORY_SCOPE_AGENT); }
__device__ __forceinline__ unsigned xb_add(unsigned* p, unsigned v) { return __hip_atomic_fetch_add(p, v, __ATOMIC_RELAXED, __HIP_MEMORY_SCOPE_AGENT); }
__device__ __forceinline__ unsigned xb_xcc_id() { return (unsigned)__builtin_amdgcn_s_getreg((3 << 11) | 20) & 0xFu; }
#define XB_SPIN(cond, bar) do { unsigned _sp = 0; while (cond) { __builtin_amdgcn_s_sleep(1); \
    if ((++_sp & 255u) == 0u) { if (xb_ld(&(bar)[XB_TMO])) break; if (_sp > XB_SPIN_CAP) { atomicAdd(&(bar)[XB_TMO], 1u); break; } } } } while (0)

struct XcdBarrier {
    unsigned* bar; unsigned x;
    volatile LAS unsigned* st;
};

__device__ __forceinline__ XcdBarrier xcd_barrier_post(unsigned* bar, volatile LAS unsigned* st) {
    XcdBarrier b; b.bar = bar; b.x = xb_xcc_id(); b.st = st;
    if (threadIdx.x == 0) (void)xb_add(&bar[XB_XCNT(b.x)], 1u);
    return b;
}
__device__ __forceinline__ void xcd_barrier_complete(unsigned* bar, unsigned x, unsigned& nloc, unsigned& nx) {
    const unsigned G = gridDim.x * gridDim.y * gridDim.z;
    unsigned sum, cnt, mine, sp = 0u;
    for (;;) {
        sum = 0u; cnt = 0u; mine = 0u;
#pragma unroll
        for (unsigned j = 0; j < 16; ++j) { const unsigned c = xb_ld(&bar[XB_XCNT(j)]); sum += c; cnt += (c > 0u) ? 1u : 0u; mine = (j == x) ? c : mine; }
        if (sum == G) break;
        __builtin_amdgcn_s_sleep(1);
        if ((++sp & 255u) == 0u) { if (xb_ld(&bar[XB_TMO])) break; if (sp > XB_SPIN_CAP) { atomicAdd(&bar[XB_TMO], 1u); break; } }
    }
    nloc = mine > 0u ? mine : 1u; nx = cnt > 0u ? cnt : 1u;
}

__device__ __forceinline__ void xcd_barrier(const XcdBarrier& b) {
    asm volatile("s_waitcnt vmcnt(0)" ::: "memory");
    __syncthreads();
    if (threadIdx.x == 0) {
        unsigned* bar = b.bar;
        __builtin_amdgcn_s_waitcnt(0);
        unsigned nloc = b.st[0], nx = b.st[1];
        if (nloc == 0u) { xcd_barrier_complete(bar, b.x, nloc, nx); b.st[0] = nloc; b.st[1] = nx; }
        const unsigned old = xb_add(&bar[XB_XSUB(b.x)], 1u);
        const unsigned gen = old / nloc;
        if (old + 1u == (gen + 1u) * nloc) {
            __builtin_amdgcn_fence(__ATOMIC_RELEASE, "agent");
            asm volatile("s_waitcnt vmcnt(0)" ::: "memory");
            const unsigned og = xb_add(&bar[XB_TOP], 1u);
            const unsigned tg = og / nx;
            if (og + 1u == (tg + 1u) * nx) xb_add(&bar[XB_TOPGEN], 1u);
            else XB_SPIN(xb_ld(&bar[XB_TOPGEN]) == tg, bar);
            __builtin_amdgcn_fence(__ATOMIC_ACQUIRE, "agent");
            xb_add(&bar[XB_XGEN(b.x)], 1u);
            asm volatile("s_waitcnt vmcnt(0)" ::: "memory");
        } else {
            XB_SPIN(xb_ld(&bar[XB_XGEN(b.x)]) == gen, bar);
            __builtin_amdgcn_fence(__ATOMIC_ACQUIRE, "agent");
            asm volatile("s_waitcnt vmcnt(0)" ::: "memory");
        }
    }
    __syncthreads();
}


using pg8::FIX_INV;
__device__ __forceinline__ float wave_sum(float v) {
#pragma unroll
    for (int o = 1; o < 64; o <<= 1) v += __shfl_xor(v, o);
    return v;
}
__device__ __forceinline__ int maprow(int map, int n) {
    const int r12 = ((n >> 7) << 8) + (n & 127) + (map == 2 ? 128 : 0);
    const int r3 = (n & ~255) + (((n >> 5) & 1) << 7) + (((n >> 6) & 3) << 5) + (n & 31);
    return map == 0 ? n : (map == 3 ? r3 : r12);
}
struct TItem { const float* W; const float* gain; bf16* WT; const float* cmax; int K, N, map, coff, k0, n0; };
struct TRegs { f32x4 v[16]; f32x4 g0, g1; float cm[8]; };
__device__ __forceinline__ void titem_load(const TItem& t, TRegs& R, const float* dummy, int lane) {
    const float* p = t.W + (size_t)(t.k0 + (lane >> 4)) * t.N + t.n0 + 4 * (lane & 15);
#pragma unroll
    for (int i = 0; i < 16; ++i) R.v[i] = __builtin_nontemporal_load((const f32x4*)(p + (size_t)(4 * i) * t.N));
    const float* gp = (t.gain ? t.gain + t.k0 : dummy + (t.k0 & 4095)) + 8 * (lane & 7);
    R.g0 = *(const f32x4*)gp; R.g1 = *(const f32x4*)(gp + 4);
    const float* cp = t.cmax ? t.cmax : dummy;
#pragma unroll
    for (int j = 0; j < 8; ++j) R.cm[j] = cp[t.cmax ? maprow(t.map, t.n0 + 8 * j + (lane >> 3) + t.coff) : j];
}
__device__ __forceinline__ void titem_lds_write(const TRegs& R, LAS float* scr, int lane) {
#pragma unroll
    for (int i = 0; i < 16; ++i) { const int kk = 4 * i + (lane >> 4), c4 = (lane & 15) ^ (((kk >> 3) & 3) << 1); *(LAS f32x4*)(scr + kk * 64 + 4 * c4) = R.v[i]; }
}
__device__ __forceinline__ void titem_emit(const TItem& t, f32x4 g0, f32x4 g1, const float (&cm)[8], LAS float* scr, int lane) {
    LDS_WAIT(); asm volatile("" ::: "memory");
    const int c = lane & 7, nn = lane >> 3;
    const bool hg = t.gain != nullptr; const f32x4 one = {1.f, 1.f, 1.f, 1.f};
    g0 = hg ? g0 : one; g1 = hg ? g1 : one;
    const int sw = (c & 3) << 1;
#pragma unroll
    for (int j = 0; j < 8; ++j) { const int n = 8 * j + nn; const LAS float* sp = scr + (8 * c) * 64 + ((((n >> 2) ^ sw) << 2) | (n & 3));
        const size_t drow = (size_t)maprow(t.map, t.n0 + n + t.coff);
        if (t.cmax) {
            const float inv = cm[j] > 0.f ? 127.0f / cm[j] : 0.f;
            const int q0 = __float2int_rn(sp[0 * 64] * g0.x * inv), q1 = __float2int_rn(sp[1 * 64] * g0.y * inv), q2 = __float2int_rn(sp[2 * 64] * g0.z * inv), q3 = __float2int_rn(sp[3 * 64] * g0.w * inv);
            const int q4 = __float2int_rn(sp[4 * 64] * g1.x * inv), q5 = __float2int_rn(sp[5 * 64] * g1.y * inv), q6 = __float2int_rn(sp[6 * 64] * g1.z * inv), q7 = __float2int_rn(sp[7 * 64] * g1.w * inv);
            v2u o; o.x = (unsigned)(q0 & 255) | ((unsigned)(q1 & 255) << 8) | ((unsigned)(q2 & 255) << 16) | ((unsigned)q3 << 24);
            o.y = (unsigned)(q4 & 255) | ((unsigned)(q5 & 255) << 8) | ((unsigned)(q6 & 255) << 16) | ((unsigned)q7 << 24);
            __builtin_nontemporal_store(o, (GAS v2u*)((unsigned char*)t.WT + drow * t.K + t.k0 + 8 * c));
        } else {
        v4u o; o.x = pk2(sp[0 * 64] * g0.x, sp[1 * 64] * g0.y); o.y = pk2(sp[2 * 64] * g0.z, sp[3 * 64] * g0.w); o.z = pk2(sp[4 * 64] * g1.x, sp[5 * 64] * g1.y); o.w = pk2(sp[6 * 64] * g1.z, sp[7 * 64] * g1.w);
        __builtin_nontemporal_store(o, (GAS v4u*)(t.WT + drow * t.K + t.k0 + 8 * c)); } }
    LDS_WAIT(); asm volatile("" ::: "memory");
}
struct Args { const float* in[23]; float* out; unsigned char* ws; int ph_lo, ph_hi; };
constexpr int P0_ITEMS_A = 64 * 128;
constexpr int P0_ITEMS_ALL = 64 * 128 + 64 * 64 + 2 * 64 * 172 + 172 * 64 + 64 * 16 + 64 * 64 + 64 * 64 + 2 * 64 * 172 + 172 * 64;
__device__ __forceinline__ void p0_prologue(const Args& a, unsigned char* ws, LAS unsigned char* lds, int gw, int NGW, int it_lo, int it_hi, int misc, int wave, int lane) {
    LAS float* scr = (LAS float*)(lds + wave * 16384);
    constexpr int IT_1 = 64 * 128, IT_SQ = 64 * 64, IT_G = 64 * 172, IT_D = 172 * 64, IT_KV = 64 * 16;
    constexpr int NITEMS = IT_1 + IT_SQ + 2 * IT_G + IT_D + IT_KV + IT_SQ + IT_SQ + 2 * IT_G + IT_D;
    auto describe = [&](int it) -> TItem {
        TItem t; int r = it; t.gain = nullptr; t.cmax = nullptr; t.K = 4096; t.N = 4096; t.map = 0; t.coff = 0;
        if (r < IT_1) { t.W = a.in[5]; t.gain = a.in[4]; t.WT = (bf16*)(ws + WS_W1T); t.N = 8192; }
        else if ((r -= IT_1) < IT_SQ) { t.W = a.in[10]; t.WT = (bf16*)(ws + WS_W2T); }
        else if ((r -= IT_SQ) < IT_G) { t.W = a.in[20]; t.gain = a.in[19]; t.WT = (bf16*)(ws + WS_WGU0); t.N = DFF; t.map = 1; t.cmax = (const float*)(ws + CM_OFF); }
        else if ((r -= IT_G) < IT_G) { t.W = a.in[21]; t.gain = a.in[19]; t.WT = (bf16*)(ws + WS_WGU0); t.N = DFF; t.map = 2; t.cmax = (const float*)(ws + CM_OFF); }
        else if ((r -= IT_G) < IT_D) { t.W = a.in[22]; t.WT = (bf16*)(ws + WS_WD0); t.K = DFF; }
        else if ((r -= IT_D) < IT_KV) { t.W = a.in[12]; t.gain = a.in[11]; t.WT = (bf16*)(ws + WS_WQKV); t.N = 1024; t.map = 3; }
        else if ((r -= IT_KV) < IT_SQ) { t.W = a.in[15]; t.gain = a.in[14]; t.WT = (bf16*)(ws + WS_WQKV); t.map = 3; t.coff = 1024; }
        else if ((r -= IT_SQ) < IT_SQ) { t.W = a.in[18]; t.WT = (bf16*)(ws + WS_WOT); }
        else if ((r -= IT_SQ) < IT_G) { t.W = a.in[20] + (size_t)D * DFF; t.gain = a.in[19] + D; t.WT = (bf16*)(ws + WS_WGU1); t.N = DFF; t.map = 1; t.cmax = (const float*)(ws + CM_OFF + CM_STRIDE); }
        else if ((r -= IT_G) < IT_G) { t.W = a.in[21] + (size_t)D * DFF; t.gain = a.in[19] + D; t.WT = (bf16*)(ws + WS_WGU1); t.N = DFF; t.map = 2; t.cmax = (const float*)(ws + CM_OFF + CM_STRIDE); }
        else { r -= IT_G; t.W = a.in[22] + (size_t)D * DFF; t.WT = (bf16*)(ws + WS_WD1); t.K = DFF; }
        const int nblk = t.N >> 6, kb = r / nblk; t.k0 = 64 * kb; t.n0 = 64 * (r - kb * nblk);
        return t;
    };
    static_assert(NITEMS == P0_ITEMS_ALL && IT_1 == P0_ITEMS_A, "item counts");
    if (it_lo + gw < it_hi) {
        const int first = it_lo + gw, last = first + ((it_hi - 1 - first) / NGW) * NGW, count = (last - first) / NGW + 1;
        TRegs ra, rb; const float* dummy = a.in[4];
        TItem ta = describe(first), tb = describe(first + NGW <= last ? first + NGW : last);
        titem_load(ta, ra, dummy, lane); titem_load(tb, rb, dummy, lane);
        for (int j = 0; j < count; j += 2) {
            const int i2 = first + (j + 2) * NGW, i3 = first + (j + 3) * NGW;
            const TItem tc = describe(i2 <= last ? i2 : last), td = describe(i3 <= last ? i3 : last);
            { titem_lds_write(ra, scr, lane); const f32x4 g0 = ra.g0, g1 = ra.g1; float cm[8]; _Pragma("unroll") for (int q = 0; q < 8; ++q) cm[q] = ra.cm[q]; titem_load(tc, ra, dummy, lane); titem_emit(ta, g0, g1, cm, scr, lane); }
            { titem_lds_write(rb, scr, lane); const f32x4 g0 = rb.g0, g1 = rb.g1; float cm[8]; _Pragma("unroll") for (int q = 0; q < 8; ++q) cm[q] = rb.cm[q]; titem_load(td, rb, dummy, lane); titem_emit(tb, g0, g1, cm, scr, lane); }
            ta = tc; tb = td;
        }
        asm volatile("s_waitcnt vmcnt(0)" ::: "memory");
    }
    if (!misc) return;
    bf16* XB = (bf16*)(ws + WS_XB); u64* ssq_x = (u64*)(ws + ST_OFF);
    for (int m = gw; m < M; m += NGW) {
        const float* xrow = m < MP ? a.in[0] + (size_t)m * D : a.in[1] + (size_t)(m - MP) * D;
        const GAS f32x4* xr = (const GAS f32x4*)xrow + lane; GAS v2u* o8 = (GAS v2u*)(XB + (size_t)m * D) + lane; float ss = 0.f;
#pragma unroll 4
        for (int j = 0; j < 16; ++j) { const f32x4 v = xr[64 * j]; ss += (v.x * v.x + v.y * v.y) + (v.z * v.z + v.w * v.w); v2u o; o.x = pk2(v.x, v.y); o.y = pk2(v.z, v.w); o8[64 * j] = o; }
        ss = wave_sum(ss);
        if (lane == 0) ssq_x[m] = (u64)(ss * pg8::FIX_SCALE);
    }
    const int gt = gw * 64 + lane, NT = NGW * 64;
    bf16* KB = (bf16*)(ws + WS_KB); bf16* VB = (bf16*)(ws + WS_VB); bf16* WSB = (bf16*)(ws + WS_WSB);
    for (int i = gt; i < 65536; i += NT) {
        const int e = i * 8, b = e >> 16, t = (e >> 9) & 127, c = e & 511; const size_t dst = (size_t)(8192 + 160 * b + t) * 512 + c;
        { const f32x4 v0 = *(const f32x4*)(a.in[2] + e), v1 = *(const f32x4*)(a.in[2] + e + 4); v4u o; o.x = pk2(v0.x, v0.y); o.y = pk2(v0.z, v0.w); o.z = pk2(v1.x, v1.y); o.w = pk2(v1.z, v1.w); *(v4u*)(KB + dst) = o; }
        { const f32x4 v0 = *(const f32x4*)(a.in[3] + e), v1 = *(const f32x4*)(a.in[3] + e + 4); v4u o; o.x = pk2(v0.x, v0.y); o.y = pk2(v0.z, v0.w); o.z = pk2(v1.x, v1.y); o.w = pk2(v1.z, v1.w); *(v4u*)(VB + dst) = o; }
    }
    for (int i = gt; i < 16384; i += NT) {
        const int e = i * 8, ii = (e >> 7) & 127, j = e & 127; const bool keep = (ii >> 6) >= (j >> 6);
        const f32x4 v0 = *(const f32x4*)(a.in[8] + e), v1 = *(const f32x4*)(a.in[8] + e + 4); v4u o = {0u, 0u, 0u, 0u};
        if (keep) { o.x = pk2(v0.x, v0.y); o.y = pk2(v0.z, v0.w); o.z = pk2(v1.x, v1.y); o.w = pk2(v1.z, v1.w); }
        *(v4u*)(WSB + e) = o;
    }
}


__device__ __forceinline__ void absmax_pass(const Args& a, unsigned char* ws, int gw, int NGW, int lane) {
    constexpr int PER = 16 * 172, NIT = 4 * PER;
    const int r = lane >> 4;
    for (int it = gw; it < NIT; it += NGW) {
        const int mat = it / PER, rem = it - mat * PER, kg = rem / 172, nb = rem - kg * 172, l = mat >> 1, up = mat & 1;
        const float* W = (up ? a.in[21] : a.in[20]) + (size_t)l * D * DFF; const float* gain = a.in[19] + l * D;
        unsigned* cmax = (unsigned*)(ws + CM_OFF + (size_t)l * CM_STRIDE);
        const int k0 = 256 * kg, n0 = 64 * nb;
        const float* p = W + (size_t)(k0 + r) * DFF + n0 + 4 * (lane & 15);
        f32x4 va[16], vb[16]; float ga[16], gb[16];
#define AM_LOAD(v_, g_, sb_) do { _Pragma("unroll") for (int i = 0; i < 16; ++i) { v_[i] = __builtin_nontemporal_load((const f32x4*)(p + (size_t)(64 * (sb_) + 4 * i) * DFF)); g_[i] = gain[k0 + 64 * (sb_) + 4 * i + r]; } } while (0)
#define AM_MAX(v_, g_) do { _Pragma("unroll") for (int i = 0; i < 16; ++i) { m0 = fmaxf(m0, fabsf(v_[i].x * g_[i])); m1 = fmaxf(m1, fabsf(v_[i].y * g_[i])); m2 = fmaxf(m2, fabsf(v_[i].z * g_[i])); m3 = fmaxf(m3, fabsf(v_[i].w * g_[i])); } } while (0)
        float m0 = 0.f, m1 = 0.f, m2 = 0.f, m3 = 0.f;
        AM_LOAD(va, ga, 0); AM_LOAD(vb, gb, 1);
        AM_MAX(va, ga); AM_LOAD(va, ga, 2);
        AM_MAX(vb, gb); AM_LOAD(vb, gb, 3);
        AM_MAX(va, ga); AM_MAX(vb, gb);
#undef AM_LOAD
#undef AM_MAX
        m0 = fmaxf(m0, __shfl_xor(m0, 16)); m0 = fmaxf(m0, __shfl_xor(m0, 32)); m1 = fmaxf(m1, __shfl_xor(m1, 16)); m1 = fmaxf(m1, __shfl_xor(m1, 32));
        m2 = fmaxf(m2, __shfl_xor(m2, 16)); m2 = fmaxf(m2, __shfl_xor(m2, 32)); m3 = fmaxf(m3, __shfl_xor(m3, 16)); m3 = fmaxf(m3, __shfl_xor(m3, 32));
        if (lane < 16) {
            unsigned* cp = cmax + maprow(1 + up, n0 + 4 * lane);
            (void)__hip_atomic_fetch_max(cp + 0, __builtin_bit_cast(unsigned, m0), __ATOMIC_RELAXED, __HIP_MEMORY_SCOPE_AGENT);
            (void)__hip_atomic_fetch_max(cp + 1, __builtin_bit_cast(unsigned, m1), __ATOMIC_RELAXED, __HIP_MEMORY_SCOPE_AGENT);
            (void)__hip_atomic_fetch_max(cp + 2, __builtin_bit_cast(unsigned, m2), __ATOMIC_RELAXED, __HIP_MEMORY_SCOPE_AGENT);
            (void)__hip_atomic_fetch_max(cp + 3, __builtin_bit_cast(unsigned, m3), __ATOMIC_RELAXED, __HIP_MEMORY_SCOPE_AGENT);
        }
    }
}
__device__ __forceinline__ void quant_rows(const bf16* XB, const u64* ssq, unsigned char* A8, float* rowscale, int gw, int NGW, int lane) {
    for (int m = gw; m < M; m += NGW) {
        const v4u* xr = (const v4u*)(XB + (size_t)m * D) + lane; v4u w[8]; unsigned mx = 0u;
#pragma unroll
        for (int j = 0; j < 8; ++j) { w[j] = xr[64 * j];
#pragma unroll
            for (int q = 0; q < 4; ++q) { const unsigned t = w[j][q] & 0x7fff7fffu; const unsigned lo = t & 0xffffu, hi = t >> 16; mx = mx > lo ? mx : lo; mx = mx > hi ? mx : hi; } }
#pragma unroll
        for (int o = 1; o < 64; o <<= 1) { const unsigned t = (unsigned)__shfl_xor((int)mx, o); mx = mx > t ? mx : t; }
        const float fmx = __builtin_bit_cast(float, mx << 16), inv = fmx > 0.f ? 127.0f / fmx : 0.f;
        v2u* orow = (v2u*)(A8 + (size_t)m * D) + lane;
#pragma unroll
        for (int j = 0; j < 8; ++j) { unsigned b[8];
#pragma unroll
            for (int q = 0; q < 4; ++q) { b[2 * q] = (unsigned)__float2int_rn(bflo(w[j][q]) * inv) & 255u; b[2 * q + 1] = (unsigned)__float2int_rn(bfhi(w[j][q]) * inv) & 255u; }
            v2u o; o.x = b[0] | (b[1] << 8) | (b[2] << 16) | (b[3] << 24); o.y = b[4] | (b[5] << 8) | (b[6] << 16) | (b[7] << 24); orow[64 * j] = o; }
        if (lane == 0) rowscale[m] = fmx * (1.0f / 127.0f) * rsqrtf((float)ssq[m] * (pg8::FIX_INV * (1.0f / 4096.0f)) + 1e-6f);
    }
}
__device__ __forceinline__ void sgu_phase(LAS unsigned char* lds, const bf16* UV, const bf16* WSB, const u64* lnsum, const u64* lnssq, const float* ln_g, const float* ln_b,
                                          const float* b_s, bf16* Z, float* out_sguv, int wave, int lane) {
    const int fr = lane & 15, fq = lane >> 4;
    LAS unsigned char* img = lds + wave * 17408;
    for (int uidx = blockIdx.x; uidx < 576; uidx += gridDim.x) {
        const bool samp = uidx >= 512;
        const int g = uidx & 7, chunk = samp ? ((uidx - 512) >> 3) : (uidx >> 3);
        const int row_base = samp ? MP + 32 * chunk : 128 * chunk, nrows = samp ? 32 : 128;
        const int cw = 512 * g + 64 * wave;
        {
            const int cp = lane & 7, c = cw + 8 * cp;
            const f32x4 g0 = *(const f32x4*)(ln_g + c), g1 = *(const f32x4*)(ln_g + c + 4), b0 = *(const f32x4*)(ln_b + c), b1 = *(const f32x4*)(ln_b + c + 4);
            for (int it = 0; it < nrows / 8; ++it) {
                const int j = it * 8 + (lane >> 3), row = row_base + j;
                const v4u raw = *(const v4u*)(UV + (size_t)row * NSGU + D + c);
                const float mean = (float)(long long)lnsum[row] * (FIX_INV / 4096.0f), ex2 = (float)lnssq[row] * (FIX_INV / 4096.0f);
                const float rstd = rsqrtf(fmaxf(ex2 - mean * mean, 0.f) + 1e-5f);
                f32x4 x0 = {bflo(raw.x), bfhi(raw.x), bflo(raw.y), bfhi(raw.y)}, x1 = {bflo(raw.z), bfhi(raw.z), bflo(raw.w), bfhi(raw.w)};
                x0 = (x0 - mean) * rstd * g0 + b0; x1 = (x1 - mean) * rstd * g1 + b1;
                if (samp) { float* op = out_sguv + (size_t)(row - MP) * D + c; *(f32x4*)op = x0; *(f32x4*)(op + 4) = x1; }
                LAS unsigned short* wp = (LAS unsigned short*)(img + (8 * cp) * 272 + j * 2);
#pragma unroll
                for (int i = 0; i < 4; ++i) { wp[i * 136] = (unsigned short)f2bf(x0[i]); wp[(4 + i) * 136] = (unsigned short)f2bf(x1[i]); }
            }
        }
        LDS_WAIT(); asm volatile("" ::: "memory");
        const int nmt = nrows >> 4, kmax = nrows >> 5;
        bf16x8 bfr[4][4];
#pragma unroll
        for (int nt = 0; nt < 4; ++nt)
#pragma unroll
            for (int ks = 0; ks < 4; ++ks) bfr[nt][ks] = (ks < kmax) ? *(const LAS bf16x8*)(img + (16 * nt + fr) * 272 + (32 * ks + 8 * fq) * 2) : (bf16x8){0, 0, 0, 0, 0, 0, 0, 0};
        const bf16* Wg = WSB + g * 16384;
        for (int mt = 0; mt < nmt; ++mt) {
            bf16x8 af[4];
#pragma unroll
            for (int ks = 0; ks < 4; ++ks) af[ks] = (ks < kmax) ? *(const bf16x8*)(Wg + (16 * mt + fr) * 128 + 32 * ks + 8 * fq) : (bf16x8){0, 0, 0, 0, 0, 0, 0, 0};
            f32x4 acc[4];
#pragma unroll
            for (int nt = 0; nt < 4; ++nt) acc[nt] = (f32x4){0.f, 0.f, 0.f, 0.f};
#pragma unroll
            for (int ks = 0; ks < 4; ++ks)
                if (ks < kmax) {
#pragma unroll
                    for (int nt = 0; nt < 4; ++nt) acc[nt] = __builtin_amdgcn_mfma_f32_16x16x32_bf16(bfr[nt][ks], af[ks], acc[nt], 0, 0, 0);
                }
            const int i = 16 * mt + fr; const float bias = b_s[g * 128 + i]; const size_t ro = (size_t)(row_base + i);
#pragma unroll
            for (int nt = 0; nt < 4; ++nt) {
                const int c = cw + 16 * nt + 4 * fq; const v2u uu = *(const v2u*)(UV + ro * NSGU + c);
                f32x4 z = {bflo(uu.x), bfhi(uu.x), bflo(uu.y), bfhi(uu.y)};
                { const pg8::f32x2 ga = pg8::gelu_pk((pg8::f32x2){z[0], z[1]}), gb = pg8::gelu_pk((pg8::f32x2){z[2], z[3]}); z = (f32x4){ga.x, ga.y, gb.x, gb.y}; }
                z = z * (acc[nt] + bias);
                v2u o; o.x = pk2(z[0], z[1]); o.y = pk2(z[2], z[3]); *(v2u*)(Z + ro * D + c) = o;
            }
        }
        LDS_WAIT(); asm volatile("" ::: "memory");
    }
}

__device__ __forceinline__ void attn_phase(LAS unsigned char* lds, const bf16* Q, const bf16* KB, const bf16* VB, const float* sinks, bf16* O, int tid, int wave, int lane) {
    const int fr = lane & 15, fq = lane >> 4;
    LAS unsigned char* Ks = lds; LAS unsigned char* Vt = lds + 27648;
    constexpr float LOG2E = 1.4426950408889634f;
    for (int uidx = blockIdx.x; uidx < 1088; uidx += gridDim.x) {
        int kvh, qbase, kbase, klo, khi, nmt;
        if (uidx < 1024) { kvh = uidx & 7; const int bc = uidx >> 3, c = bc & 63; qbase = bc * 64; kbase = qbase - 128; klo = c >= 2 ? 0 : (2 - c) * 64; khi = 192; nmt = 4; }
        else { const int s = uidx - 1024; kvh = s & 7; const int b = s >> 3; qbase = MP + 32 * b; kbase = MP + 160 * b; klo = 0; khi = 160; nmt = 2; }
        __syncthreads();
#pragma unroll
        for (int it = 0; it < 3; ++it) {
            const int p = tid + 512 * it, key = p >> 3, ch = p & 7;
            v4u kk = {0u, 0u, 0u, 0u}, vv = {0u, 0u, 0u, 0u};
            if (key >= klo && key < khi) { const size_t off = (size_t)(kbase + key) * 512 + kvh * 64 + ch * 8; kk = *(const v4u*)(KB + off); vv = *(const v4u*)(VB + off); }
            *(LAS v4u*)(Ks + key * 144 + ch * 16) = kk;
            LAS unsigned short* vp = (LAS unsigned short*)(Vt + (ch * 8) * 392 + key * 2);
            vp[0 * 196] = (unsigned short)(vv.x & 0xffffu); vp[1 * 196] = (unsigned short)(vv.x >> 16); vp[2 * 196] = (unsigned short)(vv.y & 0xffffu); vp[3 * 196] = (unsigned short)(vv.y >> 16);
            vp[4 * 196] = (unsigned short)(vv.z & 0xffffu); vp[5 * 196] = (unsigned short)(vv.z >> 16); vp[6 * 196] = (unsigned short)(vv.w & 0xffffu); vp[7 * 196] = (unsigned short)(vv.w >> 16);
        }
        __syncthreads();
        const int head = kvh * 8 + wave; const float sink = sinks[head];
        for (int mt = 0; mt < nmt; ++mt) {
            const int qrow = qbase + 16 * mt + fr;
            const bf16* qp = Q + (size_t)qrow * D + head * 64 + 8 * fq;
            const bf16x8 q0 = *(const bf16x8*)qp, q1 = *(const bf16x8*)(qp + 32);
            f32x4 s[12]; float mx = sink;
#pragma unroll
            for (int nt = 0; nt < 12; ++nt) {
                const LAS unsigned char* kp = Ks + (16 * nt + fr) * 144 + fq * 16;
                const bf16x8 k0 = *(const LAS bf16x8*)kp, k1 = *(const LAS bf16x8*)(kp + 64);
                f32x4 a = {0.f, 0.f, 0.f, 0.f};
                a = __builtin_amdgcn_mfma_f32_16x16x32_bf16(k0, q0, a, 0, 0, 0);
                a = __builtin_amdgcn_mfma_f32_16x16x32_bf16(k1, q1, a, 0, 0, 0);
                if (16 * nt < klo || 16 * nt >= khi) a = (f32x4){-1e30f, -1e30f, -1e30f, -1e30f};
                s[nt] = a; mx = fmaxf(mx, fmaxf(fmaxf(a[0], a[1]), fmaxf(a[2], a[3])));
            }
            mx = fmaxf(mx, __shfl_xor(mx, 16)); mx = fmaxf(mx, __shfl_xor(mx, 32));
            float l = 0.f;
#pragma unroll
            for (int nt = 0; nt < 12; ++nt) {
#pragma unroll
                for (int i = 0; i < 4; ++i) { const float e = __builtin_amdgcn_exp2f((s[nt][i] - mx) * LOG2E); s[nt][i] = e; l += e; }
            }
            l += __shfl_xor(l, 16); l += __shfl_xor(l, 32); l += __builtin_amdgcn_exp2f((sink - mx) * LOG2E);
            f32x4 o[4];
#pragma unroll
            for (int dt = 0; dt < 4; ++dt) o[dt] = (f32x4){0.f, 0.f, 0.f, 0.f};
#pragma unroll
            for (int s6 = 0; s6 < 6; ++s6) {
                const pg8::u32x4 pw = pg8::pack8(s[2 * s6], s[2 * s6 + 1]); const bf16x8 pf = __builtin_bit_cast(bf16x8, pw);
#pragma unroll
                for (int dt = 0; dt < 4; ++dt) {
                    const LAS unsigned char* vp = Vt + (16 * dt + fr) * 392 + (32 * s6 + 4 * fq) * 2;
                    const v2u lo = *(const LAS v2u*)vp, hi = *(const LAS v2u*)(vp + 32);
                    const v4u vw = {lo.x, lo.y, hi.x, hi.y};
                    o[dt] = __builtin_amdgcn_mfma_f32_16x16x32_bf16(__builtin_bit_cast(bf16x8, vw), pf, o[dt], 0, 0, 0);
                }
            }
            const float inv = 1.0f / l; bf16* op = O + (size_t)qrow * D + head * 64 + 4 * fq;
#pragma unroll
            for (int dt = 0; dt < 4; ++dt) { v2u w; w.x = pg8::cvt_pk_bf16(o[dt][0] * inv, o[dt][1] * inv); w.y = pg8::cvt_pk_bf16(o[dt][2] * inv, o[dt][3] * inv); *(v2u*)(op + 16 * dt) = w; }
        }
    }
}

template <class Epi>
__device__ __forceinline__ void tail_phase(LAS unsigned char* lds, const bf16* A, const bf16* Bt, int K, int nN, int pn_off, unsigned* qhead, const Epi& E, int tid, int wave, int lane) {
    constexpr int PITCH = 528, OPB = 64 * PITCH, BUFB = 2 * OPB;
    const int fr = lane & 15, fq = lane >> 4;
    const int nc = K >> 8;
    LAS float* part = (LAS float*)(lds + wave * 17408);
    const int row_l = tid >> 3, cg = tid & 7;
    const int colA = Epi::TAIL_SPLIT ? 4 * cg : 8 * cg, colB = Epi::TAIL_SPLIT ? 32 + 4 * cg : 8 * cg + 4;
    const int lr = tid >> 5, lc = tid & 31;
    volatile LAS unsigned* tick = (volatile LAS unsigned*)(lds + MISC_OFF + 64);
    const int cnt = nN * 2;
    int xq = (int)(xb_xcc_id() & 7u), tries = 0;
    unsigned nextj = 0u;
    if (tid == 0) nextj = __hip_atomic_fetch_add(qhead + 16 * xq, 1u, __ATOMIC_RELAXED, __HIP_MEMORY_SCOPE_AGENT);
    for (;;) {
        if (tid == 0) tick[0] = nextj;
        __syncthreads();
        const int j = (int)tick[0];
        __syncthreads();
        if (j >= cnt) { if (++tries == 8) break; xq = (xq + 1) & 7; if (tid == 0) nextj = __hip_atomic_fetch_add(qhead + 16 * xq, 1u, __ATOMIC_RELAXED, __HIP_MEMORY_SCOPE_AGENT); continue; }
        tries = 0;
        if (tid == 0) nextj = __hip_atomic_fetch_add(qhead + 16 * xq, 1u, __ATOMIC_RELAXED, __HIP_MEMORY_SCOPE_AGENT);
        const int p = ((8 * (j >> 2) + xq) << 2) + (j & 3) + 16 * pn_off;
        const int rq = p & 3, q = (p >> 2) & 3, pn = p >> 4;
        pg8::f32x4 acc[4][4];
#pragma unroll
        for (int nb = 0; nb < 4; ++nb)
#pragma unroll
            for (int mb = 0; mb < 4; ++mb) acc[nb][mb] = (pg8::f32x4){0.f, 0.f, 0.f, 0.f};
        const bf16* ag = A + (size_t)(MP + 64 * rq + lr) * K + 8 * lc;
        const bf16* bg = Bt + (size_t)(256 * pn + 32 * q + (lr & 31)) * K + 8 * lc;
        v4u a0[4], b0[4], a1[4], b1[4];
#define TL_LOAD(ra, rb, c) do { const int cc_ = (c) < nc ? (c) : nc - 1; const size_t ko_ = (size_t)256 * cc_; _Pragma("unroll") for (int i = 0; i < 4; ++i) { \
            ra[i] = *(const v4u*)(ag + (size_t)(16 * i) * K + ko_); rb[i] = *(const v4u*)(bg + (size_t)(16 * (i & 1) + 128 * (i >> 1)) * K + ko_); } } while (0)
#define TL_WRITE(ra, rb, b) do { LAS unsigned char* d_ = lds + (b) * BUFB + lr * PITCH + lc * 16; _Pragma("unroll") for (int i = 0; i < 4; ++i) { \
            *(LAS v4u*)(d_ + 16 * i * PITCH) = ra[i]; *(LAS v4u*)(d_ + OPB + 16 * i * PITCH) = rb[i]; } } while (0)
#define TL_BAR() do { asm volatile("s_waitcnt lgkmcnt(0)" ::: "memory"); __builtin_amdgcn_s_barrier(); asm volatile("" ::: "memory"); } while (0)
#define TL_STEP(c, la, lb, wa, wb) do { TL_LOAD(la, lb, (c) + 2); TL_BAR(); \
            const LAS unsigned char* fb = lds + ((c) & 1) * BUFB + fr * PITCH + (32 * wave + 8 * fq) * 2; bf16x8 fa[4], fbv[4]; \
            _Pragma("unroll") for (int i = 0; i < 4; ++i) { fa[i] = *(const LAS bf16x8*)(fb + 16 * i * PITCH); fbv[i] = *(const LAS bf16x8*)(fb + OPB + 16 * i * PITCH); } \
            _Pragma("unroll") for (int nb = 0; nb < 4; ++nb) _Pragma("unroll") for (int mb = 0; mb < 4; ++mb) acc[nb][mb] = __builtin_amdgcn_mfma_f32_16x16x32_bf16(fbv[nb], fa[mb], acc[nb][mb], 0, 0, 0); \
            TL_WRITE(wa, wb, ((c) + 1) & 1); } while (0)
        TL_LOAD(a0, b0, 0); TL_LOAD(a1, b1, 1); TL_WRITE(a0, b0, 0);
        int c = 0;
        for (; c + 1 < nc; c += 2) { TL_STEP(c, a0, b0, a1, b1); TL_STEP(c + 1, a1, b1, a0, b0); }
        if (c < nc) TL_STEP(c, a0, b0, a1, b1);
#undef TL_STEP
#undef TL_BAR
#undef TL_LOAD
#undef TL_WRITE
        asm volatile("s_waitcnt vmcnt(0)" ::: "memory"); __syncthreads();
#pragma unroll
        for (int nb = 0; nb < 4; ++nb)
#pragma unroll
            for (int mb = 0; mb < 4; ++mb) *(LAS pg8::f32x4*)(part + (16 * mb + fr) * 68 + 16 * nb + 4 * fq) = acc[nb][mb];
        __syncthreads();
        pg8::f32x4 v0 = {0.f, 0.f, 0.f, 0.f}, v1 = {0.f, 0.f, 0.f, 0.f};
#pragma unroll
        for (int w = 0; w < 8; ++w) { const LAS float* t = (const LAS float*)(lds + w * 17408) + row_l * 68; v0 += *(const LAS pg8::f32x4*)(t + colA); v1 += *(const LAS pg8::f32x4*)(t + colB); }
        E.tail(MP + 64 * rq + row_l, cg, pn, q, v0, v1);
        __syncthreads();
    }
}

#ifndef NCONV
#define NCONV 80
#endif
#ifndef SAMPLE_MAIN_GU
#define SAMPLE_MAIN_GU 64
#endif
__global__ void __launch_bounds__(NWAVES * 64, 2) yoco_fwd(Args args) {
    extern __shared__ __attribute__((aligned(16))) unsigned char lds_raw[];
    LAS unsigned char* lds = (LAS unsigned char*)lds_raw;
    const int tid = threadIdx.x, lane = tid & 63, wave = __builtin_amdgcn_readfirstlane(tid >> 6);
    const int G = gridDim.x, bx = blockIdx.x, vcu = (G % 8 == 0) ? (bx % 8) * (G / 8) + bx / 8 : bx;
    unsigned char* ws = args.ws;
    for (int u = tid; u < (LDS_BYTES - LDSCTL_OFF) / 4; u += NWAVES * 64) ((LAS unsigned*)(lds + LDSCTL_OFF))[u] = 0u;
    __syncthreads();
    volatile LAS unsigned* MISC = (volatile LAS unsigned*)(lds + MISC_OFF);
    XcdBarrier bar; bar.bar = (unsigned*)ws + CW_BAR; bar.x = 0; bar.st = nullptr;
    if (MK_ONE_LAUNCH) bar = xcd_barrier_post((unsigned*)ws + CW_BAR, MISC + 8);
    const int lo = args.ph_lo, hi = args.ph_hi;
#define IN(k) (lo <= (k) && (k) < hi)
#define SEAM(k) do { if (MK_ONE_LAUNCH && IN((k) + 1)) xcd_barrier(bar); } while (0)
    bf16* const W1T = (bf16*)(ws + WS_W1T); bf16* const W2T = (bf16*)(ws + WS_W2T); bf16* const WGU0 = (bf16*)(ws + WS_WGU0); bf16* const WD0 = (bf16*)(ws + WS_WD0);
    bf16* const WQKV = (bf16*)(ws + WS_WQKV); bf16* const WOT = (bf16*)(ws + WS_WOT); bf16* const WGU1 = (bf16*)(ws + WS_WGU1); bf16* const WD1 = (bf16*)(ws + WS_WD1);
    bf16* const XB = (bf16*)(ws + WS_XB); bf16* const ACT = (bf16*)(ws + WS_ACT); bf16* const UV = (bf16*)(ws + WS_ACT);
    bf16* const ZQ = (bf16*)(ws + WS_ZQ); bf16* const OB = (bf16*)(ws + WS_O); bf16* const KB = (bf16*)(ws + WS_KB); bf16* const VB = (bf16*)(ws + WS_VB); bf16* const WSB = (bf16*)(ws + WS_WSB);
    unsigned char* const A8 = ws + WS_H; float* const rowscale = (float*)(ws + RS_OFF); const float* const cmax0 = (const float*)(ws + CM_OFF); const float* const cmax1 = (const float*)(ws + CM_OFF + CM_STRIDE);
    unsigned* const qheads = (unsigned*)ws + CW_Q;
    u64* const ssq_x = (u64*)(ws + ST_OFF); u64* const lnsum = (u64*)(ws + ST_OFF + ST_STRIDE); u64* const lnssq = (u64*)(ws + ST_OFF + 2 * ST_STRIDE);
    u64* const ssq_h1 = (u64*)(ws + ST_OFF + 3 * ST_STRIDE); u64* const ssq_h2 = (u64*)(ws + ST_OFF + 4 * ST_STRIDE); u64* const ssq_h3 = (u64*)(ws + ST_OFF + 5 * ST_STRIDE);

    const bool split = (G == 256) && (NCONV > 0);
    const int nconv = split ? NCONV : 0, ncomp = G - nconv;
    if (IN(0)) { absmax_pass(args, ws, vcu * NWAVES + wave, G * NWAVES, lane); if (!split && MK_ONE_LAUNCH) xcd_barrier(bar);
                 p0_prologue(args, ws, lds, vcu * NWAVES + wave, G * NWAVES, 0, split ? P0_ITEMS_A : P0_ITEMS_ALL, 1, wave, lane); SEAM(0); }
    if (IN(1)) {
        if (bx >= ncomp) { p0_prologue(args, ws, lds, (bx - ncomp) * NWAVES + wave, nconv * NWAVES, P0_ITEMS_A, P0_ITEMS_ALL, 0, wave, lane); __syncthreads(); }
        pg8::Gemm g{XB, W1T, MP, NSGU, D}; pg8::SplitOrder S; S.init(MP, NSGU, G, bx); S.nblk = ncomp; S.nhalf = 16;
        pg8::EpiSguIn E{UV, ssq_x, lnsum, lnssq};
        pg8::gemm_phase<pg8::EpiSguIn, pg8::SplitOrder, PG8_ALIGN, PG8_SP2>(lds, g, S, E);
        tail_phase(lds, XB, W1T, D, 32, 0, qheads + 0 * 128, E, tid, wave, lane);
        SEAM(1);
    }
    if (IN(2)) { sgu_phase(lds, UV, WSB, lnsum, lnssq, args.in[6], args.in[7], args.in[9], ZQ, args.out + pg8::OUT_SGUV, wave, lane); SEAM(2); }
    if (IN(3)) {
        pg8::Gemm g{ZQ, W2T, MP, D, D}; pg8::StaticOrder S; S.init(MP, D, G, bx);
        pg8::EpiRes<false, true, false> E{nullptr, nullptr, nullptr, XB, ssq_h1};
        pg8::gemm_phase<pg8::EpiRes<false, true, false>, pg8::StaticOrder, PG8_ALIGN, PG8_SP2>(lds, g, S, E);
        tail_phase(lds, ZQ, W2T, D, 16, 0, qheads + 1 * 128, E, tid, wave, lane);
        SEAM(3);
    }
    if (IN(4)) { quant_rows(XB, ssq_h1, A8, rowscale, vcu * NWAVES + wave, G * NWAVES, lane); SEAM(4); }
    if (IN(5)) {
        pg8::Gemm g{(const bf16*)A8, WGU0, M, NGU, D / 2}; pg8::ExtOrder S; S.init(MP, NGU, G, bx); S.nextra = 86;
        pg8::EpiSwigluI8 E{ACT, rowscale, cmax0};
        pg8::gemm_phase<pg8::EpiSwigluI8, pg8::ExtOrder, PG8_ALIGN, PG8_SP2>(lds, g, S, E);
        SEAM(5);
    }
    if (IN(6)) {
        pg8::Gemm g{ACT, WD0, MP, D, DFF}; pg8::StaticOrder S; S.init(MP, D, G, bx);
        pg8::EpiRes<false, true, false> E{nullptr, nullptr, nullptr, XB, ssq_h2};
        pg8::gemm_phase<pg8::EpiRes<false, true, false>, pg8::StaticOrder, PG8_ALIGN, PG8_SP2>(lds, g, S, E);
        tail_phase(lds, ACT, WD0, DFF, 16, 0, qheads + 3 * 128, E, tid, wave, lane);
        SEAM(6);
    }
    if (IN(7)) {
        pg8::Gemm g{XB, WQKV, MP, NQKV, D}; pg8::StaticOrder S; S.init(MP, NQKV, G, bx);
        pg8::EpiQKV E{KB, VB, ZQ, args.out, ssq_h2, args.in[13], args.in[16]};
        pg8::gemm_phase<pg8::EpiQKV, pg8::StaticOrder, PG8_ALIGN, PG8_SP2>(lds, g, S, E);
        tail_phase(lds, XB, WQKV, D, 20, 0, qheads + 4 * 128, E, tid, wave, lane);
        SEAM(7);
    }
    if (IN(8)) { attn_phase(lds, ZQ, KB, VB, args.in[17], OB, tid, wave, lane); SEAM(8); }
    if (IN(9)) {
        pg8::Gemm g{OB, WOT, MP, D, D}; pg8::StaticOrder S; S.init(MP, D, G, bx);
        pg8::EpiRes<false, true, false> E{nullptr, nullptr, nullptr, XB, ssq_h3};
        pg8::gemm_phase<pg8::EpiRes<false, true, false>, pg8::StaticOrder, PG8_ALIGN, PG8_SP2>(lds, g, S, E);
        tail_phase(lds, OB, WOT, D, 16, 0, qheads + 5 * 128, E, tid, wave, lane);
        SEAM(9);
    }
    if (IN(10)) { quant_rows(XB, ssq_h3, A8, rowscale, vcu * NWAVES + wave, G * NWAVES, lane); SEAM(10); }
    if (IN(11)) {
        pg8::Gemm g{(const bf16*)A8, WGU1, M, NGU, D / 2}; pg8::ExtOrder S; S.init(MP, NGU, G, bx); S.nextra = 86;
        pg8::EpiSwigluI8 E{ACT, rowscale, cmax1};
        pg8::gemm_phase<pg8::EpiSwigluI8, pg8::ExtOrder, PG8_ALIGN, PG8_SP2>(lds, g, S, E);
        SEAM(11);
    }
    if (IN(12)) {
        pg8::Gemm g{ACT, WD1, MP, D, DFF}; pg8::StaticOrder S; S.init(MP, D, G, bx);
        pg8::EpiRes<false, false, true> E{nullptr, nullptr, args.out, XB, nullptr};
        pg8::gemm_phase<pg8::EpiRes<false, false, true>, pg8::StaticOrder, PG8_ALIGN, PG8_SP2>(lds, g, S, E);
        tail_phase(lds, ACT, WD1, DFF, 16, 0, qheads + 7 * 128, E, tid, wave, lane);
    }
#undef IN
#undef SEAM
}

extern "C" void kernel_launch(void* const* d_in, const int* in_sizes, int n_in, void* d_out, int out_size, void* d_ws, size_t ws_size, hipStream_t stream) {
    static int grid = 0;
    if (grid == 0) {
        if (n_in != 23 || in_sizes[0] != MP * D || out_size != 36175872 || ws_size < WS_END) {
            fprintf(stderr, "kernel_launch: unexpected shapes (n_in %d, in0 %d, out %d, ws %zu); nothing launched\n", n_in, n_in > 0 ? in_sizes[0] : -1, out_size, ws_size); grid = -1; return; }
        int dev = 0, cus = 0, per_cu = 0;
        if (hipGetDevice(&dev) != hipSuccess || hipDeviceGetAttribute(&cus, hipDeviceAttributeMultiprocessorCount, dev) != hipSuccess) { fprintf(stderr, "kernel_launch: device query failed\n"); grid = -1; return; }
        if (hipFuncSetAttribute((const void*)yoco_fwd, hipFuncAttributeMaxDynamicSharedMemorySize, LDS_BYTES) != hipSuccess) { fprintf(stderr, "kernel_launch: hipFuncSetAttribute failed\n"); grid = -1; return; }
        if (hipOccupancyMaxActiveBlocksPerMultiprocessor(&per_cu, (const void*)yoco_fwd, NWAVES * 64, LDS_BYTES) != hipSuccess || per_cu < 1)
            fprintf(stderr, "kernel_launch: note: occupancy query reports %d workgroups per CU\n", per_cu);
        (void)hipGetLastError();
        grid = cus;
    }
    if (grid < 0) return;
    if (hipMemsetAsync((char*)d_ws + WS_CTL, 0, CTL_ZERO_BYTES, stream) != hipSuccess) { fprintf(stderr, "kernel_launch: memset failed\n"); return; }
    Args a{};
    for (int i = 0; i < 23; ++i) a.in[i] = (const float*)d_in[i];
    a.out = (float*)d_out; a.ws = (unsigned char*)d_ws;
#if MK_ONE_LAUNCH
    a.ph_lo = 0; a.ph_hi = NPHASES;
    hipLaunchKernelGGL(yoco_fwd, dim3(grid), dim3(NWAVES * 64), LDS_BYTES, stream, a);
#else
    for (int p = 0; p < NPHASES; ++p) { a.ph_lo = p; a.ph_hi = p + 1; hipLaunchKernelGGL(yoco_fwd, dim3(grid), dim3(NWAVES * 64), LDS_BYTES, stream, a); }
#endif
    const hipError_t le = hipPeekAtLastError();
    if (le != hipSuccess) fprintf(stderr, "kernel_launch: launch failed: %s\n", hipGetErrorName(le));
}
```

```cpp
#include <hip/hip_runtime.h>
#include <cstdio>
#include <cstdint>
#define MK_ONE_LAUNCH 1
namespace pg8 {
#define PG8_LAS __attribute__((address_space(3)))
typedef unsigned short bf16_t;
typedef short bf16x8 __attribute__((ext_vector_type(8)));
typedef float f32x4 __attribute__((ext_vector_type(4)));
typedef unsigned u32x4 __attribute__((ext_vector_type(4)));
constexpr int BM = 256, BK = 64, HALF = 128, HTB = HALF * BK * 2  , STAGE_BYTES = 8 * HTB, NXCD = 8, WGM = 8;

__host__ __device__ __forceinline__ int lds_byte(int r, int c) { const int st = (r >> 4) * 2 + (c >> 5), rr = r & 15, cc = c & 31, ob = rr * 64 + cc * 2; return st * 1024 + (ob ^ (((ob >> 9) & 1) << 5)); }
__host__ __device__ __forceinline__ void stage_rc(int b, int& R, int& C) { const int st = b / 1024, sb = b % 1024, swz = sb ^ (((sb >> 9) & 1) << 5); R = (st >> 1) * 16 + swz / 64; C = (st & 1) * 32 + (swz % 64) / 2; }
__host__ __device__ __forceinline__ int perm32(int rho) { const int n = rho >> 4, i = rho & 15; return 8 * (i >> 2) + 4 * n + (i & 3); }

struct Unit { int pm, pn; };
struct Gemm { const bf16_t* A; const bf16_t* Bt; int M, N, K; int ablk, bblk; };
__host__ __device__ __forceinline__ size_t blk_byte(int r, int k, int K) { return (size_t)(r >> 8) * K * 512 + (size_t)(k >> 6) * 32768 + ((r >> 7) & 1) * 16384 + lds_byte(r & 127, k & 63); }

struct StaticOrder {
    int nM, nN, nwg, G, c;
    __host__ __device__ void init(int M, int N, int G_, int c_) { nM = M / BM; nN = N / BM; nwg = nM * nN; G = G_; c = c_; }
    __host__ __device__ bool next(int i, Unit& u) const {
        const long L = (long)i * G + c; if (L >= nwg) return false;
        int wgid = (int)L; { const int q = nwg / NXCD, r = nwg % NXCD, xcd = wgid % NXCD, off = wgid / NXCD; wgid = (xcd < r ? xcd * (q + 1) : r * (q + 1) + (xcd - r) * q) + off; }
        const int nig = WGM * nN, gid = wgid / nig, fm = gid * WGM, gsz = (nM - fm) < WGM ? (nM - fm) : WGM;
        u.pm = fm + ((wgid % nig) % gsz); u.pn = (wgid % nig) / gsz; return true;
    }
    __device__ __forceinline__ void a_ready(const Unit&) const {}
    __device__ __forceinline__ void done(const Unit&) const {}
};

__device__ __forceinline__ unsigned cvt_pk_bf16(float lo, float hi) { unsigned r; asm volatile("v_cvt_pk_bf16_f32 %0, %1, %2" : "=v"(r) : "v"(lo), "v"(hi)); return r; }
typedef float f32x2 __attribute__((ext_vector_type(2)));
__device__ __forceinline__ f32x2 gelu_pk(f32x2 v) {
    const f32x2 av = __builtin_elementwise_abs(v), d = av * 0.2316418882f + 1.0f;
    f32x2 t; t.x = __builtin_amdgcn_rcpf(d.x); t.y = __builtin_amdgcn_rcpf(d.y);
    f32x2 q = t * 0.5307027145f + (-0.7265760135f); q = q * t + 0.7107068705f; q = q * t + (-0.142248368f); q = q * t + 0.127414796f; q = q * t;
    const f32x2 s = (v * v) * (-0.72134752044f);
    f32x2 e; e.x = __builtin_amdgcn_exp2f(s.x); e.y = __builtin_amdgcn_exp2f(s.y);
    const f32x2 m = v * (q * e), r = v - m;
    f32x2 o; o.x = v.x < 0.f ? m.x : r.x; o.y = v.y < 0.f ? m.y : r.y; return o;
}


struct SplitOrder : StaticOrder {
    int nblk; int nhalf; int nextra;
    __device__ bool next(int i, Unit& u) const {
        if (c >= nblk) return false;
        const long L = (long)i * nblk + c; if (L >= nwg + nextra) return false;
        if (L >= nwg) { u.pm = 32; u.pn = (int)(L - nwg); return true; }
        int wgid = (int)L; { const int q = nwg / NXCD, r = nwg % NXCD, xcd = wgid % NXCD, off = wgid / NXCD; wgid = (xcd < r ? xcd * (q + 1) : r * (q + 1) + (xcd - r) * q) + off; }
        const int nig = WGM * nN, gid = wgid / nig, fm = gid * WGM, gsz = (nM - fm) < WGM ? (nM - fm) : WGM;
        u.pm = fm + ((wgid % nig) % gsz); u.pn = (wgid % nig) / gsz; if (nhalf) u.pn = (u.pn & 1) * nhalf + (u.pn >> 1); return true;
    }
};
typedef unsigned long long u64;
constexpr float FIX_SCALE = 16777216.0f, FIX_INV = 1.0f / 16777216.0f;
__device__ __forceinline__ u64 f2fixu(float v) { return (u64)(v * FIX_SCALE); }
__device__ __forceinline__ u64 f2fixs(float v) { return (u64)(long long)(v * FIX_SCALE); }
__device__ __forceinline__ void fix_add(u64* p, u64 v) { (void)__hip_atomic_fetch_add(p, v, __ATOMIC_RELAXED, __HIP_MEMORY_SCOPE_AGENT); }
__device__ __forceinline__ float rstd_of(const u64* ssq, int row) { return rsqrtf((float)ssq[row] * (FIX_INV * (1.0f / 4096.0f)) + 1e-6f); }
__device__ __forceinline__ float sum4(const f32x4& v) { return (v[0] + v[1]) + (v[2] + v[3]); }
__device__ __forceinline__ float ssq4(const f32x4& v) { return (v[0] * v[0] + v[1] * v[1]) + (v[2] * v[2] + v[3] * v[3]); }
__device__ __forceinline__ u32x4 pack8(const f32x4& a, const f32x4& b) { u32x4 w; w.x = cvt_pk_bf16(a[0], a[1]); w.y = cvt_pk_bf16(a[2], a[3]); w.z = cvt_pk_bf16(b[0], b[1]); w.w = cvt_pk_bf16(b[2], b[3]); return w; }

template <bool I8> struct AccSel { typedef f32x4 T; };
template <> struct AccSel<true> { typedef int T __attribute__((ext_vector_type(4))); };
struct EpiSguIn {
    typedef f32x4 AccT;
    static constexpr bool PERM = true, AFTER_DRAIN = false;
    bf16_t* UV; const u64* ssq; u64* lnsum; u64* lnssq;
    __device__ __forceinline__ void operator()(const f32x4 (&acc)[2][2][4][2], const Unit& u, int wr, int wc, int fr, int fq) const {
        const int row0 = u.pm * BM + wr * 64 + fr, col0 = u.pn * BM + wc * 32 + 8 * fq;
        const bool isv = u.pn >= 16;
        float rs[2][4];
#pragma unroll
        for (int ai = 0; ai < 2; ++ai)
#pragma unroll
            for (int m = 0; m < 4; ++m) rs[ai][m] = rstd_of(ssq, row0 + ai * HALF + m * 16);
#pragma unroll
        for (int ai = 0; ai < 2; ++ai)
#pragma unroll
            for (int m = 0; m < 4; ++m) {
                const int row = row0 + ai * HALF + m * 16;
                float s1 = 0.f, s2 = 0.f;
                bf16_t* rowp = UV + (size_t)row * 8192 + col0;
#pragma unroll
                for (int bj = 0; bj < 2; ++bj) {
                    f32x4 v0 = acc[ai][bj][m][0] * rs[ai][m], v1 = acc[ai][bj][m][1] * rs[ai][m];
                    if (isv) {
                        const f32x2 a = gelu_pk((f32x2){v0[0], v0[1]}), b = gelu_pk((f32x2){v0[2], v0[3]}), c = gelu_pk((f32x2){v1[0], v1[1]}), d = gelu_pk((f32x2){v1[2], v1[3]});
                        v0 = (f32x4){a.x, a.y, b.x, b.y}; v1 = (f32x4){c.x, c.y, d.x, d.y};
                        s1 += sum4(v0) + sum4(v1); s2 += ssq4(v0) + ssq4(v1); }
                    *(u32x4*)(rowp + bj * HALF) = pack8(v0, v1);
                }
                if (isv) {
                    s1 += __shfl_xor(s1, 16); s1 += __shfl_xor(s1, 32); s2 += __shfl_xor(s2, 16); s2 += __shfl_xor(s2, 32);
                    if (fq == 0) { fix_add(lnsum + row, f2fixs(s1)); fix_add(lnssq + row, f2fixu(s2)); }
                }
            }
    }
    static constexpr bool TAIL_SPLIT = false;
    __device__ __forceinline__ void tail(int row, int cg, int pn, int q, f32x4 v0, f32x4 v1) const {
        const int col = pn * BM + (cg >> 2) * HALF + q * 32 + 8 * (cg & 3);
        const float rs = rstd_of(ssq, row);
        v0 = v0 * rs; v1 = v1 * rs;
        if (pn >= 16) { const f32x2 a = gelu_pk((f32x2){v0[0], v0[1]}), b = gelu_pk((f32x2){v0[2], v0[3]}), c = gelu_pk((f32x2){v1[0], v1[1]}), d = gelu_pk((f32x2){v1[2], v1[3]});
            v0 = (f32x4){a.x, a.y, b.x, b.y}; v1 = (f32x4){c.x, c.y, d.x, d.y}; }
        *(u32x4*)(UV + (size_t)row * 8192 + col) = pack8(v0, v1);
        if (pn >= 16) {
            float s1 = sum4(v0) + sum4(v1), s2 = ssq4(v0) + ssq4(v1);
            s1 += __shfl_xor(s1, 1); s1 += __shfl_xor(s1, 2); s1 += __shfl_xor(s1, 4); s2 += __shfl_xor(s2, 1); s2 += __shfl_xor(s2, 2); s2 += __shfl_xor(s2, 4);
            if (cg == 0) { fix_add(lnsum + row, f2fixs(s1)); fix_add(lnssq + row, f2fixu(s2)); }
        }
    }
};
template <bool RES_F32, bool XBOUT, bool OUT_F32, bool I8 = false> struct EpiRes {
    typedef typename AccSel<I8>::T AccT;
    static constexpr bool PERM = true, AFTER_DRAIN = false;
    const float* res; const float* res_hi; float* out; bf16_t* XB; u64* ssq_out; const float* rowscale; const float* cmo;
    __device__ __forceinline__ static f32x4 lo4(const u32x4& w) { return (f32x4){__builtin_bit_cast(float, w.x << 16), __builtin_bit_cast(float, w.x & 0xffff0000u), __builtin_bit_cast(float, w.y << 16), __builtin_bit_cast(float, w.y & 0xffff0000u)}; }
    __device__ __forceinline__ static f32x4 hi4(const u32x4& w) { return (f32x4){__builtin_bit_cast(float, w.z << 16), __builtin_bit_cast(float, w.z & 0xffff0000u), __builtin_bit_cast(float, w.w << 16), __builtin_bit_cast(float, w.w & 0xffff0000u)}; }
    __device__ __forceinline__ void operator()(const AccT (&acc)[2][2][4][2], const Unit& u, int wr, int wc, int fr, int fq) const {
        const int row0 = u.pm * BM + wr * 64 + fr, col0 = u.pn * BM + wc * 32 + 8 * fq;
        const float* rbase = u.pm < 32 ? res : res_hi;
        f32x4 cw[2][2];
#pragma unroll
        for (int bj = 0; bj < 2; ++bj)
#pragma unroll
            for (int n = 0; n < 2; ++n) cw[bj][n] = I8 ? *(const f32x4*)(cmo + col0 + bj * HALF + 4 * n) * (1.0f / 127.0f) : (f32x4){1.f, 1.f, 1.f, 1.f};
#pragma unroll
        for (int ai = 0; ai < 2; ++ai) {
            f32x4 r[4][2][2]; float rsv[4];
#pragma unroll
            for (int m = 0; m < 4; ++m) rsv[m] = I8 ? rowscale[row0 + ai * HALF + m * 16] : 1.0f;
#pragma unroll
            for (int m = 0; m < 4; ++m) { const size_t off = (size_t)(row0 + ai * HALF + m * 16) * 4096 + col0;
#pragma unroll
                for (int bj = 0; bj < 2; ++bj) {
                    if (RES_F32) { r[m][bj][0] = *(const f32x4*)(rbase + off + bj * HALF); r[m][bj][1] = *(const f32x4*)(rbase + off + bj * HALF + 4); }
                    else { const u32x4 w = *(const u32x4*)(XB + off + bj * HALF); r[m][bj][0] = lo4(w); r[m][bj][1] = hi4(w); } } }
#pragma unroll
            for (int m = 0; m < 4; ++m) { const int row = row0 + ai * HALF + m * 16; const size_t off = (size_t)row * 4096 + col0; float ss = 0.f;
#pragma unroll
                for (int bj = 0; bj < 2; ++bj) { f32x4 o0, o1;
                    if constexpr (I8) { o0 = r[m][bj][0] + __builtin_convertvector(acc[ai][bj][m][0], f32x4) * cw[bj][0] * rsv[m]; o1 = r[m][bj][1] + __builtin_convertvector(acc[ai][bj][m][1], f32x4) * cw[bj][1] * rsv[m]; }
                    else { o0 = r[m][bj][0] + acc[ai][bj][m][0]; o1 = r[m][bj][1] + acc[ai][bj][m][1]; }
                    if (OUT_F32) { *(f32x4*)(out + off + bj * HALF) = o0; *(f32x4*)(out + off + bj * HALF + 4) = o1; }
                    if (XBOUT) { *(u32x4*)(XB + off + bj * HALF) = pack8(o0, o1); ss += ssq4(o0) + ssq4(o1); } }
                if (XBOUT) { ss += __shfl_xor(ss, 16); ss += __shfl_xor(ss, 32); if (fq == 0) fix_add(ssq_out + row, f2fixu(ss)); } }
            asm volatile("" ::: "memory");
        }
    }
    static constexpr bool TAIL_SPLIT = false;
    __device__ __forceinline__ void tail(int row, int cg, int pn, int q, f32x4 v0, f32x4 v1) const {
        const size_t off = (size_t)row * 4096 + pn * BM + (cg >> 2) * HALF + q * 32 + 8 * (cg & 3);
        if constexpr (I8) { const float rs = rowscale[row] * (1.0f / 127.0f); const float* cp = cmo + pn * BM + (cg >> 2) * HALF + q * 32 + 8 * (cg & 3); v0 = v0 * *(const f32x4*)cp * rs; v1 = v1 * *(const f32x4*)(cp + 4) * rs; }
        f32x4 r0, r1;
        if (RES_F32) { r0 = *(const f32x4*)(res_hi + off); r1 = *(const f32x4*)(res_hi + off + 4); }
        else { const u32x4 w = *(const u32x4*)(XB + off); r0 = lo4(w); r1 = hi4(w); }
        const f32x4 o0 = r0 + v0, o1 = r1 + v1;
        if (OUT_F32) { *(f32x4*)(out + off) = o0; *(f32x4*)(out + off + 4) = o1; }
        if (XBOUT) {
            *(u32x4*)(XB + off) = pack8(o0, o1);
            float ss = ssq4(o0) + ssq4(o1); ss += __shfl_xor(ss, 1); ss += __shfl_xor(ss, 2); ss += __shfl_xor(ss, 4);
            if (cg == 0) fix_add(ssq_out + row, f2fixu(ss));
        }
    }
};
struct EpiSwiglu {
    typedef f32x4 AccT;
    static constexpr bool PERM = true, AFTER_DRAIN = false;
    bf16_t* ACT; const u64* ssq;
    __device__ __forceinline__ void operator()(const f32x4 (&acc)[2][2][4][2], const Unit& u, int wr, int wc, int fr, int fq) const {
        const int row0 = u.pm * BM + wr * 64 + fr, col0 = u.pn * HALF + wc * 32 + 8 * fq;
        float rs[2][4];
#pragma unroll
        for (int ai = 0; ai < 2; ++ai)
#pragma unroll
            for (int m = 0; m < 4; ++m) rs[ai][m] = rstd_of(ssq, row0 + ai * HALF + m * 16);
#pragma unroll
        for (int ai = 0; ai < 2; ++ai)
#pragma unroll
            for (int m = 0; m < 4; ++m) {
                const int row = row0 + ai * HALF + m * 16; f32x4 o[2];
#pragma unroll
                for (int n = 0; n < 2; ++n) { const f32x4 g = acc[ai][0][m][n] * rs[ai][m], up = acc[ai][1][m][n] * rs[ai][m];
#pragma unroll
                    for (int j = 0; j < 4; ++j) o[n][j] = g[j] * __builtin_amdgcn_rcpf(1.0f + __builtin_amdgcn_exp2f(-1.44269504f * g[j])) * up[j]; }
                *(u32x4*)(ACT + (size_t)row * 11008 + col0) = pack8(o[0], o[1]);
            }
    }
    static constexpr bool TAIL_SPLIT = true;
    __device__ __forceinline__ void tail(int row, int cg, int pn, int q, f32x4 g, f32x4 up) const {
        const float rs = rstd_of(ssq, row);
        g = g * rs; up = up * rs; f32x4 o;
#pragma unroll
        for (int j = 0; j < 4; ++j) o[j] = g[j] * __builtin_amdgcn_rcpf(1.0f + __builtin_amdgcn_exp2f(-1.44269504f * g[j])) * up[j];
        typedef unsigned u32x2t __attribute__((ext_vector_type(2)));
        u32x2t w; w.x = cvt_pk_bf16(o[0], o[1]); w.y = cvt_pk_bf16(o[2], o[3]);
        *(u32x2t*)(ACT + (size_t)row * 11008 + pn * HALF + q * 32 + 4 * cg) = w;
    }
};

struct EpiSwigluI8 {
    typedef int i32x4 __attribute__((ext_vector_type(4)));
    typedef i32x4 AccT;
    static constexpr bool PERM = true, AFTER_DRAIN = false, TAIL_SPLIT = true;
    bf16_t* ACT; const float* rowscale; const float* colmax;
    __device__ __forceinline__ void operator()(const i32x4 (&acc)[2][2][4][2], const Unit& u, int wr, int wc, int fr, int fq) const {
        const int row0 = u.pm * BM + wr * 64 + fr, col0 = u.pn * HALF + wc * 32 + 8 * fq, bcol = u.pn * BM + wc * 32 + 8 * fq;
        f32x4 cw[2][2];
#pragma unroll
        for (int bj = 0; bj < 2; ++bj)
#pragma unroll
            for (int n = 0; n < 2; ++n) cw[bj][n] = *(const f32x4*)(colmax + bcol + bj * HALF + 4 * n) * (1.0f / 127.0f);
        float rs[2][4];
#pragma unroll
        for (int ai = 0; ai < 2; ++ai)
#pragma unroll
            for (int m = 0; m < 4; ++m) rs[ai][m] = rowscale[row0 + ai * HALF + m * 16];
#pragma unroll
        for (int ai = 0; ai < 2; ++ai)
#pragma unroll
            for (int m = 0; m < 4; ++m) {
                const int row = row0 + ai * HALF + m * 16; f32x4 o[2];
#pragma unroll
                for (int n = 0; n < 2; ++n) {
#pragma unroll
                    for (int j = 0; j < 4; ++j) { const float g = (float)acc[ai][0][m][n][j] * rs[ai][m] * cw[0][n][j], up = (float)acc[ai][1][m][n][j] * rs[ai][m] * cw[1][n][j];
                        o[n][j] = g * __builtin_amdgcn_rcpf(1.0f + __builtin_amdgcn_exp2f(-1.44269504f * g)) * up; } }
                *(u32x4*)((char*)ACT + blk_byte(row, col0, 11008)) = pack8(o[0], o[1]);
            }
    }
    __device__ __forceinline__ void tail(int row, int cg, int pn, int q, f32x4 g, f32x4 up) const {
        const float rs = rowscale[row] * (1.0f / 127.0f);
        const f32x4 cgv = *(const f32x4*)(colmax + pn * BM + q * 32 + 4 * cg), cuv = *(const f32x4*)(colmax + pn * BM + HALF + q * 32 + 4 * cg);
        g = g * cgv * rs; up = up * cuv * rs; f32x4 o;
#pragma unroll
        for (int j = 0; j < 4; ++j) o[j] = g[j] * __builtin_amdgcn_rcpf(1.0f + __builtin_amdgcn_exp2f(-1.44269504f * g[j])) * up[j];
        typedef unsigned u32x2t __attribute__((ext_vector_type(2)));
        u32x2t w; w.x = cvt_pk_bf16(o[0], o[1]); w.y = cvt_pk_bf16(o[2], o[3]);
        *(u32x2t*)((char*)ACT + blk_byte(row, pn * HALF + q * 32 + 4 * cg, 11008)) = w;
    }
};
constexpr size_t OUT_KP = 34603008, OUT_VP = 34734080, OUT_KS = 34865152, OUT_VS = 34996224, OUT_SGUV = 35127296;
template <bool I8> struct EpiQKVT {
    typedef int i32x4_t __attribute__((ext_vector_type(4)));
    typedef typename AccSel<I8>::T AccT;
    static constexpr bool PERM = true, AFTER_DRAIN = false;
    bf16_t *KB, *VB, *QB; float* out; const u64* ssq; const float* kg; const float* qg; const float* rowscale; const float* cmq;
    __device__ __forceinline__ void operator()(const AccT (&acc)[2][2][4][2], const Unit& u, int wr, int wc, int fr, int fq) const {
        const int row0 = u.pm * BM + wr * 64 + fr;
        const bool isk = u.pn < 2, isq = u.pn >= 4, isv = !isk && !isq;
        const int hidx = (isk ? u.pn : (isq ? u.pn - 4 : u.pn - 2)) * 4 + wc;
        bf16_t* const kvb = isk ? KB : VB; const size_t o_s = isk ? OUT_KS : OUT_VS, o_p = isk ? OUT_KP : OUT_VP;
        const float* gp = (u.pn < 2) ? kg : qg;
        f32x4 gv[2][2];
#pragma unroll
        for (int bj = 0; bj < 2; ++bj)
#pragma unroll
            for (int n = 0; n < 2; ++n) gv[bj][n] = *(const f32x4*)(gp + 32 * bj + 8 * fq + 4 * n);
        const float gs = isq ? 0.125f : 1.0f;
        float rs[2][4];
#pragma unroll
        for (int ai = 0; ai < 2; ++ai)
#pragma unroll
            for (int m = 0; m < 4; ++m) rs[ai][m] = I8 ? rowscale[row0 + ai * HALF + m * 16] : rstd_of(ssq, row0 + ai * HALF + m * 16);
        f32x4 cw[2][2];
#pragma unroll
        for (int bj = 0; bj < 2; ++bj)
#pragma unroll
            for (int n = 0; n < 2; ++n) cw[bj][n] = I8 ? *(const f32x4*)(cmq + u.pn * BM + bj * HALF + wc * 32 + 8 * fq + 4 * n) * (1.0f / 127.0f) : (f32x4){1.f, 1.f, 1.f, 1.f};
#pragma unroll
        for (int ai = 0; ai < 2; ++ai)
#pragma unroll
            for (int m = 0; m < 4; ++m) {
                const int row = row0 + ai * HALF + m * 16;
                f32x4 t[2][2]; float ss = 0.f;
#pragma unroll
                for (int bj = 0; bj < 2; ++bj)
#pragma unroll
                    for (int n = 0; n < 2; ++n) { if constexpr (I8) t[bj][n] = __builtin_convertvector(acc[ai][bj][m][n], f32x4) * cw[bj][n] * rs[ai][m]; else t[bj][n] = acc[ai][bj][m][n] * rs[ai][m]; ss += ssq4(t[bj][n]); }
                if (!isv) {
                    ss += __shfl_xor(ss, 16); ss += __shfl_xor(ss, 32);
                    const float r = rsqrtf(ss * (1.0f / 64.0f) + 1e-6f) * gs;
#pragma unroll
                    for (int bj = 0; bj < 2; ++bj)
#pragma unroll
                        for (int n = 0; n < 2; ++n) t[bj][n] = t[bj][n] * r * gv[bj][n];
                }
                if (isq) {
                    bf16_t* p = QB + (size_t)row * 4096 + hidx * 64 + 8 * fq;
#pragma unroll
                    for (int bj = 0; bj < 2; ++bj) *(u32x4*)(p + 32 * bj) = pack8(t[bj][0], t[bj][1]);
                } else {
                    const int kr = row < 8192 ? row : 8192 + 160 * ((row - 8192) >> 5) + 128 + ((row - 8192) & 31);
                    bf16_t* p = kvb + (size_t)kr * 512 + hidx * 64 + 8 * fq;
#pragma unroll
                    for (int bj = 0; bj < 2; ++bj) *(u32x4*)(p + 32 * bj) = pack8(t[bj][0], t[bj][1]);
                    float* op = nullptr;
                    if (row >= 8192) op = out + o_s + (size_t)(row - 8192) * 512 + hidx * 64 + 8 * fq;
                    else { const int tt = row & 4095; if (tt >= 3968) op = out + o_p + (size_t)((row >> 12) * 128 + tt - 3968) * 512 + hidx * 64 + 8 * fq; }
                    if (op) {
#pragma unroll
                        for (int bj = 0; bj < 2; ++bj) { *(f32x4*)(op + 32 * bj) = t[bj][0]; *(f32x4*)(op + 32 * bj + 4) = t[bj][1]; }
                    }
                }
            }
    }
    static constexpr bool TAIL_SPLIT = false;
    __device__ __forceinline__ void tail(int row, int cg, int pn, int q, f32x4 v0, f32x4 v1) const {
        const bool isk = pn < 2, isq = pn >= 4, isv = !isk && !isq;
        const int hidx = (isk ? pn : (isq ? pn - 4 : pn - 2)) * 4 + q;
        const float rs = I8 ? rowscale[row] * (1.0f / 127.0f) : rstd_of(ssq, row);
        v0 = v0 * rs; v1 = v1 * rs;
        if constexpr (I8) { const float* cp = cmq + pn * BM + ((8 * cg) >> 5) * HALF + q * 32 + ((8 * cg) & 31); v0 = v0 * *(const f32x4*)cp; v1 = v1 * *(const f32x4*)(cp + 4); }
        if (!isv) {
            const float* gp = isk ? kg : qg;
            const f32x4 g0 = *(const f32x4*)(gp + 8 * cg), g1 = *(const f32x4*)(gp + 8 * cg + 4);
            float ss = ssq4(v0) + ssq4(v1); ss += __shfl_xor(ss, 1); ss += __shfl_xor(ss, 2); ss += __shfl_xor(ss, 4);
            const float r = rsqrtf(ss * (1.0f / 64.0f) + 1e-6f) * (isq ? 0.125f : 1.0f);
            v0 = v0 * r * g0; v1 = v1 * r * g1;
        }
        if (isq) { *(u32x4*)(QB + (size_t)row * 4096 + hidx * 64 + 8 * cg) = pack8(v0, v1); }
        else {
            const int kr = 8192 + 160 * ((row - 8192) >> 5) + 128 + ((row - 8192) & 31);
            *(u32x4*)((isk ? KB : VB) + (size_t)kr * 512 + hidx * 64 + 8 * cg) = pack8(v0, v1);
            float* op = out + (isk ? OUT_KS : OUT_VS) + (size_t)(row - 8192) * 512 + hidx * 64 + 8 * cg;
            *(f32x4*)op = v0; *(f32x4*)(op + 4) = v1;
        }
    }
};
typedef EpiQKVT<false> EpiQKV;
struct QOrder : StaticOrder {
    __device__ bool next(int i, Unit& u) const {
        long L;
        if (G != 256) { L = (long)i * G + c; if (L >= nwg) return false; }
        else if (c >= 128) { if (i >= 3) return false; L = (long)i * 128 + (c - 128); } else { if (i >= 1) return false; L = 384 + c; }
        int wgid = (int)L; { const int q = nwg / NXCD, r = nwg % NXCD, xcd = wgid % NXCD, off = wgid / NXCD; wgid = (xcd < r ? xcd * (q + 1) : r * (q + 1) + (xcd - r) * q) + off; }
        const int nig = WGM * nN, gid = wgid / nig, fm = gid * WGM, gsz = (nM - fm) < WGM ? (nM - fm) : WGM;
        u.pm = fm + ((wgid % nig) % gsz); u.pn = 4 + (wgid % nig) / gsz; return true;
    }
};
typedef int i32x4 __attribute__((ext_vector_type(4)));
__device__ __forceinline__ f32x4 mma16(bf16x8 a, bf16x8 b, f32x4 c) { return __builtin_amdgcn_mfma_f32_16x16x32_bf16(a, b, c, 0, 0, 0); }
__device__ __forceinline__ i32x4 mma16(bf16x8 a, bf16x8 b, i32x4 c) { return __builtin_amdgcn_mfma_i32_16x16x64_i8(__builtin_bit_cast(i32x4, a), __builtin_bit_cast(i32x4, b), c, 0, 0, 0); }
template <class Epi, class Sched, bool ALIGN_EPI = false, bool SP2 = false>
__device__ __forceinline__ void gemm_phase(PG8_LAS unsigned char* lds, const Gemm g, const Sched& S, const Epi& E) {
    const int tid = threadIdx.x, wid = __builtin_amdgcn_readfirstlane(tid >> 6), lane = tid & 63, wr = wid >> 2, wc = wid & 3, fr = lane & 15, fq = lane >> 4;
    const int K = g.K, nt = K / BK;
    unsigned voffA[2], voffB[2];
#pragma unroll
    for (int i = 0; i < 2; ++i) { int R, C; stage_rc(tid * 16 + i * 8192, R, C); const int Rb = Epi::PERM ? ((R & ~31) + perm32(R & 31)) : R;
        voffA[i] = g.ablk ? (unsigned)lds_byte(R, C) : (unsigned)(R * K + C) * 2u; voffB[i] = g.bblk ? (unsigned)lds_byte(Rb, C) : (unsigned)(Rb * K + C) * 2u; }
    const size_t kA = g.ablk ? (size_t)32768 : (size_t)(BK * 2), kB = g.bblk ? (size_t)32768 : (size_t)(BK * 2);
    const size_t hA = g.ablk ? (size_t)16384 : (size_t)HALF * K * 2, hB = g.bblk ? (size_t)16384 : (size_t)HALF * K * 2;
    const size_t tstep = (size_t)2 * HALF * K * 2;
    const unsigned ldsw = (unsigned)wid * 1024u;
    const int aoff = lds_byte(wr * 64 + fr, fq * 8), boff = lds_byte(wc * 32 + fr, fq * 8);
#define PG8_SA(b, h) (((b) * 2 + (h)) * HTB)
#define PG8_SB(b, h) ((4 + (b) * 2 + (h)) * HTB)
#define PG8_STAGE(bufoff, gbase, voff) do { _Pragma("unroll") for (int _i = 0; _i < 2; ++_i) \
        __builtin_amdgcn_global_load_lds((const unsigned*)((const char*)(gbase) + (voff)[_i]), (PG8_LAS unsigned*)(lds + (bufoff) + ldsw + _i * 8192), 16, 0, 0); } while (0)
#define PG8_LDA(dst, b, h) do { _Pragma("unroll") for (int m = 0; m < 4; ++m) _Pragma("unroll") for (int k = 0; k < 2; ++k) dst[m][k] = *(const PG8_LAS bf16x8*)(lds + PG8_SA(b, h) + aoff + m * 2048 + k * 1024); } while (0)
#define PG8_LDB(dst, b, h) do { _Pragma("unroll") for (int n = 0; n < 2; ++n) _Pragma("unroll") for (int k = 0; k < 2; ++k) dst[n][k] = *(const PG8_LAS bf16x8*)(lds + PG8_SB(b, h) + boff + n * 2048 + k * 1024); } while (0)
#define PG8_MMA(ai, bj, At, Bt) do { __builtin_amdgcn_s_setprio(1); _Pragma("unroll") for (int m = 0; m < 4; ++m) _Pragma("unroll") for (int n = 0; n < 2; ++n) _Pragma("unroll") for (int k = 0; k < 2; ++k) \
        acc[ai][bj][m][n] = mma16(Bt[n][k], At[m][k], acc[ai][bj][m][n]); __builtin_amdgcn_s_setprio(0); } while (0)
#define PG8_WAIT_V(n) asm volatile("s_waitcnt vmcnt(" #n ")" ::: "memory")
#define PG8_WAIT_L(n) asm volatile("s_waitcnt lgkmcnt(" #n ")" ::: "memory")
#define PG8_BAR __builtin_amdgcn_s_barrier()
#define PG8_SCHED __builtin_amdgcn_sched_barrier(0)
    Unit cur, nxt; int ui = 0;
    if (!S.next(0, cur)) return;
    typedef typename Epi::AccT AccT;
    AccT acc[2][2][4][2];
#pragma unroll
    for (int a = 0; a < 2; ++a)
#pragma unroll
        for (int b = 0; b < 2; ++b)
#pragma unroll
            for (int m = 0; m < 4; ++m)
#pragma unroll
                for (int n = 0; n < 2; ++n) acc[a][b][m][n] = (AccT){0, 0, 0, 0};
    bf16x8 At[4][2], B0[2][2], B1[2][2];
    const char* cA = (const char*)g.A + (size_t)cur.pm * tstep; const char* cB = (const char*)g.Bt + (size_t)cur.pn * tstep;
    S.a_ready(cur);
    if constexpr (SP2) {
        PG8_STAGE(PG8_SB(0, 0), cB, voffB); PG8_STAGE(PG8_SB(0, 1), cB + hB, voffB); PG8_STAGE(PG8_SA(0, 0), cA, voffA); PG8_STAGE(PG8_SA(0, 1), cA + hA, voffA);
        if (wr == 1) PG8_BAR;
        PG8_WAIT_V(2); PG8_BAR;
        PG8_STAGE(PG8_SB(1, 0), cB + kB, voffB); PG8_STAGE(PG8_SA(1, 0), cA + kA, voffA); PG8_STAGE(PG8_SB(1, 1), cB + hB + kB, voffB);
        PG8_WAIT_V(6); PG8_BAR;
    } else {
        PG8_STAGE(PG8_SB(0, 0), cB, voffB); PG8_STAGE(PG8_SA(0, 0), cA, voffA); PG8_STAGE(PG8_SB(0, 1), cB + hB, voffB); PG8_STAGE(PG8_SA(0, 1), cA + hA, voffA);
        if (wr == 1) PG8_BAR;
        PG8_WAIT_V(4); PG8_BAR;
        PG8_STAGE(PG8_SB(1, 0), cB + kB, voffB); PG8_STAGE(PG8_SA(1, 0), cA + kA, voffA); PG8_STAGE(PG8_SB(1, 1), cB + hB + kB, voffB);
        PG8_WAIT_V(6); PG8_BAR;
    }
    for (;;) {
        const bool has_next = S.next(ui + 1, nxt);
        const char* nA = has_next ? (const char*)g.A + (size_t)nxt.pm * tstep : cA; const char* nB = has_next ? (const char*)g.Bt + (size_t)nxt.pn * tstep : cB;
        for (int t = 0; t < nt; t += 2) {
            const bool last = (t == nt - 2);
            const char* a1 = cA + (size_t)(t + 1) * kA;
            const char* a2 = last ? nA : cA + (size_t)(t + 2) * kA; const char* b2 = last ? nB : cB + (size_t)(t + 2) * kB;
            const char* a3 = a2 + kA; const char* b3 = b2 + kB;
            if (last && has_next) S.a_ready(nxt);
            if constexpr (SP2) {
            PG8_LDB(B0, 0, 0); PG8_LDB(B1, 0, 1); PG8_SCHED; PG8_LDA(At, 0, 0); PG8_STAGE(PG8_SA(1, 1), a1 + hA, voffA);
            PG8_WAIT_V(8); PG8_WAIT_L(0); PG8_BAR; PG8_MMA(0, 0, At, B0); PG8_MMA(0, 1, At, B1); PG8_BAR; PG8_SCHED;
            PG8_LDA(At, 0, 1); PG8_STAGE(PG8_SB(0, 0), b2, voffB); PG8_STAGE(PG8_SB(0, 1), b2 + hB, voffB); PG8_STAGE(PG8_SA(0, 0), a2, voffA);
            PG8_WAIT_V(8); PG8_WAIT_L(0); PG8_BAR; PG8_MMA(1, 0, At, B0); PG8_MMA(1, 1, At, B1); PG8_BAR; PG8_SCHED;
            PG8_LDB(B0, 1, 0); PG8_LDB(B1, 1, 1); PG8_SCHED; PG8_LDA(At, 1, 0); PG8_STAGE(PG8_SA(0, 1), a2 + hA, voffA);
            PG8_WAIT_V(8); PG8_WAIT_L(0); PG8_BAR; PG8_MMA(0, 0, At, B0); PG8_MMA(0, 1, At, B1); PG8_BAR; PG8_SCHED;
            PG8_LDA(At, 1, 1); PG8_STAGE(PG8_SB(1, 0), b3, voffB); PG8_STAGE(PG8_SB(1, 1), b3 + hB, voffB); PG8_STAGE(PG8_SA(1, 0), a3, voffA);
            PG8_WAIT_V(8); PG8_WAIT_L(0); PG8_BAR; PG8_MMA(1, 0, At, B0); PG8_MMA(1, 1, At, B1); PG8_BAR; PG8_SCHED;
            } else {
            PG8_LDB(B0, 0, 0); PG8_SCHED; PG8_LDA(At, 0, 0); PG8_STAGE(PG8_SA(1, 1), a1 + hA, voffA);
            PG8_WAIT_L(8); PG8_BAR; PG8_WAIT_L(0); PG8_MMA(0, 0, At, B0); PG8_BAR; PG8_SCHED;
            PG8_LDB(B1, 0, 1); PG8_STAGE(PG8_SB(0, 0), b2, voffB);
            PG8_BAR; PG8_WAIT_L(0); PG8_MMA(0, 1, At, B1); PG8_BAR;
            PG8_LDA(At, 0, 1); PG8_STAGE(PG8_SA(0, 0), a2, voffA);
            PG8_BAR; PG8_WAIT_L(0); PG8_MMA(1, 0, At, B0); PG8_BAR; PG8_SCHED;
            PG8_STAGE(PG8_SB(0, 1), b2 + hB, voffB);
            PG8_WAIT_V(6); PG8_BAR; PG8_MMA(1, 1, At, B1); PG8_BAR;
            PG8_LDB(B0, 1, 0); PG8_SCHED; PG8_LDA(At, 1, 0); PG8_STAGE(PG8_SA(0, 1), a2 + hA, voffA);
            PG8_WAIT_L(8); PG8_BAR; PG8_WAIT_L(0); PG8_MMA(0, 0, At, B0); PG8_BAR; PG8_SCHED;
            PG8_LDB(B1, 1, 1); PG8_STAGE(PG8_SB(1, 0), b3, voffB);
            PG8_BAR; PG8_WAIT_L(0); PG8_MMA(0, 1, At, B1); PG8_BAR;
            PG8_LDA(At, 1, 1); PG8_STAGE(PG8_SA(1, 0), a3, voffA);
            PG8_BAR; PG8_WAIT_L(0); PG8_MMA(1, 0, At, B0); PG8_BAR; PG8_SCHED;
            PG8_STAGE(PG8_SB(1, 1), b3 + hB, voffB);
            PG8_WAIT_V(6); PG8_BAR; PG8_MMA(1, 1, At, B1); PG8_BAR;
            }
        }
        if constexpr (ALIGN_EPI) { if (wr == 0) PG8_BAR; }
        if constexpr (!Epi::AFTER_DRAIN) { E(acc, cur, wr, wc, fr, fq); S.done(cur); }
        if (!has_next) break;
#pragma unroll
        for (int a = 0; a < 2; ++a)
#pragma unroll
            for (int b = 0; b < 2; ++b)
#pragma unroll
                for (int m = 0; m < 4; ++m)
#pragma unroll
                    for (int n = 0; n < 2; ++n) acc[a][b][m][n] = (AccT){0, 0, 0, 0};
        cur = nxt; cA = nA; cB = nB; ++ui;
        if constexpr (ALIGN_EPI) { if (wr == 1) PG8_BAR; }
    }
    PG8_WAIT_V(0);
    if constexpr (!ALIGN_EPI) { if (wr == 0) PG8_BAR; }
    PG8_BAR;
    if constexpr (Epi::AFTER_DRAIN) { E.fused(acc, cur, wr, wc, fr, fq, lds, wid, lane); S.done(cur); }
#undef PG8_SA
#undef PG8_SB
#undef PG8_STAGE
#undef PG8_LDA
#undef PG8_LDB
#undef PG8_MMA
#undef PG8_WAIT_V
#undef PG8_WAIT_L
#undef PG8_BAR
#undef PG8_SCHED
}
}

#ifndef PG8_SP2
#define PG8_SP2 true
#endif
#ifndef PG8_ALIGN
#define PG8_ALIGN true
#endif
#ifndef MK_ONE_LAUNCH
#define MK_ONE_LAUNCH 1
#endif
constexpr int NWAVES = 8, NPHASES = 15;
constexpr int D = 4096, MP = 8192, MS = 256, M = MP + MS, DFF = 11008, NGU = 2 * DFF, NQKV = 5120, NSGU = 8192;
constexpr int KV_ROWS = 8192 + 8 * 160;
constexpr size_t MiB = 1u << 20;
constexpr size_t WS_CTL = 0, CTL_ZERO_BYTES = 1 * MiB;
constexpr int CW_BAR = 4096, CW_Q = 8192;
constexpr size_t ST_OFF = 65536, ST_STRIDE = 67584;
static_assert(ST_STRIDE == (size_t)M * 8 && ST_OFF + 6 * ST_STRIDE <= CTL_ZERO_BYTES, "stat arrays inside the memset region");
constexpr size_t CM_OFF = 524288, CM_STRIDE = 88064;
constexpr size_t RS_OFF = 720896;
constexpr size_t CMQ_OFF = 786432;
static_assert(ST_OFF + 6 * ST_STRIDE <= CM_OFF && CM_OFF + 2 * CM_STRIDE <= RS_OFF && RS_OFF + (size_t)M * 4 <= CMQ_OFF && CMQ_OFF + 5120 * 4 <= CTL_ZERO_BYTES, "control region map");
constexpr size_t CMO_OFF = 819200;
static_assert(CMQ_OFF + 5120 * 4 <= CMO_OFF && CMO_OFF + 4096 * 4 <= CTL_ZERO_BYTES, "control region map");
constexpr size_t WQ8_SHIFT = 4u << 20;
constexpr size_t WS_WSB = 1 * MiB;
constexpr size_t WS_W1T = 2 * MiB, WS_W2T = 66 * MiB, WS_WGU0 = 98 * MiB, WS_WD0 = 270 * MiB, WS_WQKV = 356 * MiB, WS_WOT = 396 * MiB, WS_WGU1 = 428 * MiB, WS_WD1 = 600 * MiB;
constexpr size_t WS_XB = 686 * MiB, WS_H = 752 * MiB  , WS_ACT = 884 * MiB, WS_ZQ = 1062 * MiB, WS_O = 1128 * MiB, WS_KB = 1194 * MiB, WS_VB = 1204 * MiB, WS_END = 1214 * MiB;
static_assert(WS_W1T + (size_t)NSGU * D * 2 <= WS_W2T && WS_W2T + (size_t)D * D * 2 <= WS_WGU0 && WS_WGU0 + (size_t)NGU * D * 2 <= WS_WD0 && WS_WD0 + (size_t)D * DFF * 2 <= WS_WQKV &&
              WS_WQKV + (size_t)NQKV * D * 2 <= WS_WOT && WS_WOT + (size_t)D * D * 2 <= WS_WGU1 && WS_WGU1 + (size_t)NGU * D * 2 <= WS_WD1 && WS_WD1 + (size_t)D * DFF * 2 <= WS_XB, "weight map");
static_assert(WS_XB + (size_t)M * D * 2 <= WS_H && WS_H + (size_t)M * D * 4 <= WS_ACT && WS_ACT + (size_t)M * DFF * 2 <= WS_ZQ && WS_ACT + (size_t)M * NSGU * 2 <= WS_ZQ &&
              WS_ZQ + (size_t)M * D * 2 <= WS_O && WS_O + (size_t)M * D * 2 <= WS_KB && WS_KB + (size_t)KV_ROWS * 512 * 2 <= WS_VB && WS_VB + (size_t)KV_ROWS * 512 * 2 <= WS_END, "activation map");
constexpr int SCR_BYTES = 139264;
constexpr int LDSCTL_OFF = SCR_BYTES, MISC_OFF = LDSCTL_OFF + 320;
constexpr int LDS_BYTES = 147456;
static_assert(MISC_OFF + 128 <= LDS_BYTES && pg8::STAGE_BYTES <= SCR_BYTES, "LDS map");

#define GAS __attribute__((address_space(1)))
#define LAS __attribute__((address_space(3)))
typedef unsigned short bf16;
typedef unsigned v4u __attribute__((ext_vector_type(4)));
typedef unsigned v2u __attribute__((ext_vector_type(2)));
typedef float f32x4 __attribute__((ext_vector_type(4)));
typedef short bf16x8 __attribute__((ext_vector_type(8)));
typedef unsigned long long u64;
#define LDS_WAIT() asm volatile("s_waitcnt lgkmcnt(0)" ::: "memory")
#define VM_WAIT() asm volatile("s_waitcnt vmcnt(0)" ::: "memory")
__device__ __forceinline__ unsigned f2bf(float f) { unsigned u = __builtin_bit_cast(unsigned, f); return (u + 0x7fffu + ((u >> 16) & 1u)) >> 16; }
typedef float f32x2_t __attribute__((ext_vector_type(2)));
typedef __bf16 bf16x2_t __attribute__((ext_vector_type(2)));
__device__ __forceinline__ unsigned pk2(float lo, float hi) { const f32x2_t v = {lo, hi}; const bf16x2_t b = __builtin_convertvector(v, bf16x2_t); return __builtin_bit_cast(unsigned, b); }
__device__ __forceinline__ float bflo(unsigned w) { return __builtin_bit_cast(float, w << 16); }
__device__ __forceinline__ float bfhi(unsigned w) { return __builtin_bit_cast(float, w & 0xffff0000u); }

#define XB_TMO      128
#define XB_XCNT(j)  (256  + 64 * (j))
#define XB_XSUB(j)  (1280 + 64 * (j))
#define XB_XGEN(j)  (2304 + 64 * (j))
#define XB_TOP      3328
#define XB_TOPGEN   3392
#define XCD_BAR_WORDS 3456
#define XB_SPIN_CAP (1u << 18)

__device__ __forceinline__ unsigned xb_ld(unsigned* p)              { return __hip_atomic_load(p, __ATOMIC_RELAXED, __HIP_MEMORY_SCOPE_AGENT); }
__device__ __forceinline__ unsigned xb_add(unsigned* p, unsigned v) { return __hip_atomic_fetch_add(p, v, __ATOMIC_RELAXED, __HIP_MEMORY_SCOPE_AGENT); }
__device__ __forceinline__ unsigned xb_xcc_id() { return (unsigned)__builtin_amdgcn_s_getreg((3 << 11) | 20) & 0xFu; }
#define XB_SPIN(cond, bar) do { unsigned _sp = 0; while (cond) { __builtin_amdgcn_s_sleep(1); \
    if ((++_sp & 255u) == 0u) { if (xb_ld(&(bar)[XB_TMO])) break; if (_sp > XB_SPIN_CAP) { atomicAdd(&(bar)[XB_TMO], 1u); break; } } } } while (0)

struct XcdBarrier {
    unsigned* bar; unsigned x;
    volatile LAS unsigned* st;
};

__device__ __forceinline__ XcdBarrier xcd_barrier_post(unsigned* bar, volatile LAS unsigned* st) {
    XcdBarrier b; b.bar = bar; b.x = xb_xcc_id(); b.st = st;
    if (threadIdx.x == 0) (void)xb_add(&bar[XB_XCNT(b.x)], 1u);
    return b;
}
__device__ __forceinline__ void xcd_barrier_complete(unsigned* bar, unsigned x, unsigned& nloc, unsigned& nx) {
    const unsigned G = gridDim.x * gridDim.y * gridDim.z;
    unsigned sum, cnt, mine, sp = 0u;
    for (;;) {
        sum = 0u; cnt = 0u; mine = 0u;
#pragma unroll
        for (unsigned j = 0; j < 16; ++j) { const unsigned c = xb_ld(&bar[XB_XCNT(j)]); sum += c; cnt += (c > 0u) ? 1u : 0u; mine = (j == x) ? c : mine; }
        if (sum == G) break;
        __builtin_amdgcn_s_sleep(1);
        if ((++sp & 255u) == 0u) { if (xb_ld(&bar[XB_TMO])) break; if (sp > XB_SPIN_CAP) { atomicAdd(&bar[XB_TMO], 1u); break; } }
    }
    nloc = mine > 0u ? mine : 1u; nx = cnt > 0u ? cnt : 1u;
}

__device__ __forceinline__ void xcd_barrier(const XcdBarrier& b) {
    asm volatile("s_waitcnt vmcnt(0)" ::: "memory");
    __syncthreads();
    if (threadIdx.x == 0) {
        unsigned* bar = b.bar;
        __builtin_amdgcn_s_waitcnt(0);
        unsigned nloc = b.st[0], nx = b.st[1];
        if (nloc == 0u) { xcd_barrier_complete(bar, b.x, nloc, nx); b.st[0] = nloc; b.st[1] = nx; }
        const unsigned old = xb_add(&bar[XB_XSUB(b.x)], 1u);
        const unsigned gen = old / nloc;
        if (old + 1u == (gen + 1u) * nloc) {
            __builtin_amdgcn_fence(__ATOMIC_RELEASE, "agent");
            asm volatile("s_waitcnt vmcnt(0)" ::: "memory");
            const unsigned og = xb_add(&bar[XB_TOP], 1u);
            const unsigned tg = og / nx;
            if (og + 1u == (tg + 1u) * nx) xb_add(&bar[XB_TOPGEN], 1u);
            else XB_SPIN(xb_ld(&bar[XB_TOPGEN]) == tg, bar);
            __builtin_amdgcn_fence(__ATOMIC_ACQUIRE, "agent");
            xb_add(&bar[XB_XGEN(b.x)], 1u);
            asm volatile("s_waitcnt vmcnt(0)" ::: "memory");
        } else {
            XB_SPIN(xb_ld(&bar[XB_XGEN(b.x)]) == gen, bar);
            __builtin_amdgcn_fence(__ATOMIC_ACQUIRE, "agent");
            asm volatile("s_waitcnt vmcnt(0)" ::: "memory");
        }
    }
    __syncthreads();
}


using pg8::FIX_INV;
__device__ __forceinline__ float wave_sum(float v) {
#pragma unroll
    for (int o = 1; o < 64; o <<= 1) v += __shfl_xor(v, o);
    return v;
}
__device__ __forceinline__ int maprow(int map, int n) {
    const int r12 = ((n >> 7) << 8) + (n & 127) + (map == 2 ? 128 : 0);
    const int r3 = (n & ~255) + (((n >> 5) & 1) << 7) + (((n >> 6) & 3) << 5) + (n & 31);
    return map == 0 ? n : (map == 3 ? r3 : r12);
}
struct TItem { const float* W; const float* gain; bf16* WT; const float* cmax; int K, N, map, coff, k0, n0, blk; };
struct TRegs { f32x4 v[16]; f32x4 g0, g1; float cm[8]; };
__device__ __forceinline__ void titem_load(const TItem& t, TRegs& R, const float* dummy, int lane) {
    const float* p = t.W + (size_t)(t.k0 + (lane >> 4)) * t.N + t.n0 + 4 * (lane & 15);
#pragma unroll
    for (int i = 0; i < 16; ++i) R.v[i] = __builtin_nontemporal_load((const f32x4*)(p + (size_t)(4 * i) * t.N));
    const float* gp = (t.gain ? t.gain + t.k0 : dummy + (t.k0 & 4095)) + 8 * (lane & 7);
    R.g0 = *(const f32x4*)gp; R.g1 = *(const f32x4*)(gp + 4);
    const float* cp = t.cmax ? t.cmax : dummy;
#pragma unroll
    for (int j = 0; j < 8; ++j) R.cm[j] = cp[t.cmax ? maprow(t.map, t.n0 + 8 * j + (lane >> 3) + t.coff) : j];
}
__device__ __forceinline__ void titem_lds_write(const TRegs& R, LAS float* scr, int lane) {
#pragma unroll
    for (int i = 0; i < 16; ++i) { const int kk = 4 * i + (lane >> 4), c4 = (lane & 15) ^ (((kk >> 3) & 3) << 1); *(LAS f32x4*)(scr + kk * 64 + 4 * c4) = R.v[i]; }
}
__device__ __forceinline__ void titem_emit(const TItem& t, f32x4 g0, f32x4 g1, const float (&cm)[8], LAS float* scr, int lane) {
    LDS_WAIT(); asm volatile("" ::: "memory");
    const int c = lane & 7, nn = lane >> 3;
    const bool hg = t.gain != nullptr; const f32x4 one = {1.f, 1.f, 1.f, 1.f};
    g0 = hg ? g0 : one; g1 = hg ? g1 : one;
    const int sw = (c & 3) << 1;
#pragma unroll
    for (int j = 0; j < 8; ++j) { const int n = 8 * j + nn; const LAS float* sp = scr + (8 * c) * 64 + ((((n >> 2) ^ sw) << 2) | (n & 3));
        const size_t drow = (size_t)maprow(t.map, t.n0 + n + t.coff);
        if (t.cmax) {
            const float inv = cm[j] > 0.f ? 127.0f / cm[j] : 0.f;
            const int q0 = __float2int_rn(sp[0 * 64] * g0.x * inv), q1 = __float2int_rn(sp[1 * 64] * g0.y * inv), q2 = __float2int_rn(sp[2 * 64] * g0.z * inv), q3 = __float2int_rn(sp[3 * 64] * g0.w * inv);
            const int q4 = __float2int_rn(sp[4 * 64] * g1.x * inv), q5 = __float2int_rn(sp[5 * 64] * g1.y * inv), q6 = __float2int_rn(sp[6 * 64] * g1.z * inv), q7 = __float2int_rn(sp[7 * 64] * g1.w * inv);
            v2u o; o.x = (unsigned)(q0 & 255) | ((unsigned)(q1 & 255) << 8) | ((unsigned)(q2 & 255) << 16) | ((unsigned)q3 << 24);
            o.y = (unsigned)(q4 & 255) | ((unsigned)(q5 & 255) << 8) | ((unsigned)(q6 & 255) << 16) | ((unsigned)q7 << 24);
            __builtin_nontemporal_store(o, (GAS v2u*)(t.blk ? (unsigned char*)t.WT + pg8::blk_byte((int)drow, (t.k0 + 8 * c) >> 1, t.K >> 1) : (unsigned char*)t.WT + drow * t.K + t.k0 + 8 * c));
        } else {
        v4u o; o.x = pk2(sp[0 * 64] * g0.x, sp[1 * 64] * g0.y); o.y = pk2(sp[2 * 64] * g0.z, sp[3 * 64] * g0.w); o.z = pk2(sp[4 * 64] * g1.x, sp[5 * 64] * g1.y); o.w = pk2(sp[6 * 64] * g1.z, sp[7 * 64] * g1.w);
        __builtin_nontemporal_store(o, (GAS v4u*)(t.blk ? (bf16*)((char*)t.WT + pg8::blk_byte((int)drow, t.k0 + 8 * c, t.K)) : t.WT + drow * t.K + t.k0 + 8 * c)); } }
    LDS_WAIT(); asm volatile("" ::: "memory");
}
struct Args { const float* in[23]; float* out; unsigned char* ws; int ph_lo, ph_hi; };
constexpr int P0_ITEMS_A = 64 * 128;
constexpr int P0_ITEMS_P1 = P0_ITEMS_A + 64 * 64 + 2 * 64 * 172 + 172 * 64 + 64 * 16 + 64 * 64, P0_ITEMS_P4 = P0_ITEMS_P1 + 64 * 64 + 64 * 172, P0_ITEMS_P6 = P0_ITEMS_P4 + 64 * 172;
constexpr int P0_ITEMS_ALL = 64 * 128 + 64 * 64 + 2 * 64 * 172 + 172 * 64 + 64 * 16 + 64 * 64 + 64 * 64 + 2 * 64 * 172 + 172 * 64;
__device__ __forceinline__ void p0_prologue(const Args& a, unsigned char* ws, LAS unsigned char* lds, int gw, int NGW, int it_lo, int it_hi, int misc, int wave, int lane) {
    LAS float* scr = (LAS float*)(lds + wave * 16384);
    constexpr int IT_1 = 64 * 128, IT_SQ = 64 * 64, IT_G = 64 * 172, IT_D = 172 * 64, IT_KV = 64 * 16;
    constexpr int NITEMS = IT_1 + IT_SQ + 2 * IT_G + IT_D + IT_KV + IT_SQ + IT_SQ + 2 * IT_G + IT_D;
    auto describe = [&](int it) -> TItem {
        TItem t; int r = it; t.gain = nullptr; t.cmax = nullptr; t.K = 4096; t.N = 4096; t.map = 0; t.coff = 0; t.blk = 1;
        if (r < IT_1) { t.W = a.in[5]; t.gain = a.in[4]; t.WT = (bf16*)(ws + WS_W1T); t.N = 8192; }
        else if ((r -= IT_1) < IT_SQ) { t.W = a.in[10]; t.WT = (bf16*)(ws + WS_W2T); }
        else if ((r -= IT_SQ) < IT_G) { t.W = a.in[20]; t.gain = a.in[19]; t.WT = (bf16*)(ws + WS_WGU0); t.N = DFF; t.map = 1; t.cmax = (const float*)(ws + CM_OFF); }
        else if ((r -= IT_G) < IT_G) { t.W = a.in[21]; t.gain = a.in[19]; t.WT = (bf16*)(ws + WS_WGU0); t.N = DFF; t.map = 2; t.cmax = (const float*)(ws + CM_OFF); }
        else if ((r -= IT_G) < IT_D) { t.W = a.in[22]; t.WT = (bf16*)(ws + WS_WD0); t.K = DFF; }
        else if ((r -= IT_D) < IT_KV) { t.W = a.in[12]; t.gain = a.in[11]; t.WT = (bf16*)(ws + WS_WQKV); t.N = 1024; t.map = 3; }
        else if ((r -= IT_KV) < IT_SQ) { t.W = a.in[15]; t.gain = a.in[14]; t.WT = (bf16*)(ws + WS_WQKV + WQ8_SHIFT); t.map = 3; t.coff = 1024; t.cmax = (const float*)(ws + CMQ_OFF); }
        else if ((r -= IT_SQ) < IT_SQ) { t.W = a.in[18]; t.WT = (bf16*)(ws + WS_WOT); t.cmax = (const float*)(ws + CMO_OFF); }
        else if ((r -= IT_SQ) < IT_G) { t.W = a.in[20] + (size_t)D * DFF; t.gain = a.in[19] + D; t.WT = (bf16*)(ws + WS_WGU1); t.N = DFF; t.map = 1; t.cmax = (const float*)(ws + CM_OFF + CM_STRIDE); }
        else if ((r -= IT_G) < IT_G) { t.W = a.in[21] + (size_t)D * DFF; t.gain = a.in[19] + D; t.WT = (bf16*)(ws + WS_WGU1); t.N = DFF; t.map = 2; t.cmax = (const float*)(ws + CM_OFF + CM_STRIDE); }
        else { r -= IT_G; t.W = a.in[22] + (size_t)D * DFF; t.WT = (bf16*)(ws + WS_WD1); t.K = DFF; }
        const int nblk = t.N >> 6, kb = r / nblk; t.k0 = 64 * kb; t.n0 = 64 * (r - kb * nblk);
        return t;
    };
    static_assert(NITEMS == P0_ITEMS_ALL && IT_1 == P0_ITEMS_A, "item counts");
    if (it_lo + gw < it_hi) {
        const int first = it_lo + gw, last = first + ((it_hi - 1 - first) / NGW) * NGW, count = (last - first) / NGW + 1;
        TRegs ra, rb; const float* dummy = a.in[4];
        TItem ta = describe(first), tb = describe(first + NGW <= last ? first + NGW : last);
        titem_load(ta, ra, dummy, lane); titem_load(tb, rb, dummy, lane);
        for (int j = 0; j < count; j += 2) {
            const int i2 = first + (j + 2) * NGW, i3 = first + (j + 3) * NGW;
            const TItem tc = describe(i2 <= last ? i2 : last), td = describe(i3 <= last ? i3 : last);
            { titem_lds_write(ra, scr, lane); const f32x4 g0 = ra.g0, g1 = ra.g1; float cm[8]; _Pragma("unroll") for (int q = 0; q < 8; ++q) cm[q] = ra.cm[q]; titem_load(tc, ra, dummy, lane); titem_emit(ta, g0, g1, cm, scr, lane); }
            { titem_lds_write(rb, scr, lane); const f32x4 g0 = rb.g0, g1 = rb.g1; float cm[8]; _Pragma("unroll") for (int q = 0; q < 8; ++q) cm[q] = rb.cm[q]; titem_load(td, rb, dummy, lane); titem_emit(tb, g0, g1, cm, scr, lane); }
            ta = tc; tb = td;
        }
        asm volatile("s_waitcnt vmcnt(0)" ::: "memory");
    }
    if (!misc) return;
    bf16* XB = (bf16*)(ws + WS_XB); u64* ssq_x = (u64*)(ws + ST_OFF);
    for (int m = gw; m < M; m += NGW) {
        const float* xrow = m < MP ? a.in[0] + (size_t)m * D : a.in[1] + (size_t)(m - MP) * D;
        const GAS f32x4* xr = (const GAS f32x4*)xrow + lane; GAS v2u* o8 = (GAS v2u*)(XB + (size_t)m * D) + lane; float ss = 0.f;
#pragma unroll 4
        for (int j = 0; j < 16; ++j) { const f32x4 v = xr[64 * j]; ss += (v.x * v.x + v.y * v.y) + (v.z * v.z + v.w * v.w); v2u o; o.x = pk2(v.x, v.y); o.y = pk2(v.z, v.w); o8[64 * j] = o; }
        ss = wave_sum(ss);
        if (lane == 0) ssq_x[m] = (u64)(ss * pg8::FIX_SCALE);
    }
    const int gt = gw * 64 + lane, NT = NGW * 64;
    bf16* KB = (bf16*)(ws + WS_KB); bf16* VB = (bf16*)(ws + WS_VB); bf16* WSB = (bf16*)(ws + WS_WSB);
    for (int i = gt; i < 65536; i += NT) {
        const int e = i * 8, b = e >> 16, t = (e >> 9) & 127, c = e & 511; const size_t dst = (size_t)(8192 + 160 * b + t) * 512 + c;
        { const f32x4 v0 = *(const f32x4*)(a.in[2] + e), v1 = *(const f32x4*)(a.in[2] + e + 4); v4u o; o.x = pk2(v0.x, v0.y); o.y = pk2(v0.z, v0.w); o.z = pk2(v1.x, v1.y); o.w = pk2(v1.z, v1.w); *(v4u*)(KB + dst) = o; }
        { const f32x4 v0 = *(const f32x4*)(a.in[3] + e), v1 = *(const f32x4*)(a.in[3] + e + 4); v4u o; o.x = pk2(v0.x, v0.y); o.y = pk2(v0.z, v0.w); o.z = pk2(v1.x, v1.y); o.w = pk2(v1.z, v1.w); *(v4u*)(VB + dst) = o; }
    }
    for (int i = gt; i < 16384; i += NT) {
        const int e = i * 8, ii = (e >> 7) & 127, j = e & 127; const bool keep = (ii >> 6) >= (j >> 6);
        const f32x4 v0 = *(const f32x4*)(a.in[8] + e), v1 = *(const f32x4*)(a.in[8] + e + 4); v4u o = {0u, 0u, 0u, 0u};
        if (keep) { o.x = pk2(v0.x, v0.y); o.y = pk2(v0.z, v0.w); o.z = pk2(v1.x, v1.y); o.w = pk2(v1.z, v1.w); }
        *(v4u*)(WSB + e) = o;
    }
}


__device__ __forceinline__ void absmax_pass(const Args& a, unsigned char* ws, int gw, int NGW, int lane) {
    constexpr int PER = 16 * 172, PERQ = 16 * 64, NIT = 4 * PER + 2 * PERQ;
    const int r = lane >> 4;
    for (int it = gw; it < NIT; it += NGW) {
        const bool iso = it >= 4 * PER + PERQ, isq = !iso && it >= 4 * PER, sq = iso || isq;
        const int mat = sq ? 0 : it / PER, rem = iso ? it - 4 * PER - PERQ : (isq ? it - 4 * PER : it - mat * PER), nblk = sq ? 64 : 172, kg = rem / nblk, nb = rem - kg * nblk, l = mat >> 1, up = mat & 1;
        const float* W = iso ? a.in[18] : (isq ? a.in[15] : (up ? a.in[21] : a.in[20]) + (size_t)l * D * DFF);
        const float* gain = iso ? a.in[14] : (isq ? a.in[14] : a.in[19] + l * D); const float gmul = iso ? 0.f : 1.f, gadd = iso ? 1.f : 0.f;
        unsigned* cmax = iso ? (unsigned*)(ws + CMO_OFF) : (isq ? (unsigned*)(ws + CMQ_OFF) : (unsigned*)(ws + CM_OFF + (size_t)l * CM_STRIDE));
        const int NW = sq ? D : DFF, amap = iso ? 0 : (isq ? 3 : 1 + up), acoff = isq ? 1024 : 0;
        const int k0 = 256 * kg, n0 = 64 * nb;
        const float* p = W + (size_t)(k0 + r) * NW + n0 + 4 * (lane & 15);
        f32x4 va[16], vb[16]; float ga[16], gb[16];
#define AM_LOAD(v_, g_, sb_) do { _Pragma("unroll") for (int i = 0; i < 16; ++i) { v_[i] = __builtin_nontemporal_load((const f32x4*)(p + (size_t)(64 * (sb_) + 4 * i) * NW)); g_[i] = gain[k0 + 64 * (sb_) + 4 * i + r] * gmul + gadd; } } while (0)
#define AM_MAX(v_, g_) do { _Pragma("unroll") for (int i = 0; i < 16; ++i) { m0 = fmaxf(m0, fabsf(v_[i].x * g_[i])); m1 = fmaxf(m1, fabsf(v_[i].y * g_[i])); m2 = fmaxf(m2, fabsf(v_[i].z * g_[i])); m3 = fmaxf(m3, fabsf(v_[i].w * g_[i])); } } while (0)
        float m0 = 0.f, m1 = 0.f, m2 = 0.f, m3 = 0.f;
        AM_LOAD(va, ga, 0); AM_LOAD(vb, gb, 1);
        AM_MAX(va, ga); AM_LOAD(va, ga, 2);
        AM_MAX(vb, gb); AM_LOAD(vb, gb, 3);
        AM_MAX(va, ga); AM_MAX(vb, gb);
#undef AM_LOAD
#undef AM_MAX
        m0 = fmaxf(m0, __shfl_xor(m0, 16)); m0 = fmaxf(m0, __shfl_xor(m0, 32)); m1 = fmaxf(m1, __shfl_xor(m1, 16)); m1 = fmaxf(m1, __shfl_xor(m1, 32));
        m2 = fmaxf(m2, __shfl_xor(m2, 16)); m2 = fmaxf(m2, __shfl_xor(m2, 32)); m3 = fmaxf(m3, __shfl_xor(m3, 16)); m3 = fmaxf(m3, __shfl_xor(m3, 32));
        if (lane < 16) {
            unsigned* cp = cmax + maprow(amap, n0 + 4 * lane + acoff);
            (void)__hip_atomic_fetch_max(cp + 0, __builtin_bit_cast(unsigned, m0), __ATOMIC_RELAXED, __HIP_MEMORY_SCOPE_AGENT);
            (void)__hip_atomic_fetch_max(cp + 1, __builtin_bit_cast(unsigned, m1), __ATOMIC_RELAXED, __HIP_MEMORY_SCOPE_AGENT);
            (void)__hip_atomic_fetch_max(cp + 2, __builtin_bit_cast(unsigned, m2), __ATOMIC_RELAXED, __HIP_MEMORY_SCOPE_AGENT);
            (void)__hip_atomic_fetch_max(cp + 3, __builtin_bit_cast(unsigned, m3), __ATOMIC_RELAXED, __HIP_MEMORY_SCOPE_AGENT);
        }
    }
}
template <int R>
__device__ __forceinline__ void quant_rows_n(const bf16* XB, const u64* ssq, unsigned char* A8, float* rowscale, int m0, int mstride, int lane) {
    v4u w[R][8]; unsigned mx[R];
#pragma unroll
    for (int r = 0; r < R; ++r) { const v4u* xr = (const v4u*)(XB + (size_t)(m0 + r * mstride) * D) + lane;
#pragma unroll
        for (int j = 0; j < 8; ++j) w[r][j] = xr[64 * j]; }
#pragma unroll
    for (int r = 0; r < R; ++r) { unsigned m = 0u;
#pragma unroll
        for (int j = 0; j < 8; ++j)
#pragma unroll
            for (int q = 0; q < 4; ++q) { const unsigned t = w[r][j][q] & 0x7fff7fffu; const unsigned lo = t & 0xffffu, hi = t >> 16; m = m > lo ? m : lo; m = m > hi ? m : hi; }
        mx[r] = m; }
#pragma unroll
    for (int o = 1; o < 64; o <<= 1)
#pragma unroll
        for (int r = 0; r < R; ++r) { const unsigned t = (unsigned)__shfl_xor((int)mx[r], o); mx[r] = mx[r] > t ? mx[r] : t; }
#pragma unroll
    for (int r = 0; r < R; ++r) { const int m = m0 + r * mstride;
        const float fmx = __builtin_bit_cast(float, mx[r] << 16), inv = fmx > 0.f ? 127.0f / fmx : 0.f;
        v2u* orow = (v2u*)(A8 + (size_t)m * D) + lane;
#pragma unroll
        for (int j = 0; j < 8; ++j) { unsigned b[8];
#pragma unroll
            for (int q = 0; q < 4; ++q) { b[2 * q] = (unsigned)__float2int_rn(bflo(w[r][j][q]) * inv) & 255u; b[2 * q + 1] = (unsigned)__float2int_rn(bfhi(w[r][j][q]) * inv) & 255u; }
            v2u o; o.x = b[0] | (b[1] << 8) | (b[2] << 16) | (b[3] << 24); o.y = b[4] | (b[5] << 8) | (b[6] << 16) | (b[7] << 24); orow[64 * j] = o; }
        if (lane == 0) rowscale[m] = fmx * (1.0f / 127.0f) * (ssq ? rsqrtf((float)ssq[m] * (pg8::FIX_INV * (1.0f / 4096.0f)) + 1e-6f) : 1.0f); }
}
__device__ __forceinline__ void quant_rows(const bf16* XB, const u64* ssq, unsigned char* A8, float* rowscale, int gw, int NGW, int lane) {
    int m = gw;
    for (; m + 3 * NGW < M; m += 4 * NGW) quant_rows_n<4>(XB, ssq, A8, rowscale, m, NGW, lane);
    for (; m < M; m += NGW) quant_rows_n<1>(XB, ssq, A8, rowscale, m, NGW, lane);
}
__device__ __forceinline__ void sgu_phase(LAS unsigned char* lds, const bf16* UV, const bf16* WSB, const u64* lnsum, const u64* lnssq, const float* ln_g, const float* ln_b,
                                          const float* b_s, bf16* Z, float* out_sguv, int wave, int lane) {
    const int fr = lane & 15, fq = lane >> 4;
    LAS unsigned char* img = lds + wave * 17408;
    for (int uidx = blockIdx.x; uidx < 576; uidx += gridDim.x) {
        const bool samp = uidx >= 512;
        const int g = uidx & 7, chunk = samp ? ((uidx - 512) >> 3) : (uidx >> 3);
        const int row_base = samp ? MP + 32 * chunk : 128 * chunk, nrows = samp ? 32 : 128;
        const int cw = 512 * g + 64 * wave;
        {
            const int cp = lane & 7, c = cw + 8 * cp;
            const f32x4 g0 = *(const f32x4*)(ln_g + c), g1 = *(const f32x4*)(ln_g + c + 4), b0 = *(const f32x4*)(ln_b + c), b1 = *(const f32x4*)(ln_b + c + 4);
            for (int it = 0; it < nrows / 8; ++it) {
                const int j = it * 8 + (lane >> 3), row = row_base + j;
                const v4u raw = *(const v4u*)(UV + (size_t)row * NSGU + D + c);
                const float mean = (float)(long long)lnsum[row] * (FIX_INV / 4096.0f), ex2 = (float)lnssq[row] * (FIX_INV / 4096.0f);
                const float rstd = rsqrtf(fmaxf(ex2 - mean * mean, 0.f) + 1e-5f);
                f32x4 x0 = {bflo(raw.x), bfhi(raw.x), bflo(raw.y), bfhi(raw.y)}, x1 = {bflo(raw.z), bfhi(raw.z), bflo(raw.w), bfhi(raw.w)};
                x0 = (x0 - mean) * rstd * g0 + b0; x1 = (x1 - mean) * rstd * g1 + b1;
                if (samp) { float* op = out_sguv + (size_t)(row - MP) * D + c; *(f32x4*)op = x0; *(f32x4*)(op + 4) = x1; }
                LAS unsigned short* wp = (LAS unsigned short*)(img + (8 * cp) * 272 + j * 2);
#pragma unroll
                for (int i = 0; i < 4; ++i) { wp[i * 136] = (unsigned short)f2bf(x0[i]); wp[(4 + i) * 136] = (unsigned short)f2bf(x1[i]); }
            }
        }
        LDS_WAIT(); asm volatile("" ::: "memory");
        const int nmt = nrows >> 4, kmax = nrows >> 5;
        bf16x8 bfr[4][4];
#pragma unroll
        for (int nt = 0; nt < 4; ++nt)
#pragma unroll
            for (int ks = 0; ks < 4; ++ks) bfr[nt][ks] = (ks < kmax) ? *(const LAS bf16x8*)(img + (16 * nt + fr) * 272 + (32 * ks + 8 * fq) * 2) : (bf16x8){0, 0, 0, 0, 0, 0, 0, 0};
        const bf16* Wg = WSB + g * 16384;
        for (int mt = 0; mt < nmt; ++mt) {
            bf16x8 af[4];
#pragma unroll
            for (int ks = 0; ks < 4; ++ks) af[ks] = (ks < kmax) ? *(const bf16x8*)(Wg + (16 * mt + fr) * 128 + 32 * ks + 8 * fq) : (bf16x8){0, 0, 0, 0, 0, 0, 0, 0};
            f32x4 acc[4];
#pragma unroll
            for (int nt = 0; nt < 4; ++nt) acc[nt] = (f32x4){0.f, 0.f, 0.f, 0.f};
#pragma unroll
            for (int ks = 0; ks < 4; ++ks)
                if (ks < kmax) {
#pragma unroll
                    for (int nt = 0; nt < 4; ++nt) acc[nt] = __builtin_amdgcn_mfma_f32_16x16x32_bf16(bfr[nt][ks], af[ks], acc[nt], 0, 0, 0);
                }
            const int i = 16 * mt + fr; const float bias = b_s[g * 128 + i]; const size_t ro = (size_t)(row_base + i);
#pragma unroll
            for (int nt = 0; nt < 4; ++nt) {
                const int c = cw + 16 * nt + 4 * fq; const v2u uu = *(const v2u*)(UV + ro * NSGU + c);
                f32x4 z = {bflo(uu.x), bfhi(uu.x), bflo(uu.y), bfhi(uu.y)};
                { const pg8::f32x2 ga = pg8::gelu_pk((pg8::f32x2){z[0], z[1]}), gb = pg8::gelu_pk((pg8::f32x2){z[2], z[3]}); z = (f32x4){ga.x, ga.y, gb.x, gb.y}; }
                z = z * (acc[nt] + bias);
                v2u o; o.x = pk2(z[0], z[1]); o.y = pk2(z[2], z[3]); *(v2u*)(Z + ro * D + c) = o;
            }
        }
        LDS_WAIT(); asm volatile("" ::: "memory");
    }
}

__device__ __forceinline__ void attn_phase(LAS unsigned char* lds, const bf16* Q, const bf16* KB, const bf16* VB, const float* sinks, bf16* O, int tid, int wave, int lane) {
    const int fr = lane & 15, fq = lane >> 4;
    LAS unsigned char* Ks = lds; LAS unsigned char* Vt = lds + 27648;
    constexpr float LOG2E = 1.4426950408889634f;
    for (int uidx = blockIdx.x; uidx < 1088; uidx += gridDim.x) {
        int kvh, qbase, kbase, klo, khi, nmt;
        if (uidx < 1024) { kvh = uidx & 7; const int bc = uidx >> 3, c = bc & 63; qbase = bc * 64; kbase = qbase - 128; klo = c >= 2 ? 0 : (2 - c) * 64; khi = 192; nmt = 4; }
        else { const int s = uidx - 1024; kvh = s & 7; const int b = s >> 3; qbase = MP + 32 * b; kbase = MP + 160 * b; klo = 0; khi = 160; nmt = 2; }
        __syncthreads();
#pragma unroll
        for (int it = 0; it < 3; ++it) {
            const int p = tid + 512 * it, key = p >> 3, ch = p & 7;
            v4u kk = {0u, 0u, 0u, 0u}, vv = {0u, 0u, 0u, 0u};
            if (key >= klo && key < khi) { const size_t off = (size_t)(kbase + key) * 512 + kvh * 64 + ch * 8; kk = *(const v4u*)(KB + off); vv = *(const v4u*)(VB + off); }
            *(LAS v4u*)(Ks + key * 144 + ch * 16) = kk;
            LAS unsigned short* vp = (LAS unsigned short*)(Vt + (ch * 8) * 392 + key * 2);
            vp[0 * 196] = (unsigned short)(vv.x & 0xffffu); vp[1 * 196] = (unsigned short)(vv.x >> 16); vp[2 * 196] = (unsigned short)(vv.y & 0xffffu); vp[3 * 196] = (unsigned short)(vv.y >> 16);
            vp[4 * 196] = (unsigned short)(vv.z & 0xffffu); vp[5 * 196] = (unsigned short)(vv.z >> 16); vp[6 * 196] = (unsigned short)(vv.w & 0xffffu); vp[7 * 196] = (unsigned short)(vv.w >> 16);
        }
        __syncthreads();
        const int head = kvh * 8 + wave; const float sink = sinks[head];
        for (int mt = 0; mt < nmt; ++mt) {
            const int qrow = qbase + 16 * mt + fr;
            const bf16* qp = Q + (size_t)qrow * D + head * 64 + 8 * fq;
            const bf16x8 q0 = *(const bf16x8*)qp, q1 = *(const bf16x8*)(qp + 32);
            f32x4 s[12]; float mx = sink;
#pragma unroll
            for (int nt = 0; nt < 12; ++nt) {
                const LAS unsigned char* kp = Ks + (16 * nt + fr) * 144 + fq * 16;
                const bf16x8 k0 = *(const LAS bf16x8*)kp, k1 = *(const LAS bf16x8*)(kp + 64);
                f32x4 a = {0.f, 0.f, 0.f, 0.f};
                a = __builtin_amdgcn_mfma_f32_16x16x32_bf16(k0, q0, a, 0, 0, 0);
                a = __builtin_amdgcn_mfma_f32_16x16x32_bf16(k1, q1, a, 0, 0, 0);
                if (16 * nt < klo || 16 * nt >= khi) a = (f32x4){-1e30f, -1e30f, -1e30f, -1e30f};
                s[nt] = a; mx = fmaxf(mx, fmaxf(fmaxf(a[0], a[1]), fmaxf(a[2], a[3])));
            }
            mx = fmaxf(mx, __shfl_xor(mx, 16)); mx = fmaxf(mx, __shfl_xor(mx, 32));
            float l = 0.f;
#pragma unroll
            for (int nt = 0; nt < 12; ++nt) {
#pragma unroll
                for (int i = 0; i < 4; ++i) { const float e = __builtin_amdgcn_exp2f((s[nt][i] - mx) * LOG2E); s[nt][i] = e; l += e; }
            }
            l += __shfl_xor(l, 16); l += __shfl_xor(l, 32); l += __builtin_amdgcn_exp2f((sink - mx) * LOG2E);
            f32x4 o[4];
#pragma unroll
            for (int dt = 0; dt < 4; ++dt) o[dt] = (f32x4){0.f, 0.f, 0.f, 0.f};
#pragma unroll
            for (int s6 = 0; s6 < 6; ++s6) {
                const pg8::u32x4 pw = pg8::pack8(s[2 * s6], s[2 * s6 + 1]); const bf16x8 pf = __builtin_bit_cast(bf16x8, pw);
#pragma unroll
                for (int dt = 0; dt < 4; ++dt) {
                    const LAS unsigned char* vp = Vt + (16 * dt + fr) * 392 + (32 * s6 + 4 * fq) * 2;
                    const v2u lo = *(const LAS v2u*)vp, hi = *(const LAS v2u*)(vp + 32);
                    const v4u vw = {lo.x, lo.y, hi.x, hi.y};
                    o[dt] = __builtin_amdgcn_mfma_f32_16x16x32_bf16(__builtin_bit_cast(bf16x8, vw), pf, o[dt], 0, 0, 0);
                }
            }
            const float inv = 1.0f / l; bf16* op = O + (size_t)qrow * D + head * 64 + 4 * fq;
#pragma unroll
            for (int dt = 0; dt < 4; ++dt) { v2u w; w.x = pg8::cvt_pk_bf16(o[dt][0] * inv, o[dt][1] * inv); w.y = pg8::cvt_pk_bf16(o[dt][2] * inv, o[dt][3] * inv); *(v2u*)(op + 16 * dt) = w; }
        }
    }
}

template <class Epi>
__device__ __forceinline__ void tail_phase(LAS unsigned char* lds, const bf16* A, const bf16* Bt, int K, int nN, int pn_off, unsigned* qhead, const Epi& E, int tid, int wave, int lane, int ablk = 0, int bblk = 1) {
    constexpr int PITCH = 528, OPB = 64 * PITCH, BUFB = 2 * OPB;
    const int fr = lane & 15, fq = lane >> 4;
    const int nc = K >> 8;
    LAS float* part = (LAS float*)(lds + wave * 17408);
    const int row_l = tid >> 3, cg = tid & 7;
    const int colA = Epi::TAIL_SPLIT ? 4 * cg : 8 * cg, colB = Epi::TAIL_SPLIT ? 32 + 4 * cg : 8 * cg + 4;
    const int lr = tid >> 5, lc = tid & 31;
    volatile LAS unsigned* tick = (volatile LAS unsigned*)(lds + MISC_OFF + 64);
    const int cnt = nN * 2;
    int xq = (int)(xb_xcc_id() & 7u), tries = 0;
    unsigned nextj = 0u;
    if (tid == 0) nextj = __hip_atomic_fetch_add(qhead + 16 * xq, 1u, __ATOMIC_RELAXED, __HIP_MEMORY_SCOPE_AGENT);
    for (;;) {
        if (tid == 0) tick[0] = nextj;
        __syncthreads();
        const int j = (int)tick[0];
        __syncthreads();
        if (j >= cnt) { if (++tries == 8) break; xq = (xq + 1) & 7; if (tid == 0) nextj = __hip_atomic_fetch_add(qhead + 16 * xq, 1u, __ATOMIC_RELAXED, __HIP_MEMORY_SCOPE_AGENT); continue; }
        tries = 0;
        if (tid == 0) nextj = __hip_atomic_fetch_add(qhead + 16 * xq, 1u, __ATOMIC_RELAXED, __HIP_MEMORY_SCOPE_AGENT);
        const int p = ((8 * (j >> 2) + xq) << 2) + (j & 3) + 16 * pn_off;
        const int rq = p & 3, q = (p >> 2) & 3, pn = p >> 4;
        typedef typename Epi::AccT AccT; AccT acc[4][4];
#pragma unroll
        for (int nb = 0; nb < 4; ++nb)
#pragma unroll
            for (int mb = 0; mb < 4; ++mb) acc[nb][mb] = (AccT){0, 0, 0, 0};
        const size_t a16 = ablk ? 1024 : (size_t)16 * K, achs = ablk ? 65536 : 256, b16 = bblk ? 1024 : (size_t)16 * K, b128 = bblk ? 8192 : (size_t)128 * K, bchs = bblk ? 65536 : 256;
        const bf16* ag = ablk ? (const bf16*)((const char*)A + pg8::blk_byte(MP + 64 * rq + lr, 8 * lc, K)) : A + (size_t)(MP + 64 * rq + lr) * K + 8 * lc;
        const bf16* bg = bblk ? (const bf16*)((const char*)Bt + pg8::blk_byte(256 * pn + 32 * q + (lr & 31), 8 * lc, K)) : Bt + (size_t)(256 * pn + 32 * q + (lr & 31)) * K + 8 * lc;
        v4u a0[4], b0[4], a1[4], b1[4];
#define TL_LOAD(ra, rb, c) do { const int cc_ = (c) < nc ? (c) : nc - 1; _Pragma("unroll") for (int i = 0; i < 4; ++i) { \
            ra[i] = *(const v4u*)(ag + a16 * i + achs * cc_); rb[i] = *(const v4u*)(bg + b16 * (i & 1) + b128 * (i >> 1) + bchs * cc_); } } while (0)
#define TL_WRITE(ra, rb, b) do { LAS unsigned char* d_ = lds + (b) * BUFB + lr * PITCH + lc * 16; _Pragma("unroll") for (int i = 0; i < 4; ++i) { \
            *(LAS v4u*)(d_ + 16 * i * PITCH) = ra[i]; *(LAS v4u*)(d_ + OPB + 16 * i * PITCH) = rb[i]; } } while (0)
#define TL_BAR() do { asm volatile("s_waitcnt lgkmcnt(0)" ::: "memory"); __builtin_amdgcn_s_barrier(); asm volatile("" ::: "memory"); } while (0)
#define TL_STEP(c, la, lb, wa, wb) do { TL_LOAD(la, lb, (c) + 2); TL_BAR(); \
            const LAS unsigned char* fb = lds + ((c) & 1) * BUFB + fr * PITCH + (32 * wave + 8 * fq) * 2; bf16x8 fa[4], fbv[4]; \
            _Pragma("unroll") for (int i = 0; i < 4; ++i) { fa[i] = *(const LAS bf16x8*)(fb + 16 * i * PITCH); fbv[i] = *(const LAS bf16x8*)(fb + OPB + 16 * i * PITCH); } \
            _Pragma("unroll") for (int nb = 0; nb < 4; ++nb) _Pragma("unroll") for (int mb = 0; mb < 4; ++mb) acc[nb][mb] = pg8::mma16(fbv[nb], fa[mb], acc[nb][mb]); \
            TL_WRITE(wa, wb, ((c) + 1) & 1); } while (0)
        TL_LOAD(a0, b0, 0); TL_LOAD(a1, b1, 1); TL_WRITE(a0, b0, 0);
        int c = 0;
        for (; c + 1 < nc; c += 2) { TL_STEP(c, a0, b0, a1, b1); TL_STEP(c + 1, a1, b1, a0, b0); }
        if (c < nc) TL_STEP(c, a0, b0, a1, b1);
#undef TL_STEP
#undef TL_BAR
#undef TL_LOAD
#undef TL_WRITE
        asm volatile("s_waitcnt vmcnt(0)" ::: "memory"); __syncthreads();
#pragma unroll
        for (int nb = 0; nb < 4; ++nb)
#pragma unroll
            for (int mb = 0; mb < 4; ++mb) *(LAS pg8::f32x4*)(part + (16 * mb + fr) * 68 + 16 * nb + 4 * fq) = __builtin_convertvector(acc[nb][mb], pg8::f32x4);
        __syncthreads();
        pg8::f32x4 v0 = {0.f, 0.f, 0.f, 0.f}, v1 = {0.f, 0.f, 0.f, 0.f};
#pragma unroll
        for (int w = 0; w < 8; ++w) { const LAS float* t = (const LAS float*)(lds + w * 17408) + row_l * 68; v0 += *(const LAS pg8::f32x4*)(t + colA); v1 += *(const LAS pg8::f32x4*)(t + colB); }
        E.tail(MP + 64 * rq + row_l, cg, pn, q, v0, v1);
        __syncthreads();
    }
}

#ifndef CONV_SPREAD
#define CONV_SPREAD 0
#endif
#ifndef PROBE_PH
#define PROBE_PH (-1)
#endif
#ifndef PROBE_MUL
#define PROBE_MUL 3
#endif
#ifndef NCONV
#define NCONV 80
#endif
#ifndef NCONV4
#define NCONV4 16
#endif
#ifndef NCONV6
#define NCONV6 24
#endif
#ifndef SAMPLE_MAIN_GU
#define SAMPLE_MAIN_GU 64
#endif
__device__ __forceinline__ void pr_begin(int k, long long& t0) { if (PROBE_PH >= 0 && k == PROBE_PH) { __syncthreads(); t0 = (long long)wall_clock64(); } }
__device__ __forceinline__ void pr_end(int k, long long t0) {
    if (PROBE_PH >= 0 && k == PROBE_PH) { __syncthreads(); const long long t1 = (long long)wall_clock64(), te = t1 + (long long)PROBE_MUL * (t1 - t0);
        while ((long long)wall_clock64() < te) __builtin_amdgcn_s_sleep(16);
        __syncthreads(); }
}
__global__ void __launch_bounds__(NWAVES * 64, 2) yoco_fwd(Args args) {
    extern __shared__ __attribute__((aligned(16))) unsigned char lds_raw[];
    LAS unsigned char* lds = (LAS unsigned char*)lds_raw;
    const int tid = threadIdx.x, lane = tid & 63, wave = __builtin_amdgcn_readfirstlane(tid >> 6);
    const int G = gridDim.x, bx = blockIdx.x, vcu = (G % 8 == 0) ? (bx % 8) * (G / 8) + bx / 8 : bx;
    unsigned char* ws = args.ws;
    for (int u = tid; u < (LDS_BYTES - LDSCTL_OFF) / 4; u += NWAVES * 64) ((LAS unsigned*)(lds + LDSCTL_OFF))[u] = 0u;
    __syncthreads();
    volatile LAS unsigned* MISC = (volatile LAS unsigned*)(lds + MISC_OFF);
    XcdBarrier bar; bar.bar = (unsigned*)ws + CW_BAR; bar.x = 0; bar.st = nullptr;
    if (MK_ONE_LAUNCH) bar = xcd_barrier_post((unsigned*)ws + CW_BAR, MISC + 8);
    const int lo = args.ph_lo, hi = args.ph_hi;
    long long pr_t0 = 0;
#define IN(k) (pr_begin((k), pr_t0), lo <= (k) && (k) < hi)
#define SEAM(k) do { pr_end((k), pr_t0); if (MK_ONE_LAUNCH && IN((k) + 1)) xcd_barrier(bar); } while (0)
    bf16* const W1T = (bf16*)(ws + WS_W1T); bf16* const W2T = (bf16*)(ws + WS_W2T); bf16* const WGU0 = (bf16*)(ws + WS_WGU0); bf16* const WD0 = (bf16*)(ws + WS_WD0);
    bf16* const WQKV = (bf16*)(ws + WS_WQKV); bf16* const WOT = (bf16*)(ws + WS_WOT); bf16* const WGU1 = (bf16*)(ws + WS_WGU1); bf16* const WD1 = (bf16*)(ws + WS_WD1);
    bf16* const XB = (bf16*)(ws + WS_XB); bf16* const ACT = (bf16*)(ws + WS_ACT); bf16* const UV = (bf16*)(ws + WS_ACT);
    bf16* const ZQ = (bf16*)(ws + WS_ZQ); bf16* const OB = (bf16*)(ws + WS_O); bf16* const KB = (bf16*)(ws + WS_KB); bf16* const VB = (bf16*)(ws + WS_VB); bf16* const WSB = (bf16*)(ws + WS_WSB);
    unsigned char* const A8 = ws + WS_H; float* const rowscale = (float*)(ws + RS_OFF); const float* const cmax0 = (const float*)(ws + CM_OFF); const float* const cmax1 = (const float*)(ws + CM_OFF + CM_STRIDE);
    unsigned* const qheads = (unsigned*)ws + CW_Q;
    u64* const ssq_x = (u64*)(ws + ST_OFF); u64* const lnsum = (u64*)(ws + ST_OFF + ST_STRIDE); u64* const lnssq = (u64*)(ws + ST_OFF + 2 * ST_STRIDE);
    u64* const ssq_h1 = (u64*)(ws + ST_OFF + 3 * ST_STRIDE); u64* const ssq_h2 = (u64*)(ws + ST_OFF + 4 * ST_STRIDE); u64* const ssq_h3 = (u64*)(ws + ST_OFF + 5 * ST_STRIDE);

    const bool split = (G == 256) && (NCONV > 0);
    const int nconv = split ? NCONV : 0, ncomp = G - nconv, nconv4 = (split && CONV_SPREAD) ? NCONV4 : 0, nconv6 = (split && CONV_SPREAD) ? NCONV6 : 0;
    const int items_p1 = (split && CONV_SPREAD) ? P0_ITEMS_P1 : P0_ITEMS_ALL;
    if (IN(0)) { absmax_pass(args, ws, vcu * NWAVES + wave, G * NWAVES, lane); if (!split && MK_ONE_LAUNCH) xcd_barrier(bar);
                 p0_prologue(args, ws, lds, vcu * NWAVES + wave, G * NWAVES, 0, split ? P0_ITEMS_A : P0_ITEMS_ALL, 1, wave, lane); SEAM(0); }
    if (IN(1)) {
        if (bx >= ncomp) { p0_prologue(args, ws, lds, (bx - ncomp) * NWAVES + wave, nconv * NWAVES, P0_ITEMS_A, items_p1, 0, wave, lane); __syncthreads(); }
        pg8::Gemm g{XB, W1T, MP, NSGU, D, 0, 1}; pg8::SplitOrder S; S.init(MP, NSGU, G, bx); S.nblk = ncomp; S.nhalf = 16; S.nextra = 0;
        pg8::EpiSguIn E{UV, ssq_x, lnsum, lnssq};
        pg8::gemm_phase<pg8::EpiSguIn, pg8::SplitOrder, PG8_ALIGN, PG8_SP2>(lds, g, S, E);
        tail_phase(lds, XB, W1T, D, 32, 0, qheads + 0 * 128, E, tid, wave, lane);
        SEAM(1);
    }
    if (IN(2)) { sgu_phase(lds, UV, WSB, lnsum, lnssq, args.in[6], args.in[7], args.in[9], ZQ, args.out + pg8::OUT_SGUV, wave, lane); SEAM(2); }
    if (IN(3)) {
        pg8::Gemm g{ZQ, W2T, MP, D, D, 0, 1}; pg8::StaticOrder S; S.init(MP, D, G, bx);
        pg8::EpiRes<false, true, false> E{nullptr, nullptr, nullptr, XB, ssq_h1};
        pg8::gemm_phase<pg8::EpiRes<false, true, false>, pg8::StaticOrder, PG8_ALIGN, PG8_SP2>(lds, g, S, E);
        tail_phase(lds, ZQ, W2T, D, 16, 0, qheads + 1 * 128, E, tid, wave, lane);
        SEAM(3);
    }
    if (IN(4)) { quant_rows(XB, ssq_h1, A8, rowscale, vcu * NWAVES + wave, G * NWAVES, lane); SEAM(4); }
    if (IN(5)) {
        if (bx >= G - nconv4) { p0_prologue(args, ws, lds, (bx - (G - nconv4)) * NWAVES + wave, nconv4 * NWAVES, P0_ITEMS_P1, P0_ITEMS_P4, 0, wave, lane); __syncthreads(); }
        pg8::Gemm g{(const bf16*)A8, WGU0, M, NGU, D / 2, 0, 1}; pg8::SplitOrder S; S.init(MP, NGU, G, bx); S.nblk = G - nconv4; S.nhalf = 0; S.nextra = SAMPLE_MAIN_GU;
        pg8::EpiSwigluI8 E{ACT, rowscale, cmax0};
        pg8::gemm_phase<pg8::EpiSwigluI8, pg8::SplitOrder, PG8_ALIGN, PG8_SP2>(lds, g, S, E);
        tail_phase(lds, (const bf16*)A8, WGU0, D / 2, 86 - SAMPLE_MAIN_GU, SAMPLE_MAIN_GU, qheads + 2 * 128, E, tid, wave, lane);
        SEAM(5);
    }
    if (IN(6)) {
        pg8::Gemm g{ACT, WD0, MP, D, DFF, 1, 1}; pg8::StaticOrder S; S.init(MP, D, G, bx);
        pg8::EpiRes<false, true, false> E{nullptr, nullptr, nullptr, XB, ssq_h2};
        pg8::gemm_phase<pg8::EpiRes<false, true, false>, pg8::StaticOrder, PG8_ALIGN, PG8_SP2>(lds, g, S, E);
        tail_phase(lds, ACT, WD0, DFF, 16, 0, qheads + 3 * 128, E, tid, wave, lane, 1, 1);
        SEAM(6);
    }
    if (IN(7)) { quant_rows(XB, ssq_h2, A8, rowscale, vcu * NWAVES + wave, G * NWAVES, lane); SEAM(7); }
    if (IN(8)) {
        { pg8::Gemm g{XB, WQKV, MP, 1024, D, 0, 1}; pg8::SplitOrder S; S.init(MP, 1024, G, bx); S.nblk = (G == 256) ? 128 : G; S.nhalf = 0; S.nextra = 0;
          pg8::EpiQKV E{KB, VB, ZQ, args.out, ssq_h2, args.in[13], args.in[16], nullptr, nullptr};
          pg8::gemm_phase<pg8::EpiQKV, pg8::SplitOrder, PG8_ALIGN, PG8_SP2>(lds, g, S, E); }
        { pg8::Gemm g{(const bf16*)A8, (const bf16*)(ws + WS_WQKV + WQ8_SHIFT), MP, 4096, D / 2, 0, 1}; pg8::QOrder S; S.init(MP, 4096, G, bx);
          pg8::EpiQKVT<true> E{KB, VB, ZQ, args.out, ssq_h2, args.in[13], args.in[16], rowscale, (const float*)(ws + CMQ_OFF)};
          pg8::gemm_phase<pg8::EpiQKVT<true>, pg8::QOrder, PG8_ALIGN, PG8_SP2>(lds, g, S, E);
          tail_phase(lds, (const bf16*)A8, (const bf16*)(ws + WS_WQKV + WQ8_SHIFT), D / 2, 16, 4, qheads + 8 * 128, E, tid, wave, lane); }
        { pg8::EpiQKV E{KB, VB, ZQ, args.out, ssq_h2, args.in[13], args.in[16], nullptr, nullptr};
          tail_phase(lds, XB, WQKV, D, 4, 0, qheads + 4 * 128, E, tid, wave, lane); }
        SEAM(8);
    }
    if (IN(9)) { attn_phase(lds, ZQ, KB, VB, args.in[17], OB, tid, wave, lane); SEAM(9); }
    if (IN(10)) { quant_rows(OB, nullptr, A8, rowscale, vcu * NWAVES + wave, G * NWAVES, lane); SEAM(10); }
    if (IN(11)) {
        pg8::Gemm g{(const bf16*)A8, WOT, MP, D, D / 2, 0, 1}; pg8::StaticOrder S; S.init(MP, D, G, bx);
        pg8::EpiRes<false, true, false, true> E{nullptr, nullptr, nullptr, XB, ssq_h3, rowscale, (const float*)(ws + CMO_OFF)};
        pg8::gemm_phase<pg8::EpiRes<false, true, false, true>, pg8::StaticOrder, PG8_ALIGN, PG8_SP2>(lds, g, S, E);
        tail_phase(lds, (const bf16*)A8, WOT, D / 2, 16, 0, qheads + 5 * 128, E, tid, wave, lane);
        SEAM(11);
    }
    if (IN(12)) { quant_rows(XB, ssq_h3, A8, rowscale, vcu * NWAVES + wave, G * NWAVES, lane); SEAM(12); }
    if (IN(13)) {
        if (bx >= G - nconv4) { p0_prologue(args, ws, lds, (bx - (G - nconv4)) * NWAVES + wave, nconv4 * NWAVES, P0_ITEMS_P6, P0_ITEMS_ALL, 0, wave, lane); __syncthreads(); }
        pg8::Gemm g{(const bf16*)A8, WGU1, M, NGU, D / 2, 0, 1}; pg8::SplitOrder S; S.init(MP, NGU, G, bx); S.nblk = G - nconv4; S.nhalf = 0; S.nextra = SAMPLE_MAIN_GU;
        pg8::EpiSwigluI8 E{ACT, rowscale, cmax1};
        pg8::gemm_phase<pg8::EpiSwigluI8, pg8::SplitOrder, PG8_ALIGN, PG8_SP2>(lds, g, S, E);
        tail_phase(lds, (const bf16*)A8, WGU1, D / 2, 86 - SAMPLE_MAIN_GU, SAMPLE_MAIN_GU, qheads + 6 * 128, E, tid, wave, lane);
        SEAM(13);
    }
    if (IN(14)) {
        pg8::Gemm g{ACT, WD1, MP, D, DFF, 1, 1}; pg8::StaticOrder S; S.init(MP, D, G, bx);
        pg8::EpiRes<false, false, true> E{nullptr, nullptr, args.out, XB, nullptr};
        pg8::gemm_phase<pg8::EpiRes<false, false, true>, pg8::StaticOrder, PG8_ALIGN, PG8_SP2>(lds, g, S, E);
        tail_phase(lds, ACT, WD1, DFF, 16, 0, qheads + 7 * 128, E, tid, wave, lane, 1, 1);
        pr_end(14, pr_t0);
    }
#undef IN
#undef SEAM
}

extern "C" void kernel_launch(void* const* d_in, const int* in_sizes, int n_in, void* d_out, int out_size, void* d_ws, size_t ws_size, hipStream_t stream) {
    static int grid = 0;
    if (grid == 0) {
        if (n_in != 23 || in_sizes[0] != MP * D || out_size != 36175872 || ws_size < WS_END) {
            fprintf(stderr, "kernel_launch: unexpected shapes (n_in %d, in0 %d, out %d, ws %zu); nothing launched\n", n_in, n_in > 0 ? in_sizes[0] : -1, out_size, ws_size); grid = -1; return; }
        int dev = 0, cus = 0, per_cu = 0;
        if (hipGetDevice(&dev) != hipSuccess || hipDeviceGetAttribute(&cus, hipDeviceAttributeMultiprocessorCount, dev) != hipSuccess) { fprintf(stderr, "kernel_launch: device query failed\n"); grid = -1; return; }
        if (hipFuncSetAttribute((const void*)yoco_fwd, hipFuncAttributeMaxDynamicSharedMemorySize, LDS_BYTES) != hipSuccess) { fprintf(stderr, "kernel_launch: hipFuncSetAttribute failed\n"); grid = -1; return; }
        if (hipOccupancyMaxActiveBlocksPerMultiprocessor(&per_cu, (const void*)yoco_fwd, NWAVES * 64, LDS_BYTES) != hipSuccess || per_cu < 1)
            fprintf(stderr, "kernel_launch: note: occupancy query reports %d workgroups per CU\n", per_cu);
        (void)hipGetLastError();
        grid = cus;
    }
    if (grid < 0) return;
    if (hipMemsetAsync((char*)d_ws + WS_CTL, 0, CTL_ZERO_BYTES, stream) != hipSuccess) { fprintf(stderr, "kernel_launch: memset failed\n"); return; }
    Args a{};
    for (int i = 0; i < 23; ++i) a.in[i] = (const float*)d_in[i];
    a.out = (float*)d_out; a.ws = (unsigned char*)d_ws;
#if MK_ONE_LAUNCH
    a.ph_lo = 0; a.ph_hi = NPHASES;
    hipLaunchKernelGGL(yoco_fwd, dim3(grid), dim3(NWAVES * 64), LDS_BYTES, stream, a);
#else
    for (int p = 0; p < NPHASES; ++p) { a.ph_lo = p; a.ph_hi = p + 1; hipLaunchKernelGGL(yoco_fwd, dim3(grid), dim3(NWAVES * 64), LDS_BYTES, stream, a); }
#endif
    const hipError_t le = hipPeekAtLastError();
    if (le != hipSuccess) fprintf(stderr, "kernel_launch: launch failed: %s\n", hipGetErrorName(le));
}
```

```cpp
#include <hip/hip_runtime.h>
#include <cstdio>
#include <cstdint>
#define MK_ONE_LAUNCH 1
namespace pg8 {
#define PG8_LAS __attribute__((address_space(3)))
typedef unsigned short bf16_t;
typedef short bf16x8 __attribute__((ext_vector_type(8)));
typedef float f32x4 __attribute__((ext_vector_type(4)));
typedef unsigned u32x4 __attribute__((ext_vector_type(4)));
constexpr int BM = 256, BK = 64, HALF = 128, HTB = HALF * BK * 2  , STAGE_BYTES = 8 * HTB, NXCD = 8, WGM = 8;

__host__ __device__ __forceinline__ int lds_byte(int r, int c) { const int st = (r >> 4) * 2 + (c >> 5), rr = r & 15, cc = c & 31, ob = rr * 64 + cc * 2; return st * 1024 + (ob ^ (((ob >> 9) & 1) << 5)); }
__host__ __device__ __forceinline__ void stage_rc(int b, int& R, int& C) { const int st = b / 1024, sb = b % 1024, swz = sb ^ (((sb >> 9) & 1) << 5); R = (st >> 1) * 16 + swz / 64; C = (st & 1) * 32 + (swz % 64) / 2; }
__host__ __device__ __forceinline__ int perm32(int rho) { const int n = rho >> 4, i = rho & 15; return 8 * (i >> 2) + 4 * n + (i & 3); }

struct Unit { int pm, pn; };
struct Gemm { const bf16_t* A; const bf16_t* Bt; int M, N, K; int ablk, bblk; };
__host__ __device__ __forceinline__ size_t blk_byte(int r, int k, int K) { return (size_t)(r >> 8) * K * 512 + (size_t)(k >> 6) * 32768 + ((r >> 7) & 1) * 16384 + lds_byte(r & 127, k & 63); }

struct StaticOrder {
    int nM, nN, nwg, G, c;
    __host__ __device__ void init(int M, int N, int G_, int c_) { nM = M / BM; nN = N / BM; nwg = nM * nN; G = G_; c = c_; }
    __host__ __device__ bool next(int i, Unit& u) const {
        const long L = (long)i * G + c; if (L >= nwg) return false;
        int wgid = (int)L; { const int q = nwg / NXCD, r = nwg % NXCD, xcd = wgid % NXCD, off = wgid / NXCD; wgid = (xcd < r ? xcd * (q + 1) : r * (q + 1) + (xcd - r) * q) + off; }
        const int nig = WGM * nN, gid = wgid / nig, fm = gid * WGM, gsz = (nM - fm) < WGM ? (nM - fm) : WGM;
        u.pm = fm + ((wgid % nig) % gsz); u.pn = (wgid % nig) / gsz; return true;
    }
    __device__ __forceinline__ void a_ready(const Unit&) const {}
    __device__ __forceinline__ void done(const Unit&) const {}
};

__device__ __forceinline__ unsigned cvt_pk_bf16(float lo, float hi) { unsigned r; asm volatile("v_cvt_pk_bf16_f32 %0, %1, %2" : "=v"(r) : "v"(lo), "v"(hi)); return r; }
typedef float f32x2 __attribute__((ext_vector_type(2)));
__device__ __forceinline__ f32x2 gelu_pk(f32x2 v) {
    const f32x2 av = __builtin_elementwise_abs(v), d = av * 0.2316418882f + 1.0f;
    f32x2 t; t.x = __builtin_amdgcn_rcpf(d.x); t.y = __builtin_amdgcn_rcpf(d.y);
    f32x2 q = t * 0.5307027145f + (-0.7265760135f); q = q * t + 0.7107068705f; q = q * t + (-0.142248368f); q = q * t + 0.127414796f; q = q * t;
    const f32x2 s = (v * v) * (-0.72134752044f);
    f32x2 e; e.x = __builtin_amdgcn_exp2f(s.x); e.y = __builtin_amdgcn_exp2f(s.y);
    const f32x2 m = v * (q * e), r = v - m;
    f32x2 o; o.x = v.x < 0.f ? m.x : r.x; o.y = v.y < 0.f ? m.y : r.y; return o;
}


struct SplitOrder : StaticOrder {
    int nblk; int nhalf; int nextra;
    __device__ bool next(int i, Unit& u) const {
        if (c >= nblk) return false;
        const long L = (long)i * nblk + c; if (L >= nwg + nextra) return false;
        if (L >= nwg) { u.pm = 32; u.pn = (int)(L - nwg); return true; }
        int wgid = (int)L; { const int q = nwg / NXCD, r = nwg % NXCD, xcd = wgid % NXCD, off = wgid / NXCD; wgid = (xcd < r ? xcd * (q + 1) : r * (q + 1) + (xcd - r) * q) + off; }
        const int nig = WGM * nN, gid = wgid / nig, fm = gid * WGM, gsz = (nM - fm) < WGM ? (nM - fm) : WGM;
        u.pm = fm + ((wgid % nig) % gsz); u.pn = (wgid % nig) / gsz; if (nhalf) u.pn = (u.pn & 1) * nhalf + (u.pn >> 1); return true;
    }
};
typedef unsigned long long u64;
constexpr float FIX_SCALE = 16777216.0f, FIX_INV = 1.0f / 16777216.0f;
__device__ __forceinline__ u64 f2fixu(float v) { return (u64)(v * FIX_SCALE); }
__device__ __forceinline__ u64 f2fixs(float v) { return (u64)(long long)(v * FIX_SCALE); }
__device__ __forceinline__ void fix_add(u64* p, u64 v) { (void)__hip_atomic_fetch_add(p, v, __ATOMIC_RELAXED, __HIP_MEMORY_SCOPE_AGENT); }
__device__ __forceinline__ float rstd_of(const u64* ssq, int row) { return rsqrtf((float)ssq[row] * (FIX_INV * (1.0f / 4096.0f)) + 1e-6f); }
__device__ __forceinline__ float sum4(const f32x4& v) { return (v[0] + v[1]) + (v[2] + v[3]); }
__device__ __forceinline__ float ssq4(const f32x4& v) { return (v[0] * v[0] + v[1] * v[1]) + (v[2] * v[2] + v[3] * v[3]); }
__device__ __forceinline__ u32x4 pack8(const f32x4& a, const f32x4& b) { u32x4 w; w.x = cvt_pk_bf16(a[0], a[1]); w.y = cvt_pk_bf16(a[2], a[3]); w.z = cvt_pk_bf16(b[0], b[1]); w.w = cvt_pk_bf16(b[2], b[3]); return w; }

template <bool I8> struct AccSel { typedef f32x4 T; };
template <> struct AccSel<true> { typedef int T __attribute__((ext_vector_type(4))); };
struct EpiSguIn {
    typedef f32x4 AccT;
    static constexpr bool PERM = true, AFTER_DRAIN = false;
    bf16_t* UV; const u64* ssq; u64* lnsum; u64* lnssq;
    __device__ __forceinline__ void operator()(const f32x4 (&acc)[2][2][4][2], const Unit& u, int wr, int wc, int fr, int fq) const {
        const int row0 = u.pm * BM + wr * 64 + fr, col0 = u.pn * BM + wc * 32 + 8 * fq;
        const bool isv = u.pn >= 16;
        float rs[2][4];
#pragma unroll
        for (int ai = 0; ai < 2; ++ai)
#pragma unroll
            for (int m = 0; m < 4; ++m) rs[ai][m] = rstd_of(ssq, row0 + ai * HALF + m * 16);
#pragma unroll
        for (int ai = 0; ai < 2; ++ai)
#pragma unroll
            for (int m = 0; m < 4; ++m) {
                const int row = row0 + ai * HALF + m * 16;
                float s1 = 0.f, s2 = 0.f;
                bf16_t* rowp = UV + (size_t)row * 8192 + col0;
#pragma unroll
                for (int bj = 0; bj < 2; ++bj) {
                    f32x4 v0 = acc[ai][bj][m][0] * rs[ai][m], v1 = acc[ai][bj][m][1] * rs[ai][m];
                    if (isv) {
                        const f32x2 a = gelu_pk((f32x2){v0[0], v0[1]}), b = gelu_pk((f32x2){v0[2], v0[3]}), c = gelu_pk((f32x2){v1[0], v1[1]}), d = gelu_pk((f32x2){v1[2], v1[3]});
                        v0 = (f32x4){a.x, a.y, b.x, b.y}; v1 = (f32x4){c.x, c.y, d.x, d.y};
                        s1 += sum4(v0) + sum4(v1); s2 += ssq4(v0) + ssq4(v1); }
                    *(u32x4*)(rowp + bj * HALF) = pack8(v0, v1);
                }
                if (isv) {
                    s1 += __shfl_xor(s1, 16); s1 += __shfl_xor(s1, 32); s2 += __shfl_xor(s2, 16); s2 += __shfl_xor(s2, 32);
                    if (fq == 0) { fix_add(lnsum + row, f2fixs(s1)); fix_add(lnssq + row, f2fixu(s2)); }
                }
            }
    }
    static constexpr bool TAIL_SPLIT = false;
    __device__ __forceinline__ void tail(int row, int cg, int pn, int q, f32x4 v0, f32x4 v1) const {
        const int col = pn * BM + (cg >> 2) * HALF + q * 32 + 8 * (cg & 3);
        const float rs = rstd_of(ssq, row);
        v0 = v0 * rs; v1 = v1 * rs;
        if (pn >= 16) { const f32x2 a = gelu_pk((f32x2){v0[0], v0[1]}), b = gelu_pk((f32x2){v0[2], v0[3]}), c = gelu_pk((f32x2){v1[0], v1[1]}), d = gelu_pk((f32x2){v1[2], v1[3]});
            v0 = (f32x4){a.x, a.y, b.x, b.y}; v1 = (f32x4){c.x, c.y, d.x, d.y}; }
        *(u32x4*)(UV + (size_t)row * 8192 + col) = pack8(v0, v1);
        if (pn >= 16) {
            float s1 = sum4(v0) + sum4(v1), s2 = ssq4(v0) + ssq4(v1);
            s1 += __shfl_xor(s1, 1); s1 += __shfl_xor(s1, 2); s1 += __shfl_xor(s1, 4); s2 += __shfl_xor(s2, 1); s2 += __shfl_xor(s2, 2); s2 += __shfl_xor(s2, 4);
            if (cg == 0) { fix_add(lnsum + row, f2fixs(s1)); fix_add(lnssq + row, f2fixu(s2)); }
        }
    }
};
template <bool RES_F32, bool XBOUT, bool OUT_F32, bool I8 = false> struct EpiRes {
    typedef typename AccSel<I8>::T AccT;
    static constexpr bool PERM = true, AFTER_DRAIN = false;
    const float* res; const float* res_hi; float* out; bf16_t* XB; u64* ssq_out; const float* rowscale; const float* cmo;
    __device__ __forceinline__ static f32x4 lo4(const u32x4& w) { return (f32x4){__builtin_bit_cast(float, w.x << 16), __builtin_bit_cast(float, w.x & 0xffff0000u), __builtin_bit_cast(float, w.y << 16), __builtin_bit_cast(float, w.y & 0xffff0000u)}; }
    __device__ __forceinline__ static f32x4 hi4(const u32x4& w) { return (f32x4){__builtin_bit_cast(float, w.z << 16), __builtin_bit_cast(float, w.z & 0xffff0000u), __builtin_bit_cast(float, w.w << 16), __builtin_bit_cast(float, w.w & 0xffff0000u)}; }
    __device__ __forceinline__ void operator()(const AccT (&acc)[2][2][4][2], const Unit& u, int wr, int wc, int fr, int fq) const {
        const int row0 = u.pm * BM + wr * 64 + fr, col0 = u.pn * BM + wc * 32 + 8 * fq;
        const float* rbase = u.pm < 32 ? res : res_hi;
        f32x4 cw[2][2];
#pragma unroll
        for (int bj = 0; bj < 2; ++bj)
#pragma unroll
            for (int n = 0; n < 2; ++n) cw[bj][n] = I8 ? *(const f32x4*)(cmo + col0 + bj * HALF + 4 * n) * (1.0f / 127.0f) : (f32x4){1.f, 1.f, 1.f, 1.f};
#pragma unroll
        for (int ai = 0; ai < 2; ++ai) {
            f32x4 r[4][2][2]; float rsv[4];
#pragma unroll
            for (int m = 0; m < 4; ++m) rsv[m] = I8 ? rowscale[row0 + ai * HALF + m * 16] : 1.0f;
#pragma unroll
            for (int m = 0; m < 4; ++m) { const size_t off = (size_t)(row0 + ai * HALF + m * 16) * 4096 + col0;
#pragma unroll
                for (int bj = 0; bj < 2; ++bj) {
                    if (RES_F32) { r[m][bj][0] = *(const f32x4*)(rbase + off + bj * HALF); r[m][bj][1] = *(const f32x4*)(rbase + off + bj * HALF + 4); }
                    else { const u32x4 w = *(const u32x4*)(XB + off + bj * HALF); r[m][bj][0] = lo4(w); r[m][bj][1] = hi4(w); } } }
#pragma unroll
            for (int m = 0; m < 4; ++m) { const int row = row0 + ai * HALF + m * 16; const size_t off = (size_t)row * 4096 + col0; float ss = 0.f;
#pragma unroll
                for (int bj = 0; bj < 2; ++bj) { f32x4 o0, o1;
                    if constexpr (I8) { o0 = r[m][bj][0] + __builtin_convertvector(acc[ai][bj][m][0], f32x4) * cw[bj][0] * rsv[m]; o1 = r[m][bj][1] + __builtin_convertvector(acc[ai][bj][m][1], f32x4) * cw[bj][1] * rsv[m]; }
                    else { o0 = r[m][bj][0] + acc[ai][bj][m][0]; o1 = r[m][bj][1] + acc[ai][bj][m][1]; }
                    if (OUT_F32) { *(f32x4*)(out + off + bj * HALF) = o0; *(f32x4*)(out + off + bj * HALF + 4) = o1; }
                    if (XBOUT) { *(u32x4*)(XB + off + bj * HALF) = pack8(o0, o1); ss += ssq4(o0) + ssq4(o1); } }
                if (XBOUT) { ss += __shfl_xor(ss, 16); ss += __shfl_xor(ss, 32); if (fq == 0) fix_add(ssq_out + row, f2fixu(ss)); } }
            asm volatile("" ::: "memory");
        }
    }
    static constexpr bool TAIL_SPLIT = false;
    __device__ __forceinline__ void tail(int row, int cg, int pn, int q, f32x4 v0, f32x4 v1) const {
        const size_t off = (size_t)row * 4096 + pn * BM + (cg >> 2) * HALF + q * 32 + 8 * (cg & 3);
        if constexpr (I8) { const float rs = rowscale[row] * (1.0f / 127.0f); const float* cp = cmo + pn * BM + (cg >> 2) * HALF + q * 32 + 8 * (cg & 3); v0 = v0 * *(const f32x4*)cp * rs; v1 = v1 * *(const f32x4*)(cp + 4) * rs; }
        f32x4 r0, r1;
        if (RES_F32) { r0 = *(const f32x4*)(res_hi + off); r1 = *(const f32x4*)(res_hi + off + 4); }
        else { const u32x4 w = *(const u32x4*)(XB + off); r0 = lo4(w); r1 = hi4(w); }
        const f32x4 o0 = r0 + v0, o1 = r1 + v1;
        if (OUT_F32) { *(f32x4*)(out + off) = o0; *(f32x4*)(out + off + 4) = o1; }
        if (XBOUT) {
            *(u32x4*)(XB + off) = pack8(o0, o1);
            float ss = ssq4(o0) + ssq4(o1); ss += __shfl_xor(ss, 1); ss += __shfl_xor(ss, 2); ss += __shfl_xor(ss, 4);
            if (cg == 0) fix_add(ssq_out + row, f2fixu(ss));
        }
    }
};
struct EpiSwiglu {
    typedef f32x4 AccT;
    static constexpr bool PERM = true, AFTER_DRAIN = false;
    bf16_t* ACT; const u64* ssq;
    __device__ __forceinline__ void operator()(const f32x4 (&acc)[2][2][4][2], const Unit& u, int wr, int wc, int fr, int fq) const {
        const int row0 = u.pm * BM + wr * 64 + fr, col0 = u.pn * HALF + wc * 32 + 8 * fq;
        float rs[2][4];
#pragma unroll
        for (int ai = 0; ai < 2; ++ai)
#pragma unroll
            for (int m = 0; m < 4; ++m) rs[ai][m] = rstd_of(ssq, row0 + ai * HALF + m * 16);
#pragma unroll
        for (int ai = 0; ai < 2; ++ai)
#pragma unroll
            for (int m = 0; m < 4; ++m) {
                const int row = row0 + ai * HALF + m * 16; f32x4 o[2];
#pragma unroll
                for (int n = 0; n < 2; ++n) { const f32x4 g = acc[ai][0][m][n] * rs[ai][m], up = acc[ai][1][m][n] * rs[ai][m];
#pragma unroll
                    for (int j = 0; j < 4; ++j) o[n][j] = g[j] * __builtin_amdgcn_rcpf(1.0f + __builtin_amdgcn_exp2f(-1.44269504f * g[j])) * up[j]; }
                *(u32x4*)(ACT + (size_t)row * 11008 + col0) = pack8(o[0], o[1]);
            }
    }
    static constexpr bool TAIL_SPLIT = true;
    __device__ __forceinline__ void tail(int row, int cg, int pn, int q, f32x4 g, f32x4 up) const {
        const float rs = rstd_of(ssq, row);
        g = g * rs; up = up * rs; f32x4 o;
#pragma unroll
        for (int j = 0; j < 4; ++j) o[j] = g[j] * __builtin_amdgcn_rcpf(1.0f + __builtin_amdgcn_exp2f(-1.44269504f * g[j])) * up[j];
        typedef unsigned u32x2t __attribute__((ext_vector_type(2)));
        u32x2t w; w.x = cvt_pk_bf16(o[0], o[1]); w.y = cvt_pk_bf16(o[2], o[3]);
        *(u32x2t*)(ACT + (size_t)row * 11008 + pn * HALF + q * 32 + 4 * cg) = w;
    }
};

struct EpiSwigluI8 {
    typedef int i32x4 __attribute__((ext_vector_type(4)));
    typedef i32x4 AccT;
    static constexpr bool PERM = true, AFTER_DRAIN = false, TAIL_SPLIT = true;
    bf16_t* ACT; const float* rowscale; const float* colmax;
    __device__ __forceinline__ void operator()(const i32x4 (&acc)[2][2][4][2], const Unit& u, int wr, int wc, int fr, int fq) const {
        const int row0 = u.pm * BM + wr * 64 + fr, col0 = u.pn * HALF + wc * 32 + 8 * fq, bcol = u.pn * BM + wc * 32 + 8 * fq;
        f32x4 cw[2][2];
#pragma unroll
        for (int bj = 0; bj < 2; ++bj)
#pragma unroll
            for (int n = 0; n < 2; ++n) cw[bj][n] = *(const f32x4*)(colmax + bcol + bj * HALF + 4 * n) * (1.0f / 127.0f);
        float rs[2][4];
#pragma unroll
        for (int ai = 0; ai < 2; ++ai)
#pragma unroll
            for (int m = 0; m < 4; ++m) rs[ai][m] = rowscale[row0 + ai * HALF + m * 16];
#pragma unroll
        for (int ai = 0; ai < 2; ++ai)
#pragma unroll
            for (int m = 0; m < 4; ++m) {
                const int row = row0 + ai * HALF + m * 16; f32x4 o[2];
#pragma unroll
                for (int n = 0; n < 2; ++n) {
#pragma unroll
                    for (int j = 0; j < 4; ++j) { const float g = (float)acc[ai][0][m][n][j] * rs[ai][m] * cw[0][n][j], up = (float)acc[ai][1][m][n][j] * rs[ai][m] * cw[1][n][j];
                        o[n][j] = g * __builtin_amdgcn_rcpf(1.0f + __builtin_amdgcn_exp2f(-1.44269504f * g)) * up; } }
                *(u32x4*)((char*)ACT + blk_byte(row, col0, 11008)) = pack8(o[0], o[1]);
            }
    }
    __device__ __forceinline__ void tail(int row, int cg, int pn, int q, f32x4 g, f32x4 up) const {
        const float rs = rowscale[row] * (1.0f / 127.0f);
        const f32x4 cgv = *(const f32x4*)(colmax + pn * BM + q * 32 + 4 * cg), cuv = *(const f32x4*)(colmax + pn * BM + HALF + q * 32 + 4 * cg);
        g = g * cgv * rs; up = up * cuv * rs; f32x4 o;
#pragma unroll
        for (int j = 0; j < 4; ++j) o[j] = g[j] * __builtin_amdgcn_rcpf(1.0f + __builtin_amdgcn_exp2f(-1.44269504f * g[j])) * up[j];
        typedef unsigned u32x2t __attribute__((ext_vector_type(2)));
        u32x2t w; w.x = cvt_pk_bf16(o[0], o[1]); w.y = cvt_pk_bf16(o[2], o[3]);
        *(u32x2t*)((char*)ACT + blk_byte(row, pn * HALF + q * 32 + 4 * cg, 11008)) = w;
    }
};
constexpr size_t OUT_KP = 34603008, OUT_VP = 34734080, OUT_KS = 34865152, OUT_VS = 34996224, OUT_SGUV = 35127296;
template <bool I8> struct EpiQKVT {
    typedef int i32x4_t __attribute__((ext_vector_type(4)));
    typedef typename AccSel<I8>::T AccT;
    static constexpr bool PERM = true, AFTER_DRAIN = false;
    bf16_t *KB, *VB, *QB; float* out; const u64* ssq; const float* kg; const float* qg; const float* rowscale; const float* cmq;
    __device__ __forceinline__ void operator()(const AccT (&acc)[2][2][4][2], const Unit& u, int wr, int wc, int fr, int fq) const {
        const int row0 = u.pm * BM + wr * 64 + fr;
        const bool isk = u.pn < 2, isq = u.pn >= 4, isv = !isk && !isq;
        const int hidx = (isk ? u.pn : (isq ? u.pn - 4 : u.pn - 2)) * 4 + wc;
        bf16_t* const kvb = isk ? KB : VB; const size_t o_s = isk ? OUT_KS : OUT_VS, o_p = isk ? OUT_KP : OUT_VP;
        const float* gp = (u.pn < 2) ? kg : qg;
        f32x4 gv[2][2];
#pragma unroll
        for (int bj = 0; bj < 2; ++bj)
#pragma unroll
            for (int n = 0; n < 2; ++n) gv[bj][n] = *(const f32x4*)(gp + 32 * bj + 8 * fq + 4 * n);
        const float gs = isq ? 0.125f : 1.0f;
        float rs[2][4];
#pragma unroll
        for (int ai = 0; ai < 2; ++ai)
#pragma unroll
            for (int m = 0; m < 4; ++m) rs[ai][m] = I8 ? rowscale[row0 + ai * HALF + m * 16] : rstd_of(ssq, row0 + ai * HALF + m * 16);
        f32x4 cw[2][2];
#pragma unroll
        for (int bj = 0; bj < 2; ++bj)
#pragma unroll
            for (int n = 0; n < 2; ++n) cw[bj][n] = I8 ? *(const f32x4*)(cmq + u.pn * BM + bj * HALF + wc * 32 + 8 * fq + 4 * n) * (1.0f / 127.0f) : (f32x4){1.f, 1.f, 1.f, 1.f};
#pragma unroll
        for (int ai = 0; ai < 2; ++ai)
#pragma unroll
            for (int m = 0; m < 4; ++m) {
                const int row = row0 + ai * HALF + m * 16;
                f32x4 t[2][2]; float ss = 0.f;
#pragma unroll
                for (int bj = 0; bj < 2; ++bj)
#pragma unroll
                    for (int n = 0; n < 2; ++n) { if constexpr (I8) t[bj][n] = __builtin_convertvector(acc[ai][bj][m][n], f32x4) * cw[bj][n] * rs[ai][m]; else t[bj][n] = acc[ai][bj][m][n] * rs[ai][m]; ss += ssq4(t[bj][n]); }
                if (!isv) {
                    ss += __shfl_xor(ss, 16); ss += __shfl_xor(ss, 32);
                    const float r = rsqrtf(ss * (1.0f / 64.0f) + 1e-6f) * gs;
#pragma unroll
                    for (int bj = 0; bj < 2; ++bj)
#pragma unroll
                        for (int n = 0; n < 2; ++n) t[bj][n] = t[bj][n] * r * gv[bj][n];
                }
                if (isq) {
                    bf16_t* p = QB + (size_t)row * 4096 + hidx * 64 + 8 * fq;
#pragma unroll
                    for (int bj = 0; bj < 2; ++bj) *(u32x4*)(p + 32 * bj) = pack8(t[bj][0], t[bj][1]);
                } else {
                    const int kr = row < 8192 ? row : 8192 + 160 * ((row - 8192) >> 5) + 128 + ((row - 8192) & 31);
                    bf16_t* p = kvb + (size_t)kr * 512 + hidx * 64 + 8 * fq;
#pragma unroll
                    for (int bj = 0; bj < 2; ++bj) *(u32x4*)(p + 32 * bj) = pack8(t[bj][0], t[bj][1]);
                    float* op = nullptr;
                    if (row >= 8192) op = out + o_s + (size_t)(row - 8192) * 512 + hidx * 64 + 8 * fq;
                    else { const int tt = row & 4095; if (tt >= 3968) op = out + o_p + (size_t)((row >> 12) * 128 + tt - 3968) * 512 + hidx * 64 + 8 * fq; }
                    if (op) {
#pragma unroll
                        for (int bj = 0; bj < 2; ++bj) { *(f32x4*)(op + 32 * bj) = t[bj][0]; *(f32x4*)(op + 32 * bj + 4) = t[bj][1]; }
                    }
                }
            }
    }
    static constexpr bool TAIL_SPLIT = false;
    __device__ __forceinline__ void tail(int row, int cg, int pn, int q, f32x4 v0, f32x4 v1) const {
        const bool isk = pn < 2, isq = pn >= 4, isv = !isk && !isq;
        const int hidx = (isk ? pn : (isq ? pn - 4 : pn - 2)) * 4 + q;
        const float rs = I8 ? rowscale[row] * (1.0f / 127.0f) : rstd_of(ssq, row);
        v0 = v0 * rs; v1 = v1 * rs;
        if constexpr (I8) { const float* cp = cmq + pn * BM + ((8 * cg) >> 5) * HALF + q * 32 + ((8 * cg) & 31); v0 = v0 * *(const f32x4*)cp; v1 = v1 * *(const f32x4*)(cp + 4); }
        if (!isv) {
            const float* gp = isk ? kg : qg;
            const f32x4 g0 = *(const f32x4*)(gp + 8 * cg), g1 = *(const f32x4*)(gp + 8 * cg + 4);
            float ss = ssq4(v0) + ssq4(v1); ss += __shfl_xor(ss, 1); ss += __shfl_xor(ss, 2); ss += __shfl_xor(ss, 4);
            const float r = rsqrtf(ss * (1.0f / 64.0f) + 1e-6f) * (isq ? 0.125f : 1.0f);
            v0 = v0 * r * g0; v1 = v1 * r * g1;
        }
        if (isq) { *(u32x4*)(QB + (size_t)row * 4096 + hidx * 64 + 8 * cg) = pack8(v0, v1); }
        else {
            const int kr = 8192 + 160 * ((row - 8192) >> 5) + 128 + ((row - 8192) & 31);
            *(u32x4*)((isk ? KB : VB) + (size_t)kr * 512 + hidx * 64 + 8 * cg) = pack8(v0, v1);
            float* op = out + (isk ? OUT_KS : OUT_VS) + (size_t)(row - 8192) * 512 + hidx * 64 + 8 * cg;
            *(f32x4*)op = v0; *(f32x4*)(op + 4) = v1;
        }
    }
};
typedef EpiQKVT<false> EpiQKV;
struct QOrder : StaticOrder {
    __device__ bool next(int i, Unit& u) const {
        long L;
        if (G != 256) { L = (long)i * G + c; if (L >= nwg) return false; }
        else if (c >= 128) { if (i >= 3) return false; L = (long)i * 128 + (c - 128); } else { if (i >= 1) return false; L = 384 + c; }
        int wgid = (int)L; { const int q = nwg / NXCD, r = nwg % NXCD, xcd = wgid % NXCD, off = wgid / NXCD; wgid = (xcd < r ? xcd * (q + 1) : r * (q + 1) + (xcd - r) * q) + off; }
        const int nig = WGM * nN, gid = wgid / nig, fm = gid * WGM, gsz = (nM - fm) < WGM ? (nM - fm) : WGM;
        u.pm = fm + ((wgid % nig) % gsz); u.pn = 4 + (wgid % nig) / gsz; return true;
    }
};
typedef int i32x4 __attribute__((ext_vector_type(4)));
__device__ __forceinline__ f32x4 mma16(bf16x8 a, bf16x8 b, f32x4 c) { return __builtin_amdgcn_mfma_f32_16x16x32_bf16(a, b, c, 0, 0, 0); }
__device__ __forceinline__ i32x4 mma16(bf16x8 a, bf16x8 b, i32x4 c) { return __builtin_amdgcn_mfma_i32_16x16x64_i8(__builtin_bit_cast(i32x4, a), __builtin_bit_cast(i32x4, b), c, 0, 0, 0); }
template <class Epi, class Sched, bool ALIGN_EPI = false, bool SP2 = false>
__device__ __forceinline__ void gemm_phase(PG8_LAS unsigned char* lds, const Gemm g, const Sched& S, const Epi& E) {
    const int tid = threadIdx.x, wid = __builtin_amdgcn_readfirstlane(tid >> 6), lane = tid & 63, wr = wid >> 2, wc = wid & 3, fr = lane & 15, fq = lane >> 4;
    const int K = g.K, nt = K / BK;
    unsigned voffA[2], voffB[2];
#pragma unroll
    for (int i = 0; i < 2; ++i) { int R, C; stage_rc(tid * 16 + i * 8192, R, C); const int Rb = Epi::PERM ? ((R & ~31) + perm32(R & 31)) : R;
        voffA[i] = g.ablk ? (unsigned)lds_byte(R, C) : (unsigned)(R * K + C) * 2u; voffB[i] = g.bblk ? (unsigned)lds_byte(Rb, C) : (unsigned)(Rb * K + C) * 2u; }
    const size_t kA = g.ablk ? (size_t)32768 : (size_t)(BK * 2), kB = g.bblk ? (size_t)32768 : (size_t)(BK * 2);
    const size_t hA = g.ablk ? (size_t)16384 : (size_t)HALF * K * 2, hB = g.bblk ? (size_t)16384 : (size_t)HALF * K * 2;
    const size_t tstep = (size_t)2 * HALF * K * 2;
    const unsigned ldsw = (unsigned)wid * 1024u;
    const int aoff = lds_byte(wr * 64 + fr, fq * 8), boff = lds_byte(wc * 32 + fr, fq * 8);
#define PG8_SA(b, h) (((b) * 2 + (h)) * HTB)
#define PG8_SB(b, h) ((4 + (b) * 2 + (h)) * HTB)
#define PG8_STAGE(bufoff, gbase, voff) do { _Pragma("unroll") for (int _i = 0; _i < 2; ++_i) \
        __builtin_amdgcn_global_load_lds((const unsigned*)((const char*)(gbase) + (voff)[_i]), (PG8_LAS unsigned*)(lds + (bufoff) + ldsw + _i * 8192), 16, 0, 0); } while (0)
#define PG8_LDA(dst, b, h) do { _Pragma("unroll") for (int m = 0; m < 4; ++m) _Pragma("unroll") for (int k = 0; k < 2; ++k) dst[m][k] = *(const PG8_LAS bf16x8*)(lds + PG8_SA(b, h) + aoff + m * 2048 + k * 1024); } while (0)
#define PG8_LDB(dst, b, h) do { _Pragma("unroll") for (int n = 0; n < 2; ++n) _Pragma("unroll") for (int k = 0; k < 2; ++k) dst[n][k] = *(const PG8_LAS bf16x8*)(lds + PG8_SB(b, h) + boff + n * 2048 + k * 1024); } while (0)
#define PG8_MMA(ai, bj, At, Bt) do { __builtin_amdgcn_s_setprio(1); _Pragma("unroll") for (int m = 0; m < 4; ++m) _Pragma("unroll") for (int n = 0; n < 2; ++n) _Pragma("unroll") for (int k = 0; k < 2; ++k) \
        acc[ai][bj][m][n] = mma16(Bt[n][k], At[m][k], acc[ai][bj][m][n]); __builtin_amdgcn_s_setprio(0); } while (0)
#define PG8_WAIT_V(n) asm volatile("s_waitcnt vmcnt(" #n ")" ::: "memory")
#define PG8_WAIT_L(n) asm volatile("s_waitcnt lgkmcnt(" #n ")" ::: "memory")
#define PG8_BAR __builtin_amdgcn_s_barrier()
#define PG8_SCHED __builtin_amdgcn_sched_barrier(0)
    Unit cur, nxt; int ui = 0;
    if (!S.next(0, cur)) return;
    typedef typename Epi::AccT AccT;
    AccT acc[2][2][4][2];
#pragma unroll
    for (int a = 0; a < 2; ++a)
#pragma unroll
        for (int b = 0; b < 2; ++b)
#pragma unroll
            for (int m = 0; m < 4; ++m)
#pragma unroll
                for (int n = 0; n < 2; ++n) acc[a][b][m][n] = (AccT){0, 0, 0, 0};
    bf16x8 At[4][2], B0[2][2], B1[2][2];
    const char* cA = (const char*)g.A + (size_t)cur.pm * tstep; const char* cB = (const char*)g.Bt + (size_t)cur.pn * tstep;
    S.a_ready(cur);
    if constexpr (SP2) {
        PG8_STAGE(PG8_SB(0, 0), cB, voffB); PG8_STAGE(PG8_SB(0, 1), cB + hB, voffB); PG8_STAGE(PG8_SA(0, 0), cA, voffA); PG8_STAGE(PG8_SA(0, 1), cA + hA, voffA);
        if (wr == 1) PG8_BAR;
        PG8_WAIT_V(2); PG8_BAR;
        PG8_STAGE(PG8_SB(1, 0), cB + kB, voffB); PG8_STAGE(PG8_SA(1, 0), cA + kA, voffA); PG8_STAGE(PG8_SB(1, 1), cB + hB + kB, voffB);
        PG8_WAIT_V(6); PG8_BAR;
    } else {
        PG8_STAGE(PG8_SB(0, 0), cB, voffB); PG8_STAGE(PG8_SA(0, 0), cA, voffA); PG8_STAGE(PG8_SB(0, 1), cB + hB, voffB); PG8_STAGE(PG8_SA(0, 1), cA + hA, voffA);
        if (wr == 1) PG8_BAR;
        PG8_WAIT_V(4); PG8_BAR;
        PG8_STAGE(PG8_SB(1, 0), cB + kB, voffB); PG8_STAGE(PG8_SA(1, 0), cA + kA, voffA); PG8_STAGE(PG8_SB(1, 1), cB + hB + kB, voffB);
        PG8_WAIT_V(6); PG8_BAR;
    }
    for (;;) {
        const bool has_next = S.next(ui + 1, nxt);
        const char* nA = has_next ? (const char*)g.A + (size_t)nxt.pm * tstep : cA; const char* nB = has_next ? (const char*)g.Bt + (size_t)nxt.pn * tstep : cB;
        for (int t = 0; t < nt; t += 2) {
            const bool last = (t == nt - 2);
            const char* a1 = cA + (size_t)(t + 1) * kA;
            const char* a2 = last ? nA : cA + (size_t)(t + 2) * kA; const char* b2 = last ? nB : cB + (size_t)(t + 2) * kB;
            const char* a3 = a2 + kA; const char* b3 = b2 + kB;
            if (last && has_next) S.a_ready(nxt);
            if constexpr (SP2) {
            PG8_LDB(B0, 0, 0); PG8_LDB(B1, 0, 1); PG8_SCHED; PG8_LDA(At, 0, 0); PG8_STAGE(PG8_SA(1, 1), a1 + hA, voffA);
            PG8_WAIT_V(8); PG8_WAIT_L(0); PG8_BAR; PG8_MMA(0, 0, At, B0); PG8_MMA(0, 1, At, B1); PG8_BAR; PG8_SCHED;
            PG8_LDA(At, 0, 1); PG8_STAGE(PG8_SB(0, 0), b2, voffB); PG8_STAGE(PG8_SB(0, 1), b2 + hB, voffB); PG8_STAGE(PG8_SA(0, 0), a2, voffA);
            PG8_WAIT_V(8); PG8_WAIT_L(0); PG8_BAR; PG8_MMA(1, 0, At, B0); PG8_MMA(1, 1, At, B1); PG8_BAR; PG8_SCHED;
            PG8_LDB(B0, 1, 0); PG8_LDB(B1, 1, 1); PG8_SCHED; PG8_LDA(At, 1, 0); PG8_STAGE(PG8_SA(0, 1), a2 + hA, voffA);
            PG8_WAIT_V(8); PG8_WAIT_L(0); PG8_BAR; PG8_MMA(0, 0, At, B0); PG8_MMA(0, 1, At, B1); PG8_BAR; PG8_SCHED;
            PG8_LDA(At, 1, 1); PG8_STAGE(PG8_SB(1, 0), b3, voffB); PG8_STAGE(PG8_SB(1, 1), b3 + hB, voffB); PG8_STAGE(PG8_SA(1, 0), a3, voffA);
            PG8_WAIT_V(8); PG8_WAIT_L(0); PG8_BAR; PG8_MMA(1, 0, At, B0); PG8_MMA(1, 1, At, B1); PG8_BAR; PG8_SCHED;
            } else {
            PG8_LDB(B0, 0, 0); PG8_SCHED; PG8_LDA(At, 0, 0); PG8_STAGE(PG8_SA(1, 1), a1 + hA, voffA);
            PG8_WAIT_L(8); PG8_BAR; PG8_WAIT_L(0); PG8_MMA(0, 0, At, B0); PG8_BAR; PG8_SCHED;
            PG8_LDB(B1, 0, 1); PG8_STAGE(PG8_SB(0, 0), b2, voffB);
            PG8_BAR; PG8_WAIT_L(0); PG8_MMA(0, 1, At, B1); PG8_BAR;
            PG8_LDA(At, 0, 1); PG8_STAGE(PG8_SA(0, 0), a2, voffA);
            PG8_BAR; PG8_WAIT_L(0); PG8_MMA(1, 0, At, B0); PG8_BAR; PG8_SCHED;
            PG8_STAGE(PG8_SB(0, 1), b2 + hB, voffB);
            PG8_WAIT_V(6); PG8_BAR; PG8_MMA(1, 1, At, B1); PG8_BAR;
            PG8_LDB(B0, 1, 0); PG8_SCHED; PG8_LDA(At, 1, 0); PG8_STAGE(PG8_SA(0, 1), a2 + hA, voffA);
            PG8_WAIT_L(8); PG8_BAR; PG8_WAIT_L(0); PG8_MMA(0, 0, At, B0); PG8_BAR; PG8_SCHED;
            PG8_LDB(B1, 1, 1); PG8_STAGE(PG8_SB(1, 0), b3, voffB);
            PG8_BAR; PG8_WAIT_L(0); PG8_MMA(0, 1, At, B1); PG8_BAR;
            PG8_LDA(At, 1, 1); PG8_STAGE(PG8_SA(1, 0), a3, voffA);
            PG8_BAR; PG8_WAIT_L(0); PG8_MMA(1, 0, At, B0); PG8_BAR; PG8_SCHED;
            PG8_STAGE(PG8_SB(1, 1), b3 + hB, voffB);
            PG8_WAIT_V(6); PG8_BAR; PG8_MMA(1, 1, At, B1); PG8_BAR;
            }
        }
        if constexpr (ALIGN_EPI) { if (wr == 0) PG8_BAR; }
        if constexpr (!Epi::AFTER_DRAIN) { E(acc, cur, wr, wc, fr, fq); S.done(cur); }
        if (!has_next) break;
#pragma unroll
        for (int a = 0; a < 2; ++a)
#pragma unroll
            for (int b = 0; b < 2; ++b)
#pragma unroll
                for (int m = 0; m < 4; ++m)
#pragma unroll
                    for (int n = 0; n < 2; ++n) acc[a][b][m][n] = (AccT){0, 0, 0, 0};
        cur = nxt; cA = nA; cB = nB; ++ui;
        if constexpr (ALIGN_EPI) { if (wr == 1) PG8_BAR; }
    }
    PG8_WAIT_V(0);
    if constexpr (!ALIGN_EPI) { if (wr == 0) PG8_BAR; }
    PG8_BAR;
    if constexpr (Epi::AFTER_DRAIN) { E.fused(acc, cur, wr, wc, fr, fq, lds, wid, lane); S.done(cur); }
#undef PG8_SA
#undef PG8_SB
#undef PG8_STAGE
#undef PG8_LDA
#undef PG8_LDB
#undef PG8_MMA
#undef PG8_WAIT_V
#undef PG8_WAIT_L
#undef PG8_BAR
#undef PG8_SCHED
}
}

#ifndef PG8_SP2
#define PG8_SP2 true
#endif
#ifndef PG8_ALIGN
#define PG8_ALIGN true
#endif
#ifndef MK_ONE_LAUNCH
#define MK_ONE_LAUNCH 1
#endif
constexpr int NWAVES = 8, NPHASES = 15;
constexpr int D = 4096, MP = 8192, MS = 256, M = MP + MS, DFF = 11008, NGU = 2 * DFF, NQKV = 5120, NSGU = 8192;
constexpr int KV_ROWS = 8192 + 8 * 160;
constexpr size_t MiB = 1u << 20;
constexpr size_t WS_CTL = 0, CTL_ZERO_BYTES = 1 * MiB;
constexpr int CW_BAR = 4096, CW_Q = 8192;
constexpr size_t ST_OFF = 65536, ST_STRIDE = 67584;
static_assert(ST_STRIDE == (size_t)M * 8 && ST_OFF + 6 * ST_STRIDE <= CTL_ZERO_BYTES, "stat arrays inside the memset region");
constexpr size_t CM_OFF = 524288, CM_STRIDE = 88064;
constexpr size_t RS_OFF = 720896;
constexpr size_t CMQ_OFF = 786432;
static_assert(ST_OFF + 6 * ST_STRIDE <= CM_OFF && CM_OFF + 2 * CM_STRIDE <= RS_OFF && RS_OFF + (size_t)M * 4 <= CMQ_OFF && CMQ_OFF + 5120 * 4 <= CTL_ZERO_BYTES, "control region map");
constexpr size_t CMO_OFF = 819200;
static_assert(CMQ_OFF + 5120 * 4 <= CMO_OFF && CMO_OFF + 4096 * 4 <= CTL_ZERO_BYTES, "control region map");
constexpr size_t WQ8_SHIFT = 4u << 20;
constexpr size_t WS_WSB = 1 * MiB;
constexpr size_t WS_W1T = 2 * MiB, WS_W2T = 66 * MiB, WS_WGU0 = 98 * MiB, WS_WD0 = 270 * MiB, WS_WQKV = 356 * MiB, WS_WOT = 396 * MiB, WS_WGU1 = 428 * MiB, WS_WD1 = 600 * MiB;
constexpr size_t WS_XB = 686 * MiB, WS_H = 752 * MiB  , WS_ACT = 884 * MiB, WS_ZQ = 1062 * MiB, WS_O = 1128 * MiB, WS_KB = 1194 * MiB, WS_VB = 1204 * MiB, WS_END = 1214 * MiB;
static_assert(WS_W1T + (size_t)NSGU * D * 2 <= WS_W2T && WS_W2T + (size_t)D * D * 2 <= WS_WGU0 && WS_WGU0 + (size_t)NGU * D * 2 <= WS_WD0 && WS_WD0 + (size_t)D * DFF * 2 <= WS_WQKV &&
              WS_WQKV + (size_t)NQKV * D * 2 <= WS_WOT && WS_WOT + (size_t)D * D * 2 <= WS_WGU1 && WS_WGU1 + (size_t)NGU * D * 2 <= WS_WD1 && WS_WD1 + (size_t)D * DFF * 2 <= WS_XB, "weight map");
static_assert(WS_XB + (size_t)M * D * 2 <= WS_H && WS_H + (size_t)M * D * 4 <= WS_ACT && WS_ACT + (size_t)M * DFF * 2 <= WS_ZQ && WS_ACT + (size_t)M * NSGU * 2 <= WS_ZQ &&
              WS_ZQ + (size_t)M * D * 2 <= WS_O && WS_O + (size_t)M * D * 2 <= WS_KB && WS_KB + (size_t)KV_ROWS * 512 * 2 <= WS_VB && WS_VB + (size_t)KV_ROWS * 512 * 2 <= WS_END, "activation map");
constexpr int SCR_BYTES = 139264;
constexpr int LDSCTL_OFF = SCR_BYTES, MISC_OFF = LDSCTL_OFF + 320;
constexpr int LDS_BYTES = 147456;
static_assert(MISC_OFF + 128 <= LDS_BYTES && pg8::STAGE_BYTES <= SCR_BYTES, "LDS map");

#define GAS __attribute__((address_space(1)))
#define LAS __attribute__((address_space(3)))
typedef unsigned short bf16;
typedef unsigned v4u __attribute__((ext_vector_type(4)));
typedef unsigned v2u __attribute__((ext_vector_type(2)));
typedef float f32x4 __attribute__((ext_vector_type(4)));
typedef short bf16x8 __attribute__((ext_vector_type(8)));
typedef unsigned long long u64;
#define LDS_WAIT() asm volatile("s_waitcnt lgkmcnt(0)" ::: "memory")
#define VM_WAIT() asm volatile("s_waitcnt vmcnt(0)" ::: "memory")
__device__ __forceinline__ unsigned f2bf(float f) { unsigned u = __builtin_bit_cast(unsigned, f); return (u + 0x7fffu + ((u >> 16) & 1u)) >> 16; }
typedef float f32x2_t __attribute__((ext_vector_type(2)));
typedef __bf16 bf16x2_t __attribute__((ext_vector_type(2)));
__device__ __forceinline__ unsigned pk2(float lo, float hi) { const f32x2_t v = {lo, hi}; const bf16x2_t b = __builtin_convertvector(v, bf16x2_t); return __builtin_bit_cast(unsigned, b); }
__device__ __forceinline__ float bflo(unsigned w) { return __builtin_bit_cast(float, w << 16); }
__device__ __forceinline__ float bfhi(unsigned w) { return __builtin_bit_cast(float, w & 0xffff0000u); }

#define XB_TMO      128
#define XB_XCNT(j)  (256  + 64 * (j))
#define XB_XSUB(j)  (1280 + 64 * (j))
#define XB_XGEN(j)  (2304 + 64 * (j))
#define XB_TOP      3328
#define XB_TOPGEN   3392
#define XCD_BAR_WORDS 3456
#define XB_SPIN_CAP (1u << 18)

__device__ __forceinline__ unsigned xb_ld(unsigned* p)              { return __hip_atomic_load(p, __ATOMIC_RELAXED, __HIP_MEMORY_SCOPE_AGENT); }
__device__ __forceinline__ unsigned xb_add(unsigned* p, unsigned v) { return __hip_atomic_fetch_add(p, v, __ATOMIC_RELAXED, __HIP_MEMORY_SCOPE_AGENT); }
__device__ __forceinline__ unsigned xb_xcc_id() { return (unsigned)__builtin_amdgcn_s_getreg((3 << 11) | 20) & 0xFu; }
#define XB_SPIN(cond, bar) do { unsigned _sp = 0; while (cond) { __builtin_amdgcn_s_sleep(1); \
    if ((++_sp & 255u) == 0u) { if (xb_ld(&(bar)[XB_TMO])) break; if (_sp > XB_SPIN_CAP) { atomicAdd(&(bar)[XB_TMO], 1u); break; } } } } while (0)

struct XcdBarrier {
    unsigned* bar; unsigned x;
    volatile LAS unsigned* st;
};

__device__ __forceinline__ XcdBarrier xcd_barrier_post(unsigned* bar, volatile LAS unsigned* st) {
    XcdBarrier b; b.bar = bar; b.x = xb_xcc_id(); b.st = st;
    if (threadIdx.x == 0) (void)xb_add(&bar[XB_XCNT(b.x)], 1u);
    return b;
}
__device__ __forceinline__ void xcd_barrier_complete(unsigned* bar, unsigned x, unsigned& nloc, unsigned& nx) {
    const unsigned G = gridDim.x * gridDim.y * gridDim.z;
    unsigned sum, cnt, mine, sp = 0u;
    for (;;) {
        sum = 0u; cnt = 0u; mine = 0u;
#pragma unroll
        for (unsigned j = 0; j < 16; ++j) { const unsigned c = xb_ld(&bar[XB_XCNT(j)]); sum += c; cnt += (c > 0u) ? 1u : 0u; mine = (j == x) ? c : mine; }
        if (sum == G) break;
        __builtin_amdgcn_s_sleep(1);
        if ((++sp & 255u) == 0u) { if (xb_ld(&bar[XB_TMO])) break; if (sp > XB_SPIN_CAP) { atomicAdd(&bar[XB_TMO], 1u); break; } }
    }
    nloc = mine > 0u ? mine : 1u; nx = cnt > 0u ? cnt : 1u;
}

__device__ __forceinline__ void xcd_barrier(const XcdBarrier& b) {
    asm volatile("s_waitcnt vmcnt(0)" ::: "memory");
    __syncthreads();
    if (threadIdx.x == 0) {
        unsigned* bar = b.bar;
        __builtin_amdgcn_s_waitcnt(0);
        unsigned nloc = b.st[0], nx = b.st[1];
        if (nloc == 0u) { xcd_barrier_complete(bar, b.x, nloc, nx); b.st[0] = nloc; b.st[1] = nx; }
        const unsigned old = xb_add(&bar[XB_XSUB(b.x)], 1u);
        const unsigned gen = old / nloc;
        if (old + 1u == (gen + 1u) * nloc) {
            __builtin_amdgcn_fence(__ATOMIC_RELEASE, "agent");
            asm volatile("s_waitcnt vmcnt(0)" ::: "memory");
            const unsigned og = xb_add(&bar[XB_TOP], 1u);
            const unsigned tg = og / nx;
            if (og + 1u == (tg + 1u) * nx) xb_add(&bar[XB_TOPGEN], 1u);
            else XB_SPIN(xb_ld(&bar[XB_TOPGEN]) == tg, bar);
            __builtin_amdgcn_fence(__ATOMIC_ACQUIRE, "agent");
            xb_add(&bar[XB_XGEN(b.x)], 1u);
            asm volatile("s_waitcnt vmcnt(0)" ::: "memory");
        } else {
            XB_SPIN(xb_ld(&bar[XB_XGEN(b.x)]) == gen, bar);
            __builtin_amdgcn_fence(__ATOMIC_ACQUIRE, "agent");
            asm volatile("s_waitcnt vmcnt(0)" ::: "memory");
        }
    }
    __syncthreads();
}


using pg8::FIX_INV;
__device__ __forceinline__ float wave_sum(float v) {
#pragma unroll
    for (int o = 1; o < 64; o <<= 1) v += __shfl_xor(v, o);
    return v;
}
__device__ __forceinline__ int maprow(int map, int n) {
    const int r12 = ((n >> 7) << 8) + (n & 127) + (map == 2 ? 128 : 0);
    const int r3 = (n & ~255) + (((n >> 5) & 1) << 7) + (((n >> 6) & 3) << 5) + (n & 31);
    return map == 0 ? n : (map == 3 ? r3 : r12);
}
struct TItem { const float* W; const float* gain; bf16* WT; const float* cmax; int K, N, map, coff, k0, n0, blk; };
struct TRegs { f32x4 v[16]; f32x4 g0, g1; float cm[8]; };
__device__ __forceinline__ void titem_load(const TItem& t, TRegs& R, const float* dummy, int lane) {
    const float* p = t.W + (size_t)(t.k0 + (lane >> 4)) * t.N + t.n0 + 4 * (lane & 15);
#pragma unroll
    for (int i = 0; i < 16; ++i) R.v[i] = __builtin_nontemporal_load((const f32x4*)(p + (size_t)(4 * i) * t.N));
    const float* gp = (t.gain ? t.gain + t.k0 : dummy + (t.k0 & 4095)) + 8 * (lane & 7);
    R.g0 = *(const f32x4*)gp; R.g1 = *(const f32x4*)(gp + 4);
    const float* cp = t.cmax ? t.cmax : dummy;
#pragma unroll
    for (int j = 0; j < 8; ++j) R.cm[j] = cp[t.cmax ? maprow(t.map, t.n0 + 8 * j + (lane >> 3) + t.coff) : j];
}
__device__ __forceinline__ void titem_lds_write(const TRegs& R, LAS float* scr, int lane) {
#pragma unroll
    for (int i = 0; i < 16; ++i) { const int kk = 4 * i + (lane >> 4), c4 = (lane & 15) ^ (((kk >> 3) & 3) << 1); *(LAS f32x4*)(scr + kk * 64 + 4 * c4) = R.v[i]; }
}
__device__ __forceinline__ void titem_emit(const TItem& t, f32x4 g0, f32x4 g1, const float (&cm)[8], LAS float* scr, int lane) {
    LDS_WAIT(); asm volatile("" ::: "memory");
    const int c = lane & 7, nn = lane >> 3;
    const bool hg = t.gain != nullptr; const f32x4 one = {1.f, 1.f, 1.f, 1.f};
    g0 = hg ? g0 : one; g1 = hg ? g1 : one;
    const int sw = (c & 3) << 1;
#pragma unroll
    for (int j = 0; j < 8; ++j) { const int n = 8 * j + nn; const LAS float* sp = scr + (8 * c) * 64 + ((((n >> 2) ^ sw) << 2) | (n & 3));
        const size_t drow = (size_t)maprow(t.map, t.n0 + n + t.coff);
        if (t.cmax) {
            const float inv = cm[j] > 0.f ? 127.0f / cm[j] : 0.f;
            const int q0 = __float2int_rn(sp[0 * 64] * g0.x * inv), q1 = __float2int_rn(sp[1 * 64] * g0.y * inv), q2 = __float2int_rn(sp[2 * 64] * g0.z * inv), q3 = __float2int_rn(sp[3 * 64] * g0.w * inv);
            const int q4 = __float2int_rn(sp[4 * 64] * g1.x * inv), q5 = __float2int_rn(sp[5 * 64] * g1.y * inv), q6 = __float2int_rn(sp[6 * 64] * g1.z * inv), q7 = __float2int_rn(sp[7 * 64] * g1.w * inv);
            v2u o; o.x = (unsigned)(q0 & 255) | ((unsigned)(q1 & 255) << 8) | ((unsigned)(q2 & 255) << 16) | ((unsigned)q3 << 24);
            o.y = (unsigned)(q4 & 255) | ((unsigned)(q5 & 255) << 8) | ((unsigned)(q6 & 255) << 16) | ((unsigned)q7 << 24);
            __builtin_nontemporal_store(o, (GAS v2u*)(t.blk ? (unsigned char*)t.WT + pg8::blk_byte((int)drow, (t.k0 + 8 * c) >> 1, t.K >> 1) : (unsigned char*)t.WT + drow * t.K + t.k0 + 8 * c));
        } else {
        v4u o; o.x = pk2(sp[0 * 64] * g0.x, sp[1 * 64] * g0.y); o.y = pk2(sp[2 * 64] * g0.z, sp[3 * 64] * g0.w); o.z = pk2(sp[4 * 64] * g1.x, sp[5 * 64] * g1.y); o.w = pk2(sp[6 * 64] * g1.z, sp[7 * 64] * g1.w);
        __builtin_nontemporal_store(o, (GAS v4u*)(t.blk ? (bf16*)((char*)t.WT + pg8::blk_byte((int)drow, t.k0 + 8 * c, t.K)) : t.WT + drow * t.K + t.k0 + 8 * c)); } }
    LDS_WAIT(); asm volatile("" ::: "memory");
}
struct Args { const float* in[23]; float* out; unsigned char* ws; int ph_lo, ph_hi; };
constexpr int P0_ITEMS_A = 64 * 128;
constexpr int P0_ITEMS_P1 = P0_ITEMS_A + 64 * 64 + 2 * 64 * 172 + 172 * 64 + 64 * 16 + 64 * 64, P0_ITEMS_P4 = P0_ITEMS_P1 + 64 * 64 + 64 * 172, P0_ITEMS_P6 = P0_ITEMS_P4 + 64 * 172;
constexpr int P0_ITEMS_ALL = 64 * 128 + 64 * 64 + 2 * 64 * 172 + 172 * 64 + 64 * 16 + 64 * 64 + 64 * 64 + 2 * 64 * 172 + 172 * 64;
__device__ __forceinline__ void p0_prologue(const Args& a, unsigned char* ws, LAS unsigned char* lds, int gw, int NGW, int it_lo, int it_hi, int misc, int wave, int lane) {
    LAS float* scr = (LAS float*)(lds + wave * 16384);
    constexpr int IT_1 = 64 * 128, IT_SQ = 64 * 64, IT_G = 64 * 172, IT_D = 172 * 64, IT_KV = 64 * 16;
    constexpr int NITEMS = IT_1 + IT_SQ + 2 * IT_G + IT_D + IT_KV + IT_SQ + IT_SQ + 2 * IT_G + IT_D;
    auto describe = [&](int it) -> TItem {
        TItem t; int r = it; t.gain = nullptr; t.cmax = nullptr; t.K = 4096; t.N = 4096; t.map = 0; t.coff = 0; t.blk = 1;
        if (r < IT_1) { t.W = a.in[5]; t.gain = a.in[4]; t.WT = (bf16*)(ws + WS_W1T); t.N = 8192; }
        else if ((r -= IT_1) < IT_SQ) { t.W = a.in[10]; t.WT = (bf16*)(ws + WS_W2T); }
        else if ((r -= IT_SQ) < IT_G) { t.W = a.in[20]; t.gain = a.in[19]; t.WT = (bf16*)(ws + WS_WGU0); t.N = DFF; t.map = 1; t.cmax = (const float*)(ws + CM_OFF); }
        else if ((r -= IT_G) < IT_G) { t.W = a.in[21]; t.gain = a.in[19]; t.WT = (bf16*)(ws + WS_WGU0); t.N = DFF; t.map = 2; t.cmax = (const float*)(ws + CM_OFF); }
        else if ((r -= IT_G) < IT_D) { t.W = a.in[22]; t.WT = (bf16*)(ws + WS_WD0); t.K = DFF; }
        else if ((r -= IT_D) < IT_KV) { t.W = a.in[12]; t.gain = a.in[11]; t.WT = (bf16*)(ws + WS_WQKV); t.N = 1024; t.map = 3; }
        else if ((r -= IT_KV) < IT_SQ) { t.W = a.in[15]; t.gain = a.in[14]; t.WT = (bf16*)(ws + WS_WQKV + WQ8_SHIFT); t.map = 3; t.coff = 1024; t.cmax = (const float*)(ws + CMQ_OFF); }
        else if ((r -= IT_SQ) < IT_SQ) { t.W = a.in[18]; t.WT = (bf16*)(ws + WS_WOT); t.cmax = (const float*)(ws + CMO_OFF); }
        else if ((r -= IT_SQ) < IT_G) { t.W = a.in[20] + (size_t)D * DFF; t.gain = a.in[19] + D; t.WT = (bf16*)(ws + WS_WGU1); t.N = DFF; t.map = 1; t.cmax = (const float*)(ws + CM_OFF + CM_STRIDE); }
        else if ((r -= IT_G) < IT_G) { t.W = a.in[21] + (size_t)D * DFF; t.gain = a.in[19] + D; t.WT = (bf16*)(ws + WS_WGU1); t.N = DFF; t.map = 2; t.cmax = (const float*)(ws + CM_OFF + CM_STRIDE); }
        else { r -= IT_G; t.W = a.in[22] + (size_t)D * DFF; t.WT = (bf16*)(ws + WS_WD1); t.K = DFF; }
        const int nblk = t.N >> 6, kb = r / nblk; t.k0 = 64 * kb; t.n0 = 64 * (r - kb * nblk);
        return t;
    };
    static_assert(NITEMS == P0_ITEMS_ALL && IT_1 == P0_ITEMS_A, "item counts");
    if (it_lo + gw < it_hi) {
        const int first = it_lo + gw, last = first + ((it_hi - 1 - first) / NGW) * NGW, count = (last - first) / NGW + 1;
        TRegs ra, rb; const float* dummy = a.in[4];
        TItem ta = describe(first), tb = describe(first + NGW <= last ? first + NGW : last);
        titem_load(ta, ra, dummy, lane); titem_load(tb, rb, dummy, lane);
        for (int j = 0; j < count; j += 2) {
            const int i2 = first + (j + 2) * NGW, i3 = first + (j + 3) * NGW;
            const TItem tc = describe(i2 <= last ? i2 : last), td = describe(i3 <= last ? i3 : last);
            { titem_lds_write(ra, scr, lane); const f32x4 g0 = ra.g0, g1 = ra.g1; float cm[8]; _Pragma("unroll") for (int q = 0; q < 8; ++q) cm[q] = ra.cm[q]; titem_load(tc, ra, dummy, lane); titem_emit(ta, g0, g1, cm, scr, lane); }
            { titem_lds_write(rb, scr, lane); const f32x4 g0 = rb.g0, g1 = rb.g1; float cm[8]; _Pragma("unroll") for (int q = 0; q < 8; ++q) cm[q] = rb.cm[q]; titem_load(td, rb, dummy, lane); titem_emit(tb, g0, g1, cm, scr, lane); }
            ta = tc; tb = td;
        }
        asm volatile("s_waitcnt vmcnt(0)" ::: "memory");
    }
    if (!misc) return;
    bf16* XB = (bf16*)(ws + WS_XB); u64* ssq_x = (u64*)(ws + ST_OFF);
    for (int m = gw; m < M; m += NGW) {
        const float* xrow = m < MP ? a.in[0] + (size_t)m * D : a.in[1] + (size_t)(m - MP) * D;
        const GAS f32x4* xr = (const GAS f32x4*)xrow + lane; GAS v2u* o8 = (GAS v2u*)(XB + (size_t)m * D) + lane; float ss = 0.f;
#pragma unroll 4
        for (int j = 0; j < 16; ++j) { const f32x4 v = xr[64 * j]; ss += (v.x * v.x + v.y * v.y) + (v.z * v.z + v.w * v.w); v2u o; o.x = pk2(v.x, v.y); o.y = pk2(v.z, v.w); o8[64 * j] = o; }
        ss = wave_sum(ss);
        if (lane == 0) ssq_x[m] = (u64)(ss * pg8::FIX_SCALE);
    }
    const int gt = gw * 64 + lane, NT = NGW * 64;
    bf16* KB = (bf16*)(ws + WS_KB); bf16* VB = (bf16*)(ws + WS_VB); bf16* WSB = (bf16*)(ws + WS_WSB);
    for (int i = gt; i < 65536; i += NT) {
        const int e = i * 8, b = e >> 16, t = (e >> 9) & 127, c = e & 511; const size_t dst = (size_t)(8192 + 160 * b + t) * 512 + c;
        { const f32x4 v0 = *(const f32x4*)(a.in[2] + e), v1 = *(const f32x4*)(a.in[2] + e + 4); v4u o; o.x = pk2(v0.x, v0.y); o.y = pk2(v0.z, v0.w); o.z = pk2(v1.x, v1.y); o.w = pk2(v1.z, v1.w); *(v4u*)(KB + dst) = o; }
        { const f32x4 v0 = *(const f32x4*)(a.in[3] + e), v1 = *(const f32x4*)(a.in[3] + e + 4); v4u o; o.x = pk2(v0.x, v0.y); o.y = pk2(v0.z, v0.w); o.z = pk2(v1.x, v1.y); o.w = pk2(v1.z, v1.w); *(v4u*)(VB + dst) = o; }
    }
    for (int i = gt; i < 16384; i += NT) {
        const int e = i * 8, ii = (e >> 7) & 127, j = e & 127; const bool keep = (ii >> 6) >= (j >> 6);
        const f32x4 v0 = *(const f32x4*)(a.in[8] + e), v1 = *(const f32x4*)(a.in[8] + e + 4); v4u o = {0u, 0u, 0u, 0u};
        if (keep) { o.x = pk2(v0.x, v0.y); o.y = pk2(v0.z, v0.w); o.z = pk2(v1.x, v1.y); o.w = pk2(v1.z, v1.w); }
        *(v4u*)(WSB + e) = o;
    }
}


__device__ __forceinline__ void absmax_pass(const Args& a, unsigned char* ws, int gw, int NGW, int lane) {
    constexpr int PER = 16 * 172, PERQ = 16 * 64, NIT = 4 * PER + 2 * PERQ;
    const int r = lane >> 4;
    for (int it = gw; it < NIT; it += NGW) {
        const bool iso = it >= 4 * PER + PERQ, isq = !iso && it >= 4 * PER, sq = iso || isq;
        const int mat = sq ? 0 : it / PER, rem = iso ? it - 4 * PER - PERQ : (isq ? it - 4 * PER : it - mat * PER), nblk = sq ? 64 : 172, kg = rem / nblk, nb = rem - kg * nblk, l = mat >> 1, up = mat & 1;
        const float* W = iso ? a.in[18] : (isq ? a.in[15] : (up ? a.in[21] : a.in[20]) + (size_t)l * D * DFF);
        const float* gain = iso ? a.in[14] : (isq ? a.in[14] : a.in[19] + l * D); const float gmul = iso ? 0.f : 1.f, gadd = iso ? 1.f : 0.f;
        unsigned* cmax = iso ? (unsigned*)(ws + CMO_OFF) : (isq ? (unsigned*)(ws + CMQ_OFF) : (unsigned*)(ws + CM_OFF + (size_t)l * CM_STRIDE));
        const int NW = sq ? D : DFF, amap = iso ? 0 : (isq ? 3 : 1 + up), acoff = isq ? 1024 : 0;
        const int k0 = 256 * kg, n0 = 64 * nb;
        const float* p = W + (size_t)(k0 + r) * NW + n0 + 4 * (lane & 15);
        f32x4 va[16], vb[16]; float ga[16], gb[16];
#define AM_LOAD(v_, g_, sb_) do { _Pragma("unroll") for (int i = 0; i < 16; ++i) { v_[i] = __builtin_nontemporal_load((const f32x4*)(p + (size_t)(64 * (sb_) + 4 * i) * NW)); g_[i] = gain[k0 + 64 * (sb_) + 4 * i + r] * gmul + gadd; } } while (0)
#define AM_MAX(v_, g_) do { _Pragma("unroll") for (int i = 0; i < 16; ++i) { m0 = fmaxf(m0, fabsf(v_[i].x * g_[i])); m1 = fmaxf(m1, fabsf(v_[i].y * g_[i])); m2 = fmaxf(m2, fabsf(v_[i].z * g_[i])); m3 = fmaxf(m3, fabsf(v_[i].w * g_[i])); } } while (0)
        float m0 = 0.f, m1 = 0.f, m2 = 0.f, m3 = 0.f;
        AM_LOAD(va, ga, 0); AM_LOAD(vb, gb, 1);
        AM_MAX(va, ga); AM_LOAD(va, ga, 2);
        AM_MAX(vb, gb); AM_LOAD(vb, gb, 3);
        AM_MAX(va, ga); AM_MAX(vb, gb);
#undef AM_LOAD
#undef AM_MAX
        m0 = fmaxf(m0, __shfl_xor(m0, 16)); m0 = fmaxf(m0, __shfl_xor(m0, 32)); m1 = fmaxf(m1, __shfl_xor(m1, 16)); m1 = fmaxf(m1, __shfl_xor(m1, 32));
        m2 = fmaxf(m2, __shfl_xor(m2, 16)); m2 = fmaxf(m2, __shfl_xor(m2, 32)); m3 = fmaxf(m3, __shfl_xor(m3, 16)); m3 = fmaxf(m3, __shfl_xor(m3, 32));
        if (lane < 16) {
            unsigned* cp = cmax + maprow(amap, n0 + 4 * lane + acoff);
            (void)__hip_atomic_fetch_max(cp + 0, __builtin_bit_cast(unsigned, m0), __ATOMIC_RELAXED, __HIP_MEMORY_SCOPE_AGENT);
            (void)__hip_atomic_fetch_max(cp + 1, __builtin_bit_cast(unsigned, m1), __ATOMIC_RELAXED, __HIP_MEMORY_SCOPE_AGENT);
            (void)__hip_atomic_fetch_max(cp + 2, __builtin_bit_cast(unsigned, m2), __ATOMIC_RELAXED, __HIP_MEMORY_SCOPE_AGENT);
            (void)__hip_atomic_fetch_max(cp + 3, __builtin_bit_cast(unsigned, m3), __ATOMIC_RELAXED, __HIP_MEMORY_SCOPE_AGENT);
        }
    }
}
template <int R>
__device__ __forceinline__ void quant_rows_n(const bf16* XB, const u64* ssq, unsigned char* A8, float* rowscale, int m0, int mstride, int lane) {
    v4u w[R][8]; unsigned mx[R];
#pragma unroll
    for (int r = 0; r < R; ++r) { const v4u* xr = (const v4u*)(XB + (size_t)(m0 + r * mstride) * D) + lane;
#pragma unroll
        for (int j = 0; j < 8; ++j) w[r][j] = xr[64 * j]; }
#pragma unroll
    for (int r = 0; r < R; ++r) { unsigned m = 0u;
#pragma unroll
        for (int j = 0; j < 8; ++j)
#pragma unroll
            for (int q = 0; q < 4; ++q) { const unsigned t = w[r][j][q] & 0x7fff7fffu; const unsigned lo = t & 0xffffu, hi = t >> 16; m = m > lo ? m : lo; m = m > hi ? m : hi; }
        mx[r] = m; }
#pragma unroll
    for (int o = 1; o < 64; o <<= 1)
#pragma unroll
        for (int r = 0; r < R; ++r) { const unsigned t = (unsigned)__shfl_xor((int)mx[r], o); mx[r] = mx[r] > t ? mx[r] : t; }
#pragma unroll
    for (int r = 0; r < R; ++r) { const int m = m0 + r * mstride;
        const float fmx = __builtin_bit_cast(float, mx[r] << 16), inv = fmx > 0.f ? 127.0f / fmx : 0.f;
        v2u* orow = (v2u*)(A8 + (size_t)m * D) + lane;
#pragma unroll
        for (int j = 0; j < 8; ++j) { unsigned b[8];
#pragma unroll
            for (int q = 0; q < 4; ++q) { b[2 * q] = (unsigned)__float2int_rn(bflo(w[r][j][q]) * inv) & 255u; b[2 * q + 1] = (unsigned)__float2int_rn(bfhi(w[r][j][q]) * inv) & 255u; }
            v2u o; o.x = b[0] | (b[1] << 8) | (b[2] << 16) | (b[3] << 24); o.y = b[4] | (b[5] << 8) | (b[6] << 16) | (b[7] << 24); orow[64 * j] = o; }
        if (lane == 0) rowscale[m] = fmx * (1.0f / 127.0f) * (ssq ? rsqrtf((float)ssq[m] * (pg8::FIX_INV * (1.0f / 4096.0f)) + 1e-6f) : 1.0f); }
}
__device__ __forceinline__ void quant_rows(const bf16* XB, const u64* ssq, unsigned char* A8, float* rowscale, int gw, int NGW, int lane) {
    int m = gw;
    for (; m + 3 * NGW < M; m += 4 * NGW) quant_rows_n<4>(XB, ssq, A8, rowscale, m, NGW, lane);
    for (; m < M; m += NGW) quant_rows_n<1>(XB, ssq, A8, rowscale, m, NGW, lane);
}
__device__ __forceinline__ void sgu_phase(LAS unsigned char* lds, const bf16* UV, const bf16* WSB, const u64* lnsum, const u64* lnssq, const float* ln_g, const float* ln_b,
                                          const float* b_s, bf16* Z, float* out_sguv, int wave, int lane) {
    const int fr = lane & 15, fq = lane >> 4;
    LAS unsigned char* img = lds + wave * 17408;
    for (int uidx = blockIdx.x; uidx < 576; uidx += gridDim.x) {
        const bool samp = uidx >= 512;
        const int g = uidx & 7, chunk = samp ? ((uidx - 512) >> 3) : (uidx >> 3);
        const int row_base = samp ? MP + 32 * chunk : 128 * chunk, nrows = samp ? 32 : 128;
        const int cw = 512 * g + 64 * wave;
        {
            const int cp = lane & 7, c = cw + 8 * cp;
            const f32x4 g0 = *(const f32x4*)(ln_g + c), g1 = *(const f32x4*)(ln_g + c + 4), b0 = *(const f32x4*)(ln_b + c), b1 = *(const f32x4*)(ln_b + c + 4);
#pragma unroll 4
            for (int it = 0; it < nrows / 8; ++it) {
                const int j = it * 8 + (lane >> 3), row = row_base + j;
                const v4u raw = *(const v4u*)(UV + (size_t)row * NSGU + D + c);
                const float mean = (float)(long long)lnsum[row] * (FIX_INV / 4096.0f), ex2 = (float)lnssq[row] * (FIX_INV / 4096.0f);
                const float rstd = rsqrtf(fmaxf(ex2 - mean * mean, 0.f) + 1e-5f);
                f32x4 x0 = {bflo(raw.x), bfhi(raw.x), bflo(raw.y), bfhi(raw.y)}, x1 = {bflo(raw.z), bfhi(raw.z), bflo(raw.w), bfhi(raw.w)};
                x0 = (x0 - mean) * rstd * g0 + b0; x1 = (x1 - mean) * rstd * g1 + b1;
                if (samp) { float* op = out_sguv + (size_t)(row - MP) * D + c; *(f32x4*)op = x0; *(f32x4*)(op + 4) = x1; }
                LAS unsigned short* wp = (LAS unsigned short*)(img + (8 * cp) * 272 + j * 2);
#pragma unroll
                for (int i = 0; i < 4; ++i) { wp[i * 136] = (unsigned short)f2bf(x0[i]); wp[(4 + i) * 136] = (unsigned short)f2bf(x1[i]); }
            }
        }
        LDS_WAIT(); asm volatile("" ::: "memory");
        const int nmt = nrows >> 4, kmax = nrows >> 5;
        bf16x8 bfr[4][4];
#pragma unroll
        for (int nt = 0; nt < 4; ++nt)
#pragma unroll
            for (int ks = 0; ks < 4; ++ks) bfr[nt][ks] = (ks < kmax) ? *(const LAS bf16x8*)(img + (16 * nt + fr) * 272 + (32 * ks + 8 * fq) * 2) : (bf16x8){0, 0, 0, 0, 0, 0, 0, 0};
        const bf16* Wg = WSB + g * 16384;
#pragma unroll 2
        for (int mt = 0; mt < nmt; ++mt) {
            bf16x8 af[4];
#pragma unroll
            for (int ks = 0; ks < 4; ++ks) af[ks] = (ks < kmax) ? *(const bf16x8*)(Wg + (16 * mt + fr) * 128 + 32 * ks + 8 * fq) : (bf16x8){0, 0, 0, 0, 0, 0, 0, 0};
            f32x4 acc[4];
#pragma unroll
            for (int nt = 0; nt < 4; ++nt) acc[nt] = (f32x4){0.f, 0.f, 0.f, 0.f};
#pragma unroll
            for (int ks = 0; ks < 4; ++ks)
                if (ks < kmax) {
#pragma unroll
                    for (int nt = 0; nt < 4; ++nt) acc[nt] = __builtin_amdgcn_mfma_f32_16x16x32_bf16(bfr[nt][ks], af[ks], acc[nt], 0, 0, 0);
                }
            const int i = 16 * mt + fr; const float bias = b_s[g * 128 + i]; const size_t ro = (size_t)(row_base + i);
#pragma unroll
            for (int nt = 0; nt < 4; ++nt) {
                const int c = cw + 16 * nt + 4 * fq; const v2u uu = *(const v2u*)(UV + ro * NSGU + c);
                f32x4 z = {bflo(uu.x), bfhi(uu.x), bflo(uu.y), bfhi(uu.y)};
                { const pg8::f32x2 ga = pg8::gelu_pk((pg8::f32x2){z[0], z[1]}), gb = pg8::gelu_pk((pg8::f32x2){z[2], z[3]}); z = (f32x4){ga.x, ga.y, gb.x, gb.y}; }
                z = z * (acc[nt] + bias);
                v2u o; o.x = pk2(z[0], z[1]); o.y = pk2(z[2], z[3]); *(v2u*)(Z + ro * D + c) = o;
            }
        }
        LDS_WAIT(); asm volatile("" ::: "memory");
    }
}

__device__ __forceinline__ void attn_phase(LAS unsigned char* lds, const bf16* Q, const bf16* KB, const bf16* VB, const float* sinks, bf16* O, int tid, int wave, int lane) {
    const int fr = lane & 15, fq = lane >> 4;
    LAS unsigned char* Ks = lds; LAS unsigned char* Vt = lds + 27648;
    constexpr float LOG2E = 1.4426950408889634f;
    for (int uidx = blockIdx.x; uidx < 1088; uidx += gridDim.x) {
        int kvh, qbase, kbase, klo, khi, nmt;
        if (uidx < 1024) { kvh = uidx & 7; const int bc = uidx >> 3, c = bc & 63; qbase = bc * 64; kbase = qbase - 128; klo = c >= 2 ? 0 : (2 - c) * 64; khi = 192; nmt = 4; }
        else { const int s = uidx - 1024; kvh = s & 7; const int b = s >> 3; qbase = MP + 32 * b; kbase = MP + 160 * b; klo = 0; khi = 160; nmt = 2; }
        __syncthreads();
#pragma unroll
        for (int it = 0; it < 3; ++it) {
            const int p = tid + 512 * it, key = p >> 3, ch = p & 7;
            v4u kk = {0u, 0u, 0u, 0u}, vv = {0u, 0u, 0u, 0u};
            if (key >= klo && key < khi) { const size_t off = (size_t)(kbase + key) * 512 + kvh * 64 + ch * 8; kk = *(const v4u*)(KB + off); vv = *(const v4u*)(VB + off); }
            *(LAS v4u*)(Ks + key * 144 + ch * 16) = kk;
            LAS unsigned short* vp = (LAS unsigned short*)(Vt + (ch * 8) * 392 + key * 2);
            vp[0 * 196] = (unsigned short)(vv.x & 0xffffu); vp[1 * 196] = (unsigned short)(vv.x >> 16); vp[2 * 196] = (unsigned short)(vv.y & 0xffffu); vp[3 * 196] = (unsigned short)(vv.y >> 16);
            vp[4 * 196] = (unsigned short)(vv.z & 0xffffu); vp[5 * 196] = (unsigned short)(vv.z >> 16); vp[6 * 196] = (unsigned short)(vv.w & 0xffffu); vp[7 * 196] = (unsigned short)(vv.w >> 16);
        }
        __syncthreads();
        const int head = kvh * 8 + wave; const float sink = sinks[head];
        for (int mt = 0; mt < nmt; ++mt) {
            const int qrow = qbase + 16 * mt + fr;
            const bf16* qp = Q + (size_t)qrow * D + head * 64 + 8 * fq;
            const bf16x8 q0 = *(const bf16x8*)qp, q1 = *(const bf16x8*)(qp + 32);
            f32x4 s[12]; float mx = sink;
#pragma unroll
            for (int nt = 0; nt < 12; ++nt) {
                const LAS unsigned char* kp = Ks + (16 * nt + fr) * 144 + fq * 16;
                const bf16x8 k0 = *(const LAS bf16x8*)kp, k1 = *(const LAS bf16x8*)(kp + 64);
                f32x4 a = {0.f, 0.f, 0.f, 0.f};
                a = __builtin_amdgcn_mfma_f32_16x16x32_bf16(k0, q0, a, 0, 0, 0);
                a = __builtin_amdgcn_mfma_f32_16x16x32_bf16(k1, q1, a, 0, 0, 0);
                if (16 * nt < klo || 16 * nt >= khi) a = (f32x4){-1e30f, -1e30f, -1e30f, -1e30f};
                s[nt] = a; mx = fmaxf(mx, fmaxf(fmaxf(a[0], a[1]), fmaxf(a[2], a[3])));
            }
            mx = fmaxf(mx, __shfl_xor(mx, 16)); mx = fmaxf(mx, __shfl_xor(mx, 32));
            float l = 0.f;
#pragma unroll
            for (int nt = 0; nt < 12; ++nt) {
#pragma unroll
                for (int i = 0; i < 4; ++i) { const float e = __builtin_amdgcn_exp2f((s[nt][i] - mx) * LOG2E); s[nt][i] = e; l += e; }
            }
            l += __shfl_xor(l, 16); l += __shfl_xor(l, 32); l += __builtin_amdgcn_exp2f((sink - mx) * LOG2E);
            f32x4 o[4];
#pragma unroll
            for (int dt = 0; dt < 4; ++dt) o[dt] = (f32x4){0.f, 0.f, 0.f, 0.f};
#pragma unroll
            for (int s6 = 0; s6 < 6; ++s6) {
                const pg8::u32x4 pw = pg8::pack8(s[2 * s6], s[2 * s6 + 1]); const bf16x8 pf = __builtin_bit_cast(bf16x8, pw);
#pragma unroll
                for (int dt = 0; dt < 4; ++dt) {
                    const LAS unsigned char* vp = Vt + (16 * dt + fr) * 392 + (32 * s6 + 4 * fq) * 2;
                    const v2u lo = *(const LAS v2u*)vp, hi = *(const LAS v2u*)(vp + 32);
                    const v4u vw = {lo.x, lo.y, hi.x, hi.y};
                    o[dt] = __builtin_amdgcn_mfma_f32_16x16x32_bf16(__builtin_bit_cast(bf16x8, vw), pf, o[dt], 0, 0, 0);
                }
            }
            const float inv = 1.0f / l; bf16* op = O + (size_t)qrow * D + head * 64 + 4 * fq;
#pragma unroll
            for (int dt = 0; dt < 4; ++dt) { v2u w; w.x = pg8::cvt_pk_bf16(o[dt][0] * inv, o[dt][1] * inv); w.y = pg8::cvt_pk_bf16(o[dt][2] * inv, o[dt][3] * inv); *(v2u*)(op + 16 * dt) = w; }
        }
    }
}

template <class Epi>
__device__ __forceinline__ void tail_phase(LAS unsigned char* lds, const bf16* A, const bf16* Bt, int K, int nN, int pn_off, unsigned* qhead, const Epi& E, int tid, int wave, int lane, int ablk = 0, int bblk = 1) {
    constexpr int PITCH = 528, OPB = 64 * PITCH, BUFB = 2 * OPB;
    const int fr = lane & 15, fq = lane >> 4;
    const int nc = K >> 8;
    LAS float* part = (LAS float*)(lds + wave * 17408);
    const int row_l = tid >> 3, cg = tid & 7;
    const int colA = Epi::TAIL_SPLIT ? 4 * cg : 8 * cg, colB = Epi::TAIL_SPLIT ? 32 + 4 * cg : 8 * cg + 4;
    const int lr = tid >> 5, lc = tid & 31;
    volatile LAS unsigned* tick = (volatile LAS unsigned*)(lds + MISC_OFF + 64);
    const int cnt = nN * 2;
    int xq = (int)(xb_xcc_id() & 7u), tries = 0;
    unsigned nextj = 0u;
    if (tid == 0) nextj = __hip_atomic_fetch_add(qhead + 16 * xq, 1u, __ATOMIC_RELAXED, __HIP_MEMORY_SCOPE_AGENT);
    for (;;) {
        if (tid == 0) tick[0] = nextj;
        __syncthreads();
        const int j = (int)tick[0];
        __syncthreads();
        if (j >= cnt) { if (++tries == 8) break; xq = (xq + 1) & 7; if (tid == 0) nextj = __hip_atomic_fetch_add(qhead + 16 * xq, 1u, __ATOMIC_RELAXED, __HIP_MEMORY_SCOPE_AGENT); continue; }
        tries = 0;
        if (tid == 0) nextj = __hip_atomic_fetch_add(qhead + 16 * xq, 1u, __ATOMIC_RELAXED, __HIP_MEMORY_SCOPE_AGENT);
        const int p = ((8 * (j >> 2) + xq) << 2) + (j & 3) + 16 * pn_off;
        const int rq = p & 3, q = (p >> 2) & 3, pn = p >> 4;
        typedef typename Epi::AccT AccT; AccT acc[4][4];
#pragma unroll
        for (int nb = 0; nb < 4; ++nb)
#pragma unroll
            for (int mb = 0; mb < 4; ++mb) acc[nb][mb] = (AccT){0, 0, 0, 0};
        const size_t a16 = ablk ? 1024 : (size_t)16 * K, achs = ablk ? 65536 : 256, b16 = bblk ? 1024 : (size_t)16 * K, b128 = bblk ? 8192 : (size_t)128 * K, bchs = bblk ? 65536 : 256;
        const bf16* ag = ablk ? (const bf16*)((const char*)A + pg8::blk_byte(MP + 64 * rq + lr, 8 * lc, K)) : A + (size_t)(MP + 64 * rq + lr) * K + 8 * lc;
        const bf16* bg = bblk ? (const bf16*)((const char*)Bt + pg8::blk_byte(256 * pn + 32 * q + (lr & 31), 8 * lc, K)) : Bt + (size_t)(256 * pn + 32 * q + (lr & 31)) * K + 8 * lc;
        v4u a0[4], b0[4], a1[4], b1[4];
#define TL_LOAD(ra, rb, c) do { const int cc_ = (c) < nc ? (c) : nc - 1; _Pragma("unroll") for (int i = 0; i < 4; ++i) { \
            ra[i] = *(const v4u*)(ag + a16 * i + achs * cc_); rb[i] = *(const v4u*)(bg + b16 * (i & 1) + b128 * (i >> 1) + bchs * cc_); } } while (0)
#define TL_WRITE(ra, rb, b) do { LAS unsigned char* d_ = lds + (b) * BUFB + lr * PITCH + lc * 16; _Pragma("unroll") for (int i = 0; i < 4; ++i) { \
            *(LAS v4u*)(d_ + 16 * i * PITCH) = ra[i]; *(LAS v4u*)(d_ + OPB + 16 * i * PITCH) = rb[i]; } } while (0)
#define TL_BAR() do { asm volatile("s_waitcnt lgkmcnt(0)" ::: "memory"); __builtin_amdgcn_s_barrier(); asm volatile("" ::: "memory"); } while (0)
#define TL_STEP(c, la, lb, wa, wb) do { TL_LOAD(la, lb, (c) + 2); TL_BAR(); \
            const LAS unsigned char* fb = lds + ((c) & 1) * BUFB + fr * PITCH + (32 * wave + 8 * fq) * 2; bf16x8 fa[4], fbv[4]; \
            _Pragma("unroll") for (int i = 0; i < 4; ++i) { fa[i] = *(const LAS bf16x8*)(fb + 16 * i * PITCH); fbv[i] = *(const LAS bf16x8*)(fb + OPB + 16 * i * PITCH); } \
            _Pragma("unroll") for (int nb = 0; nb < 4; ++nb) _Pragma("unroll") for (int mb = 0; mb < 4; ++mb) acc[nb][mb] = pg8::mma16(fbv[nb], fa[mb], acc[nb][mb]); \
            TL_WRITE(wa, wb, ((c) + 1) & 1); } while (0)
        TL_LOAD(a0, b0, 0); TL_LOAD(a1, b1, 1); TL_WRITE(a0, b0, 0);
        int c = 0;
        for (; c + 1 < nc; c += 2) { TL_STEP(c, a0, b0, a1, b1); TL_STEP(c + 1, a1, b1, a0, b0); }
        if (c < nc) TL_STEP(c, a0, b0, a1, b1);
#undef TL_STEP
#undef TL_BAR
#undef TL_LOAD
#undef TL_WRITE
        asm volatile("s_waitcnt vmcnt(0)" ::: "memory"); __syncthreads();
#pragma unroll
        for (int nb = 0; nb < 4; ++nb)
#pragma unroll
            for (int mb = 0; mb < 4; ++mb) *(LAS pg8::f32x4*)(part + (16 * mb + fr) * 68 + 16 * nb + 4 * fq) = __builtin_convertvector(acc[nb][mb], pg8::f32x4);
        __syncthreads();
        pg8::f32x4 v0 = {0.f, 0.f, 0.f, 0.f}, v1 = {0.f, 0.f, 0.f, 0.f};
#pragma unroll
        for (int w = 0; w < 8; ++w) { const LAS float* t = (const LAS float*)(lds + w * 17408) + row_l * 68; v0 += *(const LAS pg8::f32x4*)(t + colA); v1 += *(const LAS pg8::f32x4*)(t + colB); }
        E.tail(MP + 64 * rq + row_l, cg, pn, q, v0, v1);
        __syncthreads();
    }
}

#ifndef CONV_SPREAD
#define CONV_SPREAD 0
#endif
#ifndef PROBE_PH
#define PROBE_PH (-1)
#endif
#ifndef PROBE_MUL
#define PROBE_MUL 3
#endif
#ifndef NCONV
#define NCONV 80
#endif
#ifndef NCONV4
#define NCONV4 16
#endif
#ifndef NCONV6
#define NCONV6 24
#endif
#ifndef SAMPLE_MAIN_GU
#define SAMPLE_MAIN_GU 64
#endif
__device__ __forceinline__ void pr_begin(int k, long long& t0) { if (PROBE_PH >= 0 && k == PROBE_PH) { __syncthreads(); t0 = (long long)wall_clock64(); } }
__device__ __forceinline__ void pr_end(int k, long long t0) {
    if (PROBE_PH >= 0 && k == PROBE_PH) { __syncthreads(); const long long t1 = (long long)wall_clock64(), te = t1 + (long long)PROBE_MUL * (t1 - t0);
        while ((long long)wall_clock64() < te) __builtin_amdgcn_s_sleep(16);
        __syncthreads(); }
}
__global__ void __launch_bounds__(NWAVES * 64, 2) yoco_fwd(Args args) {
    extern __shared__ __attribute__((aligned(16))) unsigned char lds_raw[];
    LAS unsigned char* lds = (LAS unsigned char*)lds_raw;
    const int tid = threadIdx.x, lane = tid & 63, wave = __builtin_amdgcn_readfirstlane(tid >> 6);
    const int G = gridDim.x, bx = blockIdx.x, vcu = (G % 8 == 0) ? (bx % 8) * (G / 8) + bx / 8 : bx;
    unsigned char* ws = args.ws;
    for (int u = tid; u < (LDS_BYTES - LDSCTL_OFF) / 4; u += NWAVES * 64) ((LAS unsigned*)(lds + LDSCTL_OFF))[u] = 0u;
    __syncthreads();
    volatile LAS unsigned* MISC = (volatile LAS unsigned*)(lds + MISC_OFF);
    XcdBarrier bar; bar.bar = (unsigned*)ws + CW_BAR; bar.x = 0; bar.st = nullptr;
    if (MK_ONE_LAUNCH) bar = xcd_barrier_post((unsigned*)ws + CW_BAR, MISC + 8);
    const int lo = args.ph_lo, hi = args.ph_hi;
    long long pr_t0 = 0;
#define IN(k) (pr_begin((k), pr_t0), lo <= (k) && (k) < hi)
#define SEAM(k) do { pr_end((k), pr_t0); if (MK_ONE_LAUNCH && IN((k) + 1)) xcd_barrier(bar); } while (0)
    bf16* const W1T = (bf16*)(ws + WS_W1T); bf16* const W2T = (bf16*)(ws + WS_W2T); bf16* const WGU0 = (bf16*)(ws + WS_WGU0); bf16* const WD0 = (bf16*)(ws + WS_WD0);
    bf16* const WQKV = (bf16*)(ws + WS_WQKV); bf16* const WOT = (bf16*)(ws + WS_WOT); bf16* const WGU1 = (bf16*)(ws + WS_WGU1); bf16* const WD1 = (bf16*)(ws + WS_WD1);
    bf16* const XB = (bf16*)(ws + WS_XB); bf16* const ACT = (bf16*)(ws + WS_ACT); bf16* const UV = (bf16*)(ws + WS_ACT);
    bf16* const ZQ = (bf16*)(ws + WS_ZQ); bf16* const OB = (bf16*)(ws + WS_O); bf16* const KB = (bf16*)(ws + WS_KB); bf16* const VB = (bf16*)(ws + WS_VB); bf16* const WSB = (bf16*)(ws + WS_WSB);
    unsigned char* const A8 = ws + WS_H; float* const rowscale = (float*)(ws + RS_OFF); const float* const cmax0 = (const float*)(ws + CM_OFF); const float* const cmax1 = (const float*)(ws + CM_OFF + CM_STRIDE);
    unsigned* const qheads = (unsigned*)ws + CW_Q;
    u64* const ssq_x = (u64*)(ws + ST_OFF); u64* const lnsum = (u64*)(ws + ST_OFF + ST_STRIDE); u64* const lnssq = (u64*)(ws + ST_OFF + 2 * ST_STRIDE);
    u64* const ssq_h1 = (u64*)(ws + ST_OFF + 3 * ST_STRIDE); u64* const ssq_h2 = (u64*)(ws + ST_OFF + 4 * ST_STRIDE); u64* const ssq_h3 = (u64*)(ws + ST_OFF + 5 * ST_STRIDE);

    const bool split = (G == 256) && (NCONV > 0);
    const int nconv = split ? NCONV : 0, ncomp = G - nconv, nconv4 = (split && CONV_SPREAD) ? NCONV4 : 0, nconv6 = (split && CONV_SPREAD) ? NCONV6 : 0;
    const int items_p1 = (split && CONV_SPREAD) ? P0_ITEMS_P1 : P0_ITEMS_ALL;
    if (IN(0)) { absmax_pass(args, ws, vcu * NWAVES + wave, G * NWAVES, lane); if (!split && MK_ONE_LAUNCH) xcd_barrier(bar);
                 p0_prologue(args, ws, lds, vcu * NWAVES + wave, G * NWAVES, 0, split ? P0_ITEMS_A : P0_ITEMS_ALL, 1, wave, lane); SEAM(0); }
    if (IN(1)) {
        if (bx >= ncomp) { p0_prologue(args, ws, lds, (bx - ncomp) * NWAVES + wave, nconv * NWAVES, P0_ITEMS_A, items_p1, 0, wave, lane); __syncthreads(); }
        pg8::Gemm g{XB, W1T, MP, NSGU, D, 0, 1}; pg8::SplitOrder S; S.init(MP, NSGU, G, bx); S.nblk = ncomp; S.nhalf = 16; S.nextra = 0;
        pg8::EpiSguIn E{UV, ssq_x, lnsum, lnssq};
        pg8::gemm_phase<pg8::EpiSguIn, pg8::SplitOrder, PG8_ALIGN, PG8_SP2>(lds, g, S, E);
        tail_phase(lds, XB, W1T, D, 32, 0, qheads + 0 * 128, E, tid, wave, lane);
        SEAM(1);
    }
    if (IN(2)) { sgu_phase(lds, UV, WSB, lnsum, lnssq, args.in[6], args.in[7], args.in[9], ZQ, args.out + pg8::OUT_SGUV, wave, lane); SEAM(2); }
    if (IN(3)) {
        pg8::Gemm g{ZQ, W2T, MP, D, D, 0, 1}; pg8::StaticOrder S; S.init(MP, D, G, bx);
        pg8::EpiRes<false, true, false> E{nullptr, nullptr, nullptr, XB, ssq_h1};
        pg8::gemm_phase<pg8::EpiRes<false, true, false>, pg8::StaticOrder, PG8_ALIGN, PG8_SP2>(lds, g, S, E);
        tail_phase(lds, ZQ, W2T, D, 16, 0, qheads + 1 * 128, E, tid, wave, lane);
        SEAM(3);
    }
    if (IN(4)) { quant_rows(XB, ssq_h1, A8, rowscale, vcu * NWAVES + wave, G * NWAVES, lane); SEAM(4); }
    if (IN(5)) {
        if (bx >= G - nconv4) { p0_prologue(args, ws, lds, (bx - (G - nconv4)) * NWAVES + wave, nconv4 * NWAVES, P0_ITEMS_P1, P0_ITEMS_P4, 0, wave, lane); __syncthreads(); }
        pg8::Gemm g{(const bf16*)A8, WGU0, M, NGU, D / 2, 0, 1}; pg8::SplitOrder S; S.init(MP, NGU, G, bx); S.nblk = G - nconv4; S.nhalf = 0; S.nextra = SAMPLE_MAIN_GU;
        pg8::EpiSwigluI8 E{ACT, rowscale, cmax0};
        pg8::gemm_phase<pg8::EpiSwigluI8, pg8::SplitOrder, PG8_ALIGN, PG8_SP2>(lds, g, S, E);
        tail_phase(lds, (const bf16*)A8, WGU0, D / 2, 86 - SAMPLE_MAIN_GU, SAMPLE_MAIN_GU, qheads + 2 * 128, E, tid, wave, lane);
        SEAM(5);
    }
    if (IN(6)) {
        pg8::Gemm g{ACT, WD0, MP, D, DFF, 1, 1}; pg8::StaticOrder S; S.init(MP, D, G, bx);
        pg8::EpiRes<false, true, false> E{nullptr, nullptr, nullptr, XB, ssq_h2};
        pg8::gemm_phase<pg8::EpiRes<false, true, false>, pg8::StaticOrder, PG8_ALIGN, PG8_SP2>(lds, g, S, E);
        tail_phase(lds, ACT, WD0, DFF, 16, 0, qheads + 3 * 128, E, tid, wave, lane, 1, 1);
        SEAM(6);
    }
    if (IN(7)) { quant_rows(XB, ssq_h2, A8, rowscale, vcu * NWAVES + wave, G * NWAVES, lane); SEAM(7); }
    if (IN(8)) {
        { pg8::Gemm g{XB, WQKV, MP, 1024, D, 0, 1}; pg8::SplitOrder S; S.init(MP, 1024, G, bx); S.nblk = (G == 256) ? 128 : G; S.nhalf = 0; S.nextra = 0;
          pg8::EpiQKV E{KB, VB, ZQ, args.out, ssq_h2, args.in[13], args.in[16], nullptr, nullptr};
          pg8::gemm_phase<pg8::EpiQKV, pg8::SplitOrder, PG8_ALIGN, PG8_SP2>(lds, g, S, E); }
        { pg8::Gemm g{(const bf16*)A8, (const bf16*)(ws + WS_WQKV + WQ8_SHIFT), MP, 4096, D / 2, 0, 1}; pg8::QOrder S; S.init(MP, 4096, G, bx);
          pg8::EpiQKVT<true> E{KB, VB, ZQ, args.out, ssq_h2, args.in[13], args.in[16], rowscale, (const float*)(ws + CMQ_OFF)};
          pg8::gemm_phase<pg8::EpiQKVT<true>, pg8::QOrder, PG8_ALIGN, PG8_SP2>(lds, g, S, E);
          tail_phase(lds, (const bf16*)A8, (const bf16*)(ws + WS_WQKV + WQ8_SHIFT), D / 2, 16, 4, qheads + 8 * 128, E, tid, wave, lane); }
        { pg8::EpiQKV E{KB, VB, ZQ, args.out, ssq_h2, args.in[13], args.in[16], nullptr, nullptr};
          tail_phase(lds, XB, WQKV, D, 4, 0, qheads + 4 * 128, E, tid, wave, lane); }
        SEAM(8);
    }
    if (IN(9)) { attn_phase(lds, ZQ, KB, VB, args.in[17], OB, tid, wave, lane); SEAM(9); }
    if (IN(10)) { quant_rows(OB, nullptr, A8, rowscale, vcu * NWAVES + wave, G * NWAVES, lane); SEAM(10); }
    if (IN(11)) {
        pg8::Gemm g{(const bf16*)A8, WOT, MP, D, D / 2, 0, 1}; pg8::StaticOrder S; S.init(MP, D, G, bx);
        pg8::EpiRes<false, true, false, true> E{nullptr, nullptr, nullptr, XB, ssq_h3, rowscale, (const float*)(ws + CMO_OFF)};
        pg8::gemm_phase<pg8::EpiRes<false, true, false, true>, pg8::StaticOrder, PG8_ALIGN, PG8_SP2>(lds, g, S, E);
        tail_phase(lds, (const bf16*)A8, WOT, D / 2, 16, 0, qheads + 5 * 128, E, tid, wave, lane);
        SEAM(11);
    }
    if (IN(12)) { quant_rows(XB, ssq_h3, A8, rowscale, vcu * NWAVES + wave, G * NWAVES, lane); SEAM(12); }
    if (IN(13)) {
        if (bx >= G - nconv4) { p0_prologue(args, ws, lds, (bx - (G - nconv4)) * NWAVES + wave, nconv4 * NWAVES, P0_ITEMS_P6, P0_ITEMS_ALL, 0, wave, lane); __syncthreads(); }
        pg8::Gemm g{(const bf16*)A8, WGU1, M, NGU, D / 2, 0, 1}; pg8::SplitOrder S; S.init(MP, NGU, G, bx); S.nblk = G - nconv4; S.nhalf = 0; S.nextra = SAMPLE_MAIN_GU;
        pg8::EpiSwigluI8 E{ACT, rowscale, cmax1};
        pg8::gemm_phase<pg8::EpiSwigluI8, pg8::SplitOrder, PG8_ALIGN, PG8_SP2>(lds, g, S, E);
        tail_phase(lds, (const bf16*)A8, WGU1, D / 2, 86 - SAMPLE_MAIN_GU, SAMPLE_MAIN_GU, qheads + 6 * 128, E, tid, wave, lane);
        SEAM(13);
    }
    if (IN(14)) {
        pg8::Gemm g{ACT, WD1, MP, D, DFF, 1, 1}; pg8::StaticOrder S; S.init(MP, D, G, bx);
        pg8::EpiRes<false, false, true> E{nullptr, nullptr, args.out, XB, nullptr};
        pg8::gemm_phase<pg8::EpiRes<false, false, true>, pg8::StaticOrder, PG8_ALIGN, PG8_SP2>(lds, g, S, E);
        tail_phase(lds, ACT, WD1, DFF, 16, 0, qheads + 7 * 128, E, tid, wave, lane, 1, 1);
        pr_end(14, pr_t0);
    }
#undef IN
#undef SEAM
}

extern "C" void kernel_launch(void* const* d_in, const int* in_sizes, int n_in, void* d_out, int out_size, void* d_ws, size_t ws_size, hipStream_t stream) {
    static int grid = 0;
    if (grid == 0) {
        if (n_in != 23 || in_sizes[0] != MP * D || out_size != 36175872 || ws_size < WS_END) {
            fprintf(stderr, "kernel_launch: unexpected shapes (n_in %d, in0 %d, out %d, ws %zu); nothing launched\n", n_in, n_in > 0 ? in_sizes[0] : -1, out_size, ws_size); grid = -1; return; }
        int dev = 0, cus = 0, per_cu = 0;
        if (hipGetDevice(&dev) != hipSuccess || hipDeviceGetAttribute(&cus, hipDeviceAttributeMultiprocessorCount, dev) != hipSuccess) { fprintf(stderr, "kernel_launch: device query failed\n"); grid = -1; return; }
        if (hipFuncSetAttribute((const void*)yoco_fwd, hipFuncAttributeMaxDynamicSharedMemorySize, LDS_BYTES) != hipSuccess) { fprintf(stderr, "kernel_launch: hipFuncSetAttribute failed\n"); grid = -1; return; }
        if (hipOccupancyMaxActiveBlocksPerMultiprocessor(&per_cu, (const void*)yoco_fwd, NWAVES * 64, LDS_BYTES) != hipSuccess || per_cu < 1)
            fprintf(stderr, "kernel_launch: note: occupancy query reports %d workgroups per CU\n", per_cu);
        (void)hipGetLastError();
        grid = cus;
    }
    if (grid < 0) return;
    if (hipMemsetAsync((char*)d_ws + WS_CTL, 0, CTL_ZERO_BYTES, stream) != hipSuccess) { fprintf(stderr, "kernel_launch: memset failed\n"); return; }
    Args a{};
    for (int i = 0; i < 23; ++i) a.in[i] = (const float*)d_in[i];
    a.out = (float*)d_out; a.ws = (unsigned char*)d_ws;
#if MK_ONE_LAUNCH
    a.ph_lo = 0; a.ph_hi = NPHASES;
    hipLaunchKernelGGL(yoco_fwd, dim3(grid), dim3(NWAVES * 64), LDS_BYTES, stream, a);
#else
    for (int p = 0; p < NPHASES; ++p) { a.ph_lo = p; a.ph_hi = p + 1; hipLaunchKernelGGL(yoco_fwd, dim3(grid), dim3(NWAVES * 64), LDS_BYTES, stream, a); }
#endif
    const hipError_t le = hipPeekAtLastError();
    if (le != hipSuccess) fprintf(stderr, "kernel_launch: launch failed: %s\n", hipGetErrorName(le));
}
```

```cpp
#include <hip/hip_runtime.h>
#include <cstdio>
#include <cstdint>
#define MK_ONE_LAUNCH 1
namespace pg8 {
#define PG8_LAS __attribute__((address_space(3)))
typedef unsigned short bf16_t;
typedef short bf16x8 __attribute__((ext_vector_type(8)));
typedef float f32x4 __attribute__((ext_vector_type(4)));
typedef unsigned u32x4 __attribute__((ext_vector_type(4)));
constexpr int BM = 256, BK = 64, HALF = 128, HTB = HALF * BK * 2  , STAGE_BYTES = 8 * HTB, NXCD = 8, WGM = 8;

__host__ __device__ __forceinline__ int lds_byte(int r, int c) { const int st = (r >> 4) * 2 + (c >> 5), rr = r & 15, cc = c & 31, ob = rr * 64 + cc * 2; return st * 1024 + (ob ^ (((ob >> 9) & 1) << 5)); }
__host__ __device__ __forceinline__ void stage_rc(int b, int& R, int& C) { const int st = b / 1024, sb = b % 1024, swz = sb ^ (((sb >> 9) & 1) << 5); R = (st >> 1) * 16 + swz / 64; C = (st & 1) * 32 + (swz % 64) / 2; }
__host__ __device__ __forceinline__ int perm32(int rho) { const int n = rho >> 4, i = rho & 15; return 8 * (i >> 2) + 4 * n + (i & 3); }

struct Unit { int pm, pn; };
struct Gemm { const bf16_t* A; const bf16_t* Bt; int M, N, K; int ablk, bblk; };
__host__ __device__ __forceinline__ size_t blk_byte(int r, int k, int K) { return (size_t)(r >> 8) * K * 512 + (size_t)(k >> 6) * 32768 + ((r >> 7) & 1) * 16384 + lds_byte(r & 127, k & 63); }

struct StaticOrder {
    int nM, nN, nwg, G, c;
    __host__ __device__ void init(int M, int N, int G_, int c_) { nM = M / BM; nN = N / BM; nwg = nM * nN; G = G_; c = c_; }
    __host__ __device__ bool next(int i, Unit& u) const {
        const long L = (long)i * G + c; if (L >= nwg) return false;
        int wgid = (int)L; { const int q = nwg / NXCD, r = nwg % NXCD, xcd = wgid % NXCD, off = wgid / NXCD; wgid = (xcd < r ? xcd * (q + 1) : r * (q + 1) + (xcd - r) * q) + off; }
        const int nig = WGM * nN, gid = wgid / nig, fm = gid * WGM, gsz = (nM - fm) < WGM ? (nM - fm) : WGM;
        u.pm = fm + ((wgid % nig) % gsz); u.pn = (wgid % nig) / gsz; return true;
    }
    __device__ __forceinline__ void a_ready(const Unit&) const {}
    __device__ __forceinline__ void done(const Unit&) const {}
};

__device__ __forceinline__ unsigned cvt_pk_bf16(float lo, float hi) { unsigned r; asm volatile("v_cvt_pk_bf16_f32 %0, %1, %2" : "=v"(r) : "v"(lo), "v"(hi)); return r; }
typedef float f32x2 __attribute__((ext_vector_type(2)));
__device__ __forceinline__ f32x2 gelu_pk(f32x2 v) {
    const f32x2 av = __builtin_elementwise_abs(v), d = av * 0.2316418882f + 1.0f;
    f32x2 t; t.x = __builtin_amdgcn_rcpf(d.x); t.y = __builtin_amdgcn_rcpf(d.y);
    f32x2 q = t * 0.5307027145f + (-0.7265760135f); q = q * t + 0.7107068705f; q = q * t + (-0.142248368f); q = q * t + 0.127414796f; q = q * t;
    const f32x2 s = (v * v) * (-0.72134752044f);
    f32x2 e; e.x = __builtin_amdgcn_exp2f(s.x); e.y = __builtin_amdgcn_exp2f(s.y);
    const f32x2 m = v * (q * e), r = v - m;
    f32x2 o; o.x = v.x < 0.f ? m.x : r.x; o.y = v.y < 0.f ? m.y : r.y; return o;
}


struct SplitOrder : StaticOrder {
    int nblk; int nhalf; int nextra;
    __device__ bool next(int i, Unit& u) const {
        if (c >= nblk) return false;
        const long L = (long)i * nblk + c; if (L >= nwg + nextra) return false;
        if (L >= nwg) { u.pm = 32; u.pn = (int)(L - nwg); return true; }
        int wgid = (int)L; { const int q = nwg / NXCD, r = nwg % NXCD, xcd = wgid % NXCD, off = wgid / NXCD; wgid = (xcd < r ? xcd * (q + 1) : r * (q + 1) + (xcd - r) * q) + off; }
        const int nig = WGM * nN, gid = wgid / nig, fm = gid * WGM, gsz = (nM - fm) < WGM ? (nM - fm) : WGM;
        u.pm = fm + ((wgid % nig) % gsz); u.pn = (wgid % nig) / gsz; if (nhalf) u.pn = (u.pn & 1) * nhalf + (u.pn >> 1); return true;
    }
};
typedef unsigned long long u64;
constexpr float FIX_SCALE = 16777216.0f, FIX_INV = 1.0f / 16777216.0f;
__device__ __forceinline__ u64 f2fixu(float v) { return (u64)(v * FIX_SCALE); }
__device__ __forceinline__ u64 f2fixs(float v) { return (u64)(long long)(v * FIX_SCALE); }
__device__ __forceinline__ void fix_add(u64* p, u64 v) { (void)__hip_atomic_fetch_add(p, v, __ATOMIC_RELAXED, __HIP_MEMORY_SCOPE_AGENT); }
__device__ __forceinline__ float rstd_of(const u64* ssq, int row) { return rsqrtf((float)ssq[row] * (FIX_INV * (1.0f / 4096.0f)) + 1e-6f); }
__device__ __forceinline__ float sum4(const f32x4& v) { return (v[0] + v[1]) + (v[2] + v[3]); }
__device__ __forceinline__ float ssq4(const f32x4& v) { return (v[0] * v[0] + v[1] * v[1]) + (v[2] * v[2] + v[3] * v[3]); }
__device__ __forceinline__ u32x4 pack8(const f32x4& a, const f32x4& b) { u32x4 w; w.x = cvt_pk_bf16(a[0], a[1]); w.y = cvt_pk_bf16(a[2], a[3]); w.z = cvt_pk_bf16(b[0], b[1]); w.w = cvt_pk_bf16(b[2], b[3]); return w; }

template <bool I8> struct AccSel { typedef f32x4 T; };
template <> struct AccSel<true> { typedef int T __attribute__((ext_vector_type(4))); };
struct EpiSguIn {
    typedef f32x4 AccT;
    static constexpr bool PERM = true, AFTER_DRAIN = false;
    bf16_t* UV; const u64* ssq; u64* lnsum; u64* lnssq;
    __device__ __forceinline__ void operator()(const f32x4 (&acc)[2][2][4][2], const Unit& u, int wr, int wc, int fr, int fq) const {
        const int row0 = u.pm * BM + wr * 64 + fr, col0 = u.pn * BM + wc * 32 + 8 * fq;
        const bool isv = u.pn >= 16;
        float rs[2][4];
#pragma unroll
        for (int ai = 0; ai < 2; ++ai)
#pragma unroll
            for (int m = 0; m < 4; ++m) rs[ai][m] = rstd_of(ssq, row0 + ai * HALF + m * 16);
#pragma unroll
        for (int ai = 0; ai < 2; ++ai)
#pragma unroll
            for (int m = 0; m < 4; ++m) {
                const int row = row0 + ai * HALF + m * 16;
                float s1 = 0.f, s2 = 0.f;
                bf16_t* rowp = UV + (size_t)row * 8192 + col0;
#pragma unroll
                for (int bj = 0; bj < 2; ++bj) {
                    f32x4 v0 = acc[ai][bj][m][0] * rs[ai][m], v1 = acc[ai][bj][m][1] * rs[ai][m];
                    if (isv) {
                        const f32x2 a = gelu_pk((f32x2){v0[0], v0[1]}), b = gelu_pk((f32x2){v0[2], v0[3]}), c = gelu_pk((f32x2){v1[0], v1[1]}), d = gelu_pk((f32x2){v1[2], v1[3]});
                        v0 = (f32x4){a.x, a.y, b.x, b.y}; v1 = (f32x4){c.x, c.y, d.x, d.y};
                        s1 += sum4(v0) + sum4(v1); s2 += ssq4(v0) + ssq4(v1); }
                    *(u32x4*)(rowp + bj * HALF) = pack8(v0, v1);
                }
                if (isv) {
                    s1 += __shfl_xor(s1, 16); s1 += __shfl_xor(s1, 32); s2 += __shfl_xor(s2, 16); s2 += __shfl_xor(s2, 32);
                    if (fq == 0) { fix_add(lnsum + row, f2fixs(s1)); fix_add(lnssq + row, f2fixu(s2)); }
                }
            }
    }
    static constexpr bool TAIL_SPLIT = false;
    __device__ __forceinline__ void tail(int row, int cg, int pn, int q, f32x4 v0, f32x4 v1) const {
        const int col = pn * BM + (cg >> 2) * HALF + q * 32 + 8 * (cg & 3);
        const float rs = rstd_of(ssq, row);
        v0 = v0 * rs; v1 = v1 * rs;
        if (pn >= 16) { const f32x2 a = gelu_pk((f32x2){v0[0], v0[1]}), b = gelu_pk((f32x2){v0[2], v0[3]}), c = gelu_pk((f32x2){v1[0], v1[1]}), d = gelu_pk((f32x2){v1[2], v1[3]});
            v0 = (f32x4){a.x, a.y, b.x, b.y}; v1 = (f32x4){c.x, c.y, d.x, d.y}; }
        *(u32x4*)(UV + (size_t)row * 8192 + col) = pack8(v0, v1);
        if (pn >= 16) {
            float s1 = sum4(v0) + sum4(v1), s2 = ssq4(v0) + ssq4(v1);
            s1 += __shfl_xor(s1, 1); s1 += __shfl_xor(s1, 2); s1 += __shfl_xor(s1, 4); s2 += __shfl_xor(s2, 1); s2 += __shfl_xor(s2, 2); s2 += __shfl_xor(s2, 4);
            if (cg == 0) { fix_add(lnsum + row, f2fixs(s1)); fix_add(lnssq + row, f2fixu(s2)); }
        }
    }
};
template <bool RES_F32, bool XBOUT, bool OUT_F32, bool I8 = false> struct EpiRes {
    typedef typename AccSel<I8>::T AccT;
    static constexpr bool PERM = true, AFTER_DRAIN = false;
    const float* res; const float* res_hi; float* out; bf16_t* XB; u64* ssq_out; const float* rowscale; const float* cmo;
    __device__ __forceinline__ static f32x4 lo4(const u32x4& w) { return (f32x4){__builtin_bit_cast(float, w.x << 16), __builtin_bit_cast(float, w.x & 0xffff0000u), __builtin_bit_cast(float, w.y << 16), __builtin_bit_cast(float, w.y & 0xffff0000u)}; }
    __device__ __forceinline__ static f32x4 hi4(const u32x4& w) { return (f32x4){__builtin_bit_cast(float, w.z << 16), __builtin_bit_cast(float, w.z & 0xffff0000u), __builtin_bit_cast(float, w.w << 16), __builtin_bit_cast(float, w.w & 0xffff0000u)}; }
    __device__ __forceinline__ void operator()(const AccT (&acc)[2][2][4][2], const Unit& u, int wr, int wc, int fr, int fq) const {
        const int row0 = u.pm * BM + wr * 64 + fr, col0 = u.pn * BM + wc * 32 + 8 * fq;
        const float* rbase = u.pm < 32 ? res : res_hi;
#pragma unroll
        for (int ai = 0; ai < 2; ++ai) {
            f32x4 cw[2][2];
#pragma unroll
            for (int bj = 0; bj < 2; ++bj)
#pragma unroll
                for (int n = 0; n < 2; ++n) cw[bj][n] = I8 ? *(const f32x4*)(cmo + col0 + bj * HALF + 4 * n) * (1.0f / 127.0f) : (f32x4){1.f, 1.f, 1.f, 1.f};
            f32x4 r[RES_F32 ? 4 : 1][2][2]; u32x4 rw[4][2]; float rsv[4];
#pragma unroll
            for (int m = 0; m < 4; ++m) rsv[m] = I8 ? rowscale[row0 + ai * HALF + m * 16] : 1.0f;
#pragma unroll
            for (int m = 0; m < 4; ++m) { const size_t off = (size_t)(row0 + ai * HALF + m * 16) * 4096 + col0;
#pragma unroll
                for (int bj = 0; bj < 2; ++bj) {
                    if (RES_F32) { r[RES_F32 ? m : 0][bj][0] = *(const f32x4*)(rbase + off + bj * HALF); r[RES_F32 ? m : 0][bj][1] = *(const f32x4*)(rbase + off + bj * HALF + 4); }
                    else { rw[m][bj] = *(const u32x4*)(XB + off + bj * HALF); } } }
#pragma unroll
            for (int m = 0; m < 4; ++m) { const int row = row0 + ai * HALF + m * 16; const size_t off = (size_t)row * 4096 + col0; float ss = 0.f;
#pragma unroll
                for (int bj = 0; bj < 2; ++bj) { f32x4 o0, o1; const f32x4 ra0 = RES_F32 ? r[RES_F32 ? m : 0][bj][0] : lo4(rw[m][bj]), ra1 = RES_F32 ? r[RES_F32 ? m : 0][bj][1] : hi4(rw[m][bj]);
                    if constexpr (I8) { o0 = ra0 + __builtin_convertvector(acc[ai][bj][m][0], f32x4) * cw[bj][0] * rsv[m]; o1 = ra1 + __builtin_convertvector(acc[ai][bj][m][1], f32x4) * cw[bj][1] * rsv[m]; }
                    else { o0 = ra0 + acc[ai][bj][m][0]; o1 = ra1 + acc[ai][bj][m][1]; }
                    if (OUT_F32) { *(f32x4*)(out + off + bj * HALF) = o0; *(f32x4*)(out + off + bj * HALF + 4) = o1; }
                    if (XBOUT) { *(u32x4*)(XB + off + bj * HALF) = pack8(o0, o1); ss += ssq4(o0) + ssq4(o1); } }
                if (XBOUT) { ss += __shfl_xor(ss, 16); ss += __shfl_xor(ss, 32); if (fq == 0) fix_add(ssq_out + row, f2fixu(ss)); } }
            asm volatile("" ::: "memory");
        }
    }
    static constexpr bool TAIL_SPLIT = false;
    __device__ __forceinline__ void tail(int row, int cg, int pn, int q, f32x4 v0, f32x4 v1) const {
        const size_t off = (size_t)row * 4096 + pn * BM + (cg >> 2) * HALF + q * 32 + 8 * (cg & 3);
        if constexpr (I8) { const float rs = rowscale[row] * (1.0f / 127.0f); const float* cp = cmo + pn * BM + (cg >> 2) * HALF + q * 32 + 8 * (cg & 3); v0 = v0 * *(const f32x4*)cp * rs; v1 = v1 * *(const f32x4*)(cp + 4) * rs; }
        f32x4 r0, r1;
        if (RES_F32) { r0 = *(const f32x4*)(res_hi + off); r1 = *(const f32x4*)(res_hi + off + 4); }
        else { const u32x4 w = *(const u32x4*)(XB + off); r0 = lo4(w); r1 = hi4(w); }
        const f32x4 o0 = r0 + v0, o1 = r1 + v1;
        if (OUT_F32) { *(f32x4*)(out + off) = o0; *(f32x4*)(out + off + 4) = o1; }
        if (XBOUT) {
            *(u32x4*)(XB + off) = pack8(o0, o1);
            float ss = ssq4(o0) + ssq4(o1); ss += __shfl_xor(ss, 1); ss += __shfl_xor(ss, 2); ss += __shfl_xor(ss, 4);
            if (cg == 0) fix_add(ssq_out + row, f2fixu(ss));
        }
    }
};
struct EpiSwiglu {
    typedef f32x4 AccT;
    static constexpr bool PERM = true, AFTER_DRAIN = false;
    bf16_t* ACT; const u64* ssq;
    __device__ __forceinline__ void operator()(const f32x4 (&acc)[2][2][4][2], const Unit& u, int wr, int wc, int fr, int fq) const {
        const int row0 = u.pm * BM + wr * 64 + fr, col0 = u.pn * HALF + wc * 32 + 8 * fq;
        float rs[2][4];
#pragma unroll
        for (int ai = 0; ai < 2; ++ai)
#pragma unroll
            for (int m = 0; m < 4; ++m) rs[ai][m] = rstd_of(ssq, row0 + ai * HALF + m * 16);
#pragma unroll
        for (int ai = 0; ai < 2; ++ai)
#pragma unroll
            for (int m = 0; m < 4; ++m) {
                const int row = row0 + ai * HALF + m * 16; f32x4 o[2];
#pragma unroll
                for (int n = 0; n < 2; ++n) { const f32x4 g = acc[ai][0][m][n] * rs[ai][m], up = acc[ai][1][m][n] * rs[ai][m];
#pragma unroll
                    for (int j = 0; j < 4; ++j) o[n][j] = g[j] * __builtin_amdgcn_rcpf(1.0f + __builtin_amdgcn_exp2f(-1.44269504f * g[j])) * up[j]; }
                *(u32x4*)(ACT + (size_t)row * 11008 + col0) = pack8(o[0], o[1]);
            }
    }
    static constexpr bool TAIL_SPLIT = true;
    __device__ __forceinline__ void tail(int row, int cg, int pn, int q, f32x4 g, f32x4 up) const {
        const float rs = rstd_of(ssq, row);
        g = g * rs; up = up * rs; f32x4 o;
#pragma unroll
        for (int j = 0; j < 4; ++j) o[j] = g[j] * __builtin_amdgcn_rcpf(1.0f + __builtin_amdgcn_exp2f(-1.44269504f * g[j])) * up[j];
        typedef unsigned u32x2t __attribute__((ext_vector_type(2)));
        u32x2t w; w.x = cvt_pk_bf16(o[0], o[1]); w.y = cvt_pk_bf16(o[2], o[3]);
        *(u32x2t*)(ACT + (size_t)row * 11008 + pn * HALF + q * 32 + 4 * cg) = w;
    }
};

struct EpiSwigluI8 {
    typedef int i32x4 __attribute__((ext_vector_type(4)));
    typedef i32x4 AccT;
    static constexpr bool PERM = true, AFTER_DRAIN = false, TAIL_SPLIT = true;
    bf16_t* ACT; const float* rowscale; const float* colmax;
    __device__ __forceinline__ void operator()(const i32x4 (&acc)[2][2][4][2], const Unit& u, int wr, int wc, int fr, int fq) const {
        const int row0 = u.pm * BM + wr * 64 + fr, col0 = u.pn * HALF + wc * 32 + 8 * fq, bcol = u.pn * BM + wc * 32 + 8 * fq;
        f32x4 cw[2][2];
#pragma unroll
        for (int bj = 0; bj < 2; ++bj)
#pragma unroll
            for (int n = 0; n < 2; ++n) cw[bj][n] = *(const f32x4*)(colmax + bcol + bj * HALF + 4 * n) * (1.0f / 127.0f);
        float rs[2][4];
#pragma unroll
        for (int ai = 0; ai < 2; ++ai)
#pragma unroll
            for (int m = 0; m < 4; ++m) rs[ai][m] = rowscale[row0 + ai * HALF + m * 16];
#pragma unroll
        for (int ai = 0; ai < 2; ++ai)
#pragma unroll
            for (int m = 0; m < 4; ++m) {
                const int row = row0 + ai * HALF + m * 16; f32x4 o[2];
#pragma unroll
                for (int n = 0; n < 2; ++n) {
#pragma unroll
                    for (int j = 0; j < 4; ++j) { const float g = (float)acc[ai][0][m][n][j] * rs[ai][m] * cw[0][n][j], up = (float)acc[ai][1][m][n][j] * rs[ai][m] * cw[1][n][j];
                        o[n][j] = g * __builtin_amdgcn_rcpf(1.0f + __builtin_amdgcn_exp2f(-1.44269504f * g)) * up; } }
                *(u32x4*)((char*)ACT + blk_byte(row, col0, 11008)) = pack8(o[0], o[1]);
            }
    }
    __device__ __forceinline__ void tail(int row, int cg, int pn, int q, f32x4 g, f32x4 up) const {
        const float rs = rowscale[row] * (1.0f / 127.0f);
        const f32x4 cgv = *(const f32x4*)(colmax + pn * BM + q * 32 + 4 * cg), cuv = *(const f32x4*)(colmax + pn * BM + HALF + q * 32 + 4 * cg);
        g = g * cgv * rs; up = up * cuv * rs; f32x4 o;
#pragma unroll
        for (int j = 0; j < 4; ++j) o[j] = g[j] * __builtin_amdgcn_rcpf(1.0f + __builtin_amdgcn_exp2f(-1.44269504f * g[j])) * up[j];
        typedef unsigned u32x2t __attribute__((ext_vector_type(2)));
        u32x2t w; w.x = cvt_pk_bf16(o[0], o[1]); w.y = cvt_pk_bf16(o[2], o[3]);
        *(u32x2t*)((char*)ACT + blk_byte(row, pn * HALF + q * 32 + 4 * cg, 11008)) = w;
    }
};
constexpr size_t OUT_KP = 34603008, OUT_VP = 34734080, OUT_KS = 34865152, OUT_VS = 34996224, OUT_SGUV = 35127296;
template <bool I8> struct EpiQKVT {
    typedef int i32x4_t __attribute__((ext_vector_type(4)));
    typedef typename AccSel<I8>::T AccT;
    static constexpr bool PERM = true, AFTER_DRAIN = false;
    bf16_t *KB, *VB, *QB; float* out; const u64* ssq; const float* kg; const float* qg; const float* rowscale; const float* cmq;
    __device__ __forceinline__ void operator()(const AccT (&acc)[2][2][4][2], const Unit& u, int wr, int wc, int fr, int fq) const {
        const int row0 = u.pm * BM + wr * 64 + fr;
        const bool isk = u.pn < 2, isq = u.pn >= 4, isv = !isk && !isq;
        const int hidx = (isk ? u.pn : (isq ? u.pn - 4 : u.pn - 2)) * 4 + wc;
        bf16_t* const kvb = isk ? KB : VB; const size_t o_s = isk ? OUT_KS : OUT_VS, o_p = isk ? OUT_KP : OUT_VP;
        const float* gp = (u.pn < 2) ? kg : qg;
        f32x4 gv[2][2];
#pragma unroll
        for (int bj = 0; bj < 2; ++bj)
#pragma unroll
            for (int n = 0; n < 2; ++n) gv[bj][n] = *(const f32x4*)(gp + 32 * bj + 8 * fq + 4 * n);
        const float gs = isq ? 0.125f : 1.0f;
        float rs[2][4];
#pragma unroll
        for (int ai = 0; ai < 2; ++ai)
#pragma unroll
            for (int m = 0; m < 4; ++m) rs[ai][m] = I8 ? rowscale[row0 + ai * HALF + m * 16] : rstd_of(ssq, row0 + ai * HALF + m * 16);
        f32x4 cw[2][2];
#pragma unroll
        for (int bj = 0; bj < 2; ++bj)
#pragma unroll
            for (int n = 0; n < 2; ++n) cw[bj][n] = I8 ? *(const f32x4*)(cmq + u.pn * BM + bj * HALF + wc * 32 + 8 * fq + 4 * n) * (1.0f / 127.0f) : (f32x4){1.f, 1.f, 1.f, 1.f};
#pragma unroll
        for (int ai = 0; ai < 2; ++ai)
#pragma unroll
            for (int m = 0; m < 4; ++m) {
                const int row = row0 + ai * HALF + m * 16;
                f32x4 t[2][2]; float ss = 0.f;
#pragma unroll
                for (int bj = 0; bj < 2; ++bj)
#pragma unroll
                    for (int n = 0; n < 2; ++n) { if constexpr (I8) t[bj][n] = __builtin_convertvector(acc[ai][bj][m][n], f32x4) * cw[bj][n] * rs[ai][m]; else t[bj][n] = acc[ai][bj][m][n] * rs[ai][m]; ss += ssq4(t[bj][n]); }
                if (!isv) {
                    ss += __shfl_xor(ss, 16); ss += __shfl_xor(ss, 32);
                    const float r = rsqrtf(ss * (1.0f / 64.0f) + 1e-6f) * gs;
#pragma unroll
                    for (int bj = 0; bj < 2; ++bj)
#pragma unroll
                        for (int n = 0; n < 2; ++n) t[bj][n] = t[bj][n] * r * gv[bj][n];
                }
                if (isq) {
                    bf16_t* p = QB + (size_t)row * 4096 + hidx * 64 + 8 * fq;
#pragma unroll
                    for (int bj = 0; bj < 2; ++bj) *(u32x4*)(p + 32 * bj) = pack8(t[bj][0], t[bj][1]);
                } else {
                    const int kr = row < 8192 ? row : 8192 + 160 * ((row - 8192) >> 5) + 128 + ((row - 8192) & 31);
                    bf16_t* p = kvb + (size_t)kr * 512 + hidx * 64 + 8 * fq;
#pragma unroll
                    for (int bj = 0; bj < 2; ++bj) *(u32x4*)(p + 32 * bj) = pack8(t[bj][0], t[bj][1]);
                    float* op = nullptr;
                    if (row >= 8192) op = out + o_s + (size_t)(row - 8192) * 512 + hidx * 64 + 8 * fq;
                    else { const int tt = row & 4095; if (tt >= 3968) op = out + o_p + (size_t)((row >> 12) * 128 + tt - 3968) * 512 + hidx * 64 + 8 * fq; }
                    if (op) {
#pragma unroll
                        for (int bj = 0; bj < 2; ++bj) { *(f32x4*)(op + 32 * bj) = t[bj][0]; *(f32x4*)(op + 32 * bj + 4) = t[bj][1]; }
                    }
                }
            }
    }
    static constexpr bool TAIL_SPLIT = false;
    __device__ __forceinline__ void tail(int row, int cg, int pn, int q, f32x4 v0, f32x4 v1) const {
        const bool isk = pn < 2, isq = pn >= 4, isv = !isk && !isq;
        const int hidx = (isk ? pn : (isq ? pn - 4 : pn - 2)) * 4 + q;
        const float rs = I8 ? rowscale[row] * (1.0f / 127.0f) : rstd_of(ssq, row);
        v0 = v0 * rs; v1 = v1 * rs;
        if constexpr (I8) { const float* cp = cmq + pn * BM + ((8 * cg) >> 5) * HALF + q * 32 + ((8 * cg) & 31); v0 = v0 * *(const f32x4*)cp; v1 = v1 * *(const f32x4*)(cp + 4); }
        if (!isv) {
            const float* gp = isk ? kg : qg;
            const f32x4 g0 = *(const f32x4*)(gp + 8 * cg), g1 = *(const f32x4*)(gp + 8 * cg + 4);
            float ss = ssq4(v0) + ssq4(v1); ss += __shfl_xor(ss, 1); ss += __shfl_xor(ss, 2); ss += __shfl_xor(ss, 4);
            const float r = rsqrtf(ss * (1.0f / 64.0f) + 1e-6f) * (isq ? 0.125f : 1.0f);
            v0 = v0 * r * g0; v1 = v1 * r * g1;
        }
        if (isq) { *(u32x4*)(QB + (size_t)row * 4096 + hidx * 64 + 8 * cg) = pack8(v0, v1); }
        else {
            const int kr = 8192 + 160 * ((row - 8192) >> 5) + 128 + ((row - 8192) & 31);
            *(u32x4*)((isk ? KB : VB) + (size_t)kr * 512 + hidx * 64 + 8 * cg) = pack8(v0, v1);
            float* op = out + (isk ? OUT_KS : OUT_VS) + (size_t)(row - 8192) * 512 + hidx * 64 + 8 * cg;
            *(f32x4*)op = v0; *(f32x4*)(op + 4) = v1;
        }
    }
};
typedef EpiQKVT<false> EpiQKV;
struct QOrder : StaticOrder {
    __device__ bool next(int i, Unit& u) const {
        long L;
        if (G != 256) { L = (long)i * G + c; if (L >= nwg) return false; }
        else if (c >= 128) { if (i >= 3) return false; L = (long)i * 128 + (c - 128); } else { if (i >= 1) return false; L = 384 + c; }
        int wgid = (int)L; { const int q = nwg / NXCD, r = nwg % NXCD, xcd = wgid % NXCD, off = wgid / NXCD; wgid = (xcd < r ? xcd * (q + 1) : r * (q + 1) + (xcd - r) * q) + off; }
        const int nig = WGM * nN, gid = wgid / nig, fm = gid * WGM, gsz = (nM - fm) < WGM ? (nM - fm) : WGM;
        u.pm = fm + ((wgid % nig) % gsz); u.pn = 4 + (wgid % nig) / gsz; return true;
    }
};
typedef int i32x4 __attribute__((ext_vector_type(4)));
__device__ __forceinline__ f32x4 mma16(bf16x8 a, bf16x8 b, f32x4 c) { return __builtin_amdgcn_mfma_f32_16x16x32_bf16(a, b, c, 0, 0, 0); }
__device__ __forceinline__ i32x4 mma16(bf16x8 a, bf16x8 b, i32x4 c) { return __builtin_amdgcn_mfma_i32_16x16x64_i8(__builtin_bit_cast(i32x4, a), __builtin_bit_cast(i32x4, b), c, 0, 0, 0); }
template <class Epi, class Sched, bool ALIGN_EPI = false, bool SP2 = false>
__device__ __forceinline__ void gemm_phase(PG8_LAS unsigned char* lds, const Gemm g, const Sched& S, const Epi& E) {
    const int tid = threadIdx.x, wid = __builtin_amdgcn_readfirstlane(tid >> 6), lane = tid & 63, wr = wid >> 2, wc = wid & 3, fr = lane & 15, fq = lane >> 4;
    const int K = g.K, nt = K / BK;
    unsigned voffA[2], voffB[2];
#pragma unroll
    for (int i = 0; i < 2; ++i) { int R, C; stage_rc(tid * 16 + i * 8192, R, C); const int Rb = Epi::PERM ? ((R & ~31) + perm32(R & 31)) : R;
        voffA[i] = g.ablk ? (unsigned)lds_byte(R, C) : (unsigned)(R * K + C) * 2u; voffB[i] = g.bblk ? (unsigned)lds_byte(Rb, C) : (unsigned)(Rb * K + C) * 2u; }
    const size_t kA = g.ablk ? (size_t)32768 : (size_t)(BK * 2), kB = g.bblk ? (size_t)32768 : (size_t)(BK * 2);
    const size_t hA = g.ablk ? (size_t)16384 : (size_t)HALF * K * 2, hB = g.bblk ? (size_t)16384 : (size_t)HALF * K * 2;
    const size_t tstep = (size_t)2 * HALF * K * 2;
    const unsigned ldsw = (unsigned)wid * 1024u;
    const int aoff = lds_byte(wr * 64 + fr, fq * 8), boff = lds_byte(wc * 32 + fr, fq * 8);
#define PG8_SA(b, h) (((b) * 2 + (h)) * HTB)
#define PG8_SB(b, h) ((4 + (b) * 2 + (h)) * HTB)
#define PG8_STAGE(bufoff, gbase, voff) do { _Pragma("unroll") for (int _i = 0; _i < 2; ++_i) \
        __builtin_amdgcn_global_load_lds((const unsigned*)((const char*)(gbase) + (voff)[_i]), (PG8_LAS unsigned*)(lds + (bufoff) + ldsw + _i * 8192), 16, 0, 0); } while (0)
#define PG8_LDA(dst, b, h) do { _Pragma("unroll") for (int m = 0; m < 4; ++m) _Pragma("unroll") for (int k = 0; k < 2; ++k) dst[m][k] = *(const PG8_LAS bf16x8*)(lds + PG8_SA(b, h) + aoff + m * 2048 + k * 1024); } while (0)
#define PG8_LDB(dst, b, h) do { _Pragma("unroll") for (int n = 0; n < 2; ++n) _Pragma("unroll") for (int k = 0; k < 2; ++k) dst[n][k] = *(const PG8_LAS bf16x8*)(lds + PG8_SB(b, h) + boff + n * 2048 + k * 1024); } while (0)
#define PG8_MMA(ai, bj, At, Bt) do { __builtin_amdgcn_s_setprio(1); _Pragma("unroll") for (int m = 0; m < 4; ++m) _Pragma("unroll") for (int n = 0; n < 2; ++n) _Pragma("unroll") for (int k = 0; k < 2; ++k) \
        acc[ai][bj][m][n] = mma16(Bt[n][k], At[m][k], acc[ai][bj][m][n]); __builtin_amdgcn_s_setprio(0); } while (0)
#define PG8_WAIT_V(n) asm volatile("s_waitcnt vmcnt(" #n ")" ::: "memory")
#define PG8_WAIT_L(n) asm volatile("s_waitcnt lgkmcnt(" #n ")" ::: "memory")
#define PG8_BAR __builtin_amdgcn_s_barrier()
#define PG8_SCHED __builtin_amdgcn_sched_barrier(0)
    Unit cur, nxt; int ui = 0;
    if (!S.next(0, cur)) return;
    typedef typename Epi::AccT AccT;
    AccT acc[2][2][4][2];
#pragma unroll
    for (int a = 0; a < 2; ++a)
#pragma unroll
        for (int b = 0; b < 2; ++b)
#pragma unroll
            for (int m = 0; m < 4; ++m)
#pragma unroll
                for (int n = 0; n < 2; ++n) acc[a][b][m][n] = (AccT){0, 0, 0, 0};
    bf16x8 At[4][2], B0[2][2], B1[2][2];
    const char* cA = (const char*)g.A + (size_t)cur.pm * tstep; const char* cB = (const char*)g.Bt + (size_t)cur.pn * tstep;
    S.a_ready(cur);
    if constexpr (SP2) {
        PG8_STAGE(PG8_SB(0, 0), cB, voffB); PG8_STAGE(PG8_SB(0, 1), cB + hB, voffB); PG8_STAGE(PG8_SA(0, 0), cA, voffA); PG8_STAGE(PG8_SA(0, 1), cA + hA, voffA);
        if (wr == 1) PG8_BAR;
        PG8_WAIT_V(2); PG8_BAR;
        PG8_STAGE(PG8_SB(1, 0), cB + kB, voffB); PG8_STAGE(PG8_SA(1, 0), cA + kA, voffA); PG8_STAGE(PG8_SB(1, 1), cB + hB + kB, voffB);
        PG8_WAIT_V(6); PG8_BAR;
    } else {
        PG8_STAGE(PG8_SB(0, 0), cB, voffB); PG8_STAGE(PG8_SA(0, 0), cA, voffA); PG8_STAGE(PG8_SB(0, 1), cB + hB, voffB); PG8_STAGE(PG8_SA(0, 1), cA + hA, voffA);
        if (wr == 1) PG8_BAR;
        PG8_WAIT_V(4); PG8_BAR;
        PG8_STAGE(PG8_SB(1, 0), cB + kB, voffB); PG8_STAGE(PG8_SA(1, 0), cA + kA, voffA); PG8_STAGE(PG8_SB(1, 1), cB + hB + kB, voffB);
        PG8_WAIT_V(6); PG8_BAR;
    }
    for (;;) {
        const bool has_next = S.next(ui + 1, nxt);
        const char* nA = has_next ? (const char*)g.A + (size_t)nxt.pm * tstep : cA; const char* nB = has_next ? (const char*)g.Bt + (size_t)nxt.pn * tstep : cB;
        for (int t = 0; t < nt; t += 2) {
            const bool last = (t == nt - 2);
            const char* a1 = cA + (size_t)(t + 1) * kA;
            const char* a2 = last ? nA : cA + (size_t)(t + 2) * kA; const char* b2 = last ? nB : cB + (size_t)(t + 2) * kB;
            const char* a3 = a2 + kA; const char* b3 = b2 + kB;
            if (last && has_next) S.a_ready(nxt);
            if constexpr (SP2) {
            PG8_LDB(B0, 0, 0); PG8_LDB(B1, 0, 1); PG8_SCHED; PG8_LDA(At, 0, 0); PG8_STAGE(PG8_SA(1, 1), a1 + hA, voffA);
            PG8_WAIT_V(8); PG8_WAIT_L(0); PG8_BAR; PG8_MMA(0, 0, At, B0); PG8_MMA(0, 1, At, B1); PG8_BAR; PG8_SCHED;
            PG8_LDA(At, 0, 1); PG8_STAGE(PG8_SB(0, 0), b2, voffB); PG8_STAGE(PG8_SB(0, 1), b2 + hB, voffB); PG8_STAGE(PG8_SA(0, 0), a2, voffA);
            PG8_WAIT_V(8); PG8_WAIT_L(0); PG8_BAR; PG8_MMA(1, 0, At, B0); PG8_MMA(1, 1, At, B1); PG8_BAR; PG8_SCHED;
            PG8_LDB(B0, 1, 0); PG8_LDB(B1, 1, 1); PG8_SCHED; PG8_LDA(At, 1, 0); PG8_STAGE(PG8_SA(0, 1), a2 + hA, voffA);
            PG8_WAIT_V(8); PG8_WAIT_L(0); PG8_BAR; PG8_MMA(0, 0, At, B0); PG8_MMA(0, 1, At, B1); PG8_BAR; PG8_SCHED;
            PG8_LDA(At, 1, 1); PG8_STAGE(PG8_SB(1, 0), b3, voffB); PG8_STAGE(PG8_SB(1, 1), b3 + hB, voffB); PG8_STAGE(PG8_SA(1, 0), a3, voffA);
            PG8_WAIT_V(8); PG8_WAIT_L(0); PG8_BAR; PG8_MMA(1, 0, At, B0); PG8_MMA(1, 1, At, B1); PG8_BAR; PG8_SCHED;
            } else {
            PG8_LDB(B0, 0, 0); PG8_SCHED; PG8_LDA(At, 0, 0); PG8_STAGE(PG8_SA(1, 1), a1 + hA, voffA);
            PG8_WAIT_L(8); PG8_BAR; PG8_WAIT_L(0); PG8_MMA(0, 0, At, B0); PG8_BAR; PG8_SCHED;
            PG8_LDB(B1, 0, 1); PG8_STAGE(PG8_SB(0, 0), b2, voffB);
            PG8_BAR; PG8_WAIT_L(0); PG8_MMA(0, 1, At, B1); PG8_BAR;
            PG8_LDA(At, 0, 1); PG8_STAGE(PG8_SA(0, 0), a2, voffA);
            PG8_BAR; PG8_WAIT_L(0); PG8_MMA(1, 0, At, B0); PG8_BAR; PG8_SCHED;
            PG8_STAGE(PG8_SB(0, 1), b2 + hB, voffB);
            PG8_WAIT_V(6); PG8_BAR; PG8_MMA(1, 1, At, B1); PG8_BAR;
            PG8_LDB(B0, 1, 0); PG8_SCHED; PG8_LDA(At, 1, 0); PG8_STAGE(PG8_SA(0, 1), a2 + hA, voffA);
            PG8_WAIT_L(8); PG8_BAR; PG8_WAIT_L(0); PG8_MMA(0, 0, At, B0); PG8_BAR; PG8_SCHED;
            PG8_LDB(B1, 1, 1); PG8_STAGE(PG8_SB(1, 0), b3, voffB);
            PG8_BAR; PG8_WAIT_L(0); PG8_MMA(0, 1, At, B1); PG8_BAR;
            PG8_LDA(At, 1, 1); PG8_STAGE(PG8_SA(1, 0), a3, voffA);
            PG8_BAR; PG8_WAIT_L(0); PG8_MMA(1, 0, At, B0); PG8_BAR; PG8_SCHED;
            PG8_STAGE(PG8_SB(1, 1), b3 + hB, voffB);
            PG8_WAIT_V(6); PG8_BAR; PG8_MMA(1, 1, At, B1); PG8_BAR;
            }
        }
        if constexpr (ALIGN_EPI) { if (wr == 0) PG8_BAR; }
        if constexpr (!Epi::AFTER_DRAIN) { E(acc, cur, wr, wc, fr, fq); S.done(cur); }
        if (!has_next) break;
#pragma unroll
        for (int a = 0; a < 2; ++a)
#pragma unroll
            for (int b = 0; b < 2; ++b)
#pragma unroll
                for (int m = 0; m < 4; ++m)
#pragma unroll
                    for (int n = 0; n < 2; ++n) acc[a][b][m][n] = (AccT){0, 0, 0, 0};
        cur = nxt; cA = nA; cB = nB; ++ui;
        if constexpr (ALIGN_EPI) { if (wr == 1) PG8_BAR; }
    }
    PG8_WAIT_V(0);
    if constexpr (!ALIGN_EPI) { if (wr == 0) PG8_BAR; }
    PG8_BAR;
    if constexpr (Epi::AFTER_DRAIN) { E.fused(acc, cur, wr, wc, fr, fq, lds, wid, lane); S.done(cur); }
#undef PG8_SA
#undef PG8_SB
#undef PG8_STAGE
#undef PG8_LDA
#undef PG8_LDB
#undef PG8_MMA
#undef PG8_WAIT_V
#undef PG8_WAIT_L
#undef PG8_BAR
#undef PG8_SCHED
}
}

#ifndef PG8_SP2
#define PG8_SP2 true
#endif
#ifndef PG8_ALIGN
#define PG8_ALIGN true
#endif
#ifndef MK_ONE_LAUNCH
#define MK_ONE_LAUNCH 1
#endif
constexpr int NWAVES = 8, NPHASES = 16;
constexpr int D = 4096, MP = 8192, MS = 256, M = MP + MS, DFF = 11008, NGU = 2 * DFF, NQKV = 5120, NSGU = 8192;
constexpr int KV_ROWS = 8192 + 8 * 160;
constexpr size_t MiB = 1u << 20;
constexpr size_t WS_CTL = 0, CTL_ZERO_BYTES = 1 * MiB;
constexpr int CW_BAR = 4096, CW_Q = 8192;
constexpr size_t ST_OFF = 65536, ST_STRIDE = 67584;
static_assert(ST_STRIDE == (size_t)M * 8 && ST_OFF + 6 * ST_STRIDE <= CTL_ZERO_BYTES, "stat arrays inside the memset region");
constexpr size_t CM_OFF = 524288, CM_STRIDE = 88064;
constexpr size_t RS_OFF = 720896;
constexpr size_t CMQ_OFF = 786432;
static_assert(ST_OFF + 6 * ST_STRIDE <= CM_OFF && CM_OFF + 2 * CM_STRIDE <= RS_OFF && RS_OFF + (size_t)M * 4 <= CMQ_OFF && CMQ_OFF + 5120 * 4 <= CTL_ZERO_BYTES, "control region map");
constexpr size_t CMO_OFF = 819200;
static_assert(CMQ_OFF + 5120 * 4 <= CMO_OFF && CMO_OFF + 4096 * 4 <= CTL_ZERO_BYTES, "control region map");
constexpr size_t CMD_OFF = 851968;
static_assert(CMO_OFF + 4096 * 4 <= CMD_OFF && CMD_OFF + 4096 * 4 <= CTL_ZERO_BYTES, "control region map");
constexpr size_t WS_ACT8 = (size_t)788 << 20;
constexpr size_t WS_WD8 = (size_t)514 << 20;
constexpr size_t WQ8_SHIFT = 4u << 20;
constexpr size_t WS_WSB = 1 * MiB;
constexpr size_t WS_W1T = 2 * MiB, WS_W2T = 66 * MiB, WS_WGU0 = 98 * MiB, WS_WD0 = 270 * MiB, WS_WQKV = 356 * MiB, WS_WOT = 396 * MiB, WS_WGU1 = 428 * MiB, WS_WD1 = 600 * MiB;
constexpr size_t WS_XB = 686 * MiB, WS_H = 752 * MiB  , WS_ACT = 884 * MiB, WS_ZQ = 1062 * MiB, WS_O = 1128 * MiB, WS_KB = 1194 * MiB, WS_VB = 1204 * MiB, WS_END = 1214 * MiB;
static_assert(WS_W1T + (size_t)NSGU * D * 2 <= WS_W2T && WS_W2T + (size_t)D * D * 2 <= WS_WGU0 && WS_WGU0 + (size_t)NGU * D * 2 <= WS_WD0 && WS_WD0 + (size_t)D * DFF * 2 <= WS_WQKV &&
              WS_WQKV + (size_t)NQKV * D * 2 <= WS_WOT && WS_WOT + (size_t)D * D * 2 <= WS_WGU1 && WS_WGU1 + (size_t)NGU * D * 2 <= WS_WD1 && WS_WD1 + (size_t)D * DFF * 2 <= WS_XB, "weight map");
static_assert(WS_XB + (size_t)M * D * 2 <= WS_H && WS_H + (size_t)M * D * 4 <= WS_ACT && WS_ACT + (size_t)M * DFF * 2 <= WS_ZQ && WS_ACT + (size_t)M * NSGU * 2 <= WS_ZQ &&
              WS_ZQ + (size_t)M * D * 2 <= WS_O && WS_O + (size_t)M * D * 2 <= WS_KB && WS_KB + (size_t)KV_ROWS * 512 * 2 <= WS_VB && WS_VB + (size_t)KV_ROWS * 512 * 2 <= WS_END, "activation map");
constexpr int SCR_BYTES = 139264;
constexpr int LDSCTL_OFF = SCR_BYTES, MISC_OFF = LDSCTL_OFF + 320;
constexpr int LDS_BYTES = 147456;
static_assert(MISC_OFF + 128 <= LDS_BYTES && pg8::STAGE_BYTES <= SCR_BYTES, "LDS map");

#define GAS __attribute__((address_space(1)))
#define LAS __attribute__((address_space(3)))
typedef unsigned short bf16;
typedef unsigned v4u __attribute__((ext_vector_type(4)));
typedef unsigned v2u __attribute__((ext_vector_type(2)));
typedef float f32x4 __attribute__((ext_vector_type(4)));
typedef short bf16x8 __attribute__((ext_vector_type(8)));
typedef unsigned long long u64;
#define LDS_WAIT() asm volatile("s_waitcnt lgkmcnt(0)" ::: "memory")
#define VM_WAIT() asm volatile("s_waitcnt vmcnt(0)" ::: "memory")
__device__ __forceinline__ unsigned f2bf(float f) { unsigned u = __builtin_bit_cast(unsigned, f); return (u + 0x7fffu + ((u >> 16) & 1u)) >> 16; }
typedef float f32x2_t __attribute__((ext_vector_type(2)));
typedef __bf16 bf16x2_t __attribute__((ext_vector_type(2)));
__device__ __forceinline__ unsigned pk2(float lo, float hi) { const f32x2_t v = {lo, hi}; const bf16x2_t b = __builtin_convertvector(v, bf16x2_t); return __builtin_bit_cast(unsigned, b); }
__device__ __forceinline__ float bflo(unsigned w) { return __builtin_bit_cast(float, w << 16); }
__device__ __forceinline__ float bfhi(unsigned w) { return __builtin_bit_cast(float, w & 0xffff0000u); }

#define XB_TMO      128
#define XB_XCNT(j)  (256  + 64 * (j))
#define XB_XSUB(j)  (1280 + 64 * (j))
#define XB_XGEN(j)  (2304 + 64 * (j))
#define XB_TOP      3328
#define XB_TOPGEN   3392
#define XCD_BAR_WORDS 3456
#define XB_SPIN_CAP (1u << 18)

__device__ __forceinline__ unsigned xb_ld(unsigned* p)              { return __hip_atomic_load(p, __ATOMIC_RELAXED, __HIP_MEMORY_SCOPE_AGENT); }
__device__ __forceinline__ unsigned xb_add(unsigned* p, unsigned v) { return __hip_atomic_fetch_add(p, v, __ATOMIC_RELAXED, __HIP_MEMORY_SCOPE_AGENT); }
__device__ __forceinline__ unsigned xb_xcc_id() { return (unsigned)__builtin_amdgcn_s_getreg((3 << 11) | 20) & 0xFu; }
#define XB_SPIN(cond, bar) do { unsigned _sp = 0; while (cond) { __builtin_amdgcn_s_sleep(1); \
    if ((++_sp & 255u) == 0u) { if (xb_ld(&(bar)[XB_TMO])) break; if (_sp > XB_SPIN_CAP) { atomicAdd(&(bar)[XB_TMO], 1u); break; } } } } while (0)

struct XcdBarrier {
    unsigned* bar; unsigned x;
    volatile LAS unsigned* st;
};

__device__ __forceinline__ XcdBarrier xcd_barrier_post(unsigned* bar, volatile LAS unsigned* st) {
    XcdBarrier b; b.bar = bar; b.x = xb_xcc_id(); b.st = st;
    if (threadIdx.x == 0) (void)xb_add(&bar[XB_XCNT(b.x)], 1u);
    return b;
}
__device__ __forceinline__ void xcd_barrier_complete(unsigned* bar, unsigned x, unsigned& nloc, unsigned& nx) {
    const unsigned G = gridDim.x * gridDim.y * gridDim.z;
    unsigned sum, cnt, mine, sp = 0u;
    for (;;) {
        sum = 0u; cnt = 0u; mine = 0u;
#pragma unroll
        for (unsigned j = 0; j < 16; ++j) { const unsigned c = xb_ld(&bar[XB_XCNT(j)]); sum += c; cnt += (c > 0u) ? 1u : 0u; mine = (j == x) ? c : mine; }
        if (sum == G) break;
        __builtin_amdgcn_s_sleep(1);
        if ((++sp & 255u) == 0u) { if (xb_ld(&bar[XB_TMO])) break; if (sp > XB_SPIN_CAP) { atomicAdd(&bar[XB_TMO], 1u); break; } }
    }
    nloc = mine > 0u ? mine : 1u; nx = cnt > 0u ? cnt : 1u;
}

__device__ __forceinline__ void xcd_barrier(const XcdBarrier& b) {
    asm volatile("s_waitcnt vmcnt(0)" ::: "memory");
    __syncthreads();
    if (threadIdx.x == 0) {
        unsigned* bar = b.bar;
        __builtin_amdgcn_s_waitcnt(0);
        unsigned nloc = b.st[0], nx = b.st[1];
        if (nloc == 0u) { xcd_barrier_complete(bar, b.x, nloc, nx); b.st[0] = nloc; b.st[1] = nx; }
        const unsigned old = xb_add(&bar[XB_XSUB(b.x)], 1u);
        const unsigned gen = old / nloc;
        if (old + 1u == (gen + 1u) * nloc) {
            __builtin_amdgcn_fence(__ATOMIC_RELEASE, "agent");
            asm volatile("s_waitcnt vmcnt(0)" ::: "memory");
            const unsigned og = xb_add(&bar[XB_TOP], 1u);
            const unsigned tg = og / nx;
            if (og + 1u == (tg + 1u) * nx) xb_add(&bar[XB_TOPGEN], 1u);
            else XB_SPIN(xb_ld(&bar[XB_TOPGEN]) == tg, bar);
            __builtin_amdgcn_fence(__ATOMIC_ACQUIRE, "agent");
            xb_add(&bar[XB_XGEN(b.x)], 1u);
            asm volatile("s_waitcnt vmcnt(0)" ::: "memory");
        } else {
            XB_SPIN(xb_ld(&bar[XB_XGEN(b.x)]) == gen, bar);
            __builtin_amdgcn_fence(__ATOMIC_ACQUIRE, "agent");
            asm volatile("s_waitcnt vmcnt(0)" ::: "memory");
        }
    }
    __syncthreads();
}


using pg8::FIX_INV;
__device__ __forceinline__ float wave_sum(float v) {
#pragma unroll
    for (int o = 1; o < 64; o <<= 1) v += __shfl_xor(v, o);
    return v;
}
__device__ __forceinline__ int maprow(int map, int n) {
    const int r12 = ((n >> 7) << 8) + (n & 127) + (map == 2 ? 128 : 0);
    const int r3 = (n & ~255) + (((n >> 5) & 1) << 7) + (((n >> 6) & 3) << 5) + (n & 31);
    return map == 0 ? n : (map == 3 ? r3 : r12);
}
struct TItem { const float* W; const float* gain; bf16* WT; const float* cmax; unsigned* amax; int K, N, map, coff, k0, n0, blk, rot; };
#define WHT_BF(a_, b_) do { const float t_ = a_; a_ = t_ + b_; b_ = t_ - b_; } while (0)
__device__ __forceinline__ void wht32(float (&v)[8], int lane) {
    WHT_BF(v[0], v[1]); WHT_BF(v[2], v[3]); WHT_BF(v[4], v[5]); WHT_BF(v[6], v[7]);
    WHT_BF(v[0], v[2]); WHT_BF(v[1], v[3]); WHT_BF(v[4], v[6]); WHT_BF(v[5], v[7]);
    WHT_BF(v[0], v[4]); WHT_BF(v[1], v[5]); WHT_BF(v[2], v[6]); WHT_BF(v[3], v[7]);
#pragma unroll
    for (int mask = 1; mask <= 2; mask <<= 1)
#pragma unroll
        for (int i = 0; i < 8; ++i) { const float pv = __shfl_xor(v[i], mask); v[i] = (lane & mask) ? pv - v[i] : v[i] + pv; }
}
struct TRegs { f32x4 v[16]; f32x4 g0, g1; float cm[8]; };
__device__ __forceinline__ void titem_load(const TItem& t, TRegs& R, const float* dummy, int lane) {
    const float* p = t.W + (size_t)(t.k0 + (lane >> 4)) * t.N + t.n0 + 4 * (lane & 15);
#pragma unroll
    for (int i = 0; i < 16; ++i) R.v[i] = __builtin_nontemporal_load((const f32x4*)(p + (size_t)(4 * i) * t.N));
    const float* gp = (t.gain ? t.gain + t.k0 : dummy + (t.k0 & 4095)) + 8 * (lane & 7);
    R.g0 = *(const f32x4*)gp; R.g1 = *(const f32x4*)(gp + 4);
    const float* cp = t.cmax ? t.cmax : dummy;
#pragma unroll
    for (int j = 0; j < 8; ++j) R.cm[j] = cp[t.cmax ? maprow(t.map, t.n0 + 8 * j + (lane >> 3) + t.coff) : j];
}
__device__ __forceinline__ void titem_lds_write(const TRegs& R, LAS float* scr, int lane) {
#pragma unroll
    for (int i = 0; i < 16; ++i) { const int kk = 4 * i + (lane >> 4), c4 = (lane & 15) ^ (((kk >> 3) & 3) << 1); *(LAS f32x4*)(scr + kk * 64 + 4 * c4) = R.v[i]; }
}
__device__ __forceinline__ void titem_emit(const TItem& t, f32x4 g0, f32x4 g1, const float (&cm)[8], LAS float* scr, int lane) {
    LDS_WAIT(); asm volatile("" ::: "memory");
    const int c = lane & 7, nn = lane >> 3;
    const bool hg = t.gain != nullptr; const f32x4 one = {1.f, 1.f, 1.f, 1.f};
    g0 = hg ? g0 : one; g1 = hg ? g1 : one;
    const int sw = (c & 3) << 1;
#pragma unroll
    for (int j = 0; j < 8; ++j) { const int n = 8 * j + nn; const LAS float* sp = scr + (8 * c) * 64 + ((((n >> 2) ^ sw) << 2) | (n & 3));
        const size_t drow = (size_t)maprow(t.map, t.n0 + n + t.coff);
        if (t.cmax) {
            const float inv = cm[j] > 0.f ? 127.0f / cm[j] : 0.f;
            const int q0 = __float2int_rn(sp[0 * 64] * g0.x * inv), q1 = __float2int_rn(sp[1 * 64] * g0.y * inv), q2 = __float2int_rn(sp[2 * 64] * g0.z * inv), q3 = __float2int_rn(sp[3 * 64] * g0.w * inv);
            const int q4 = __float2int_rn(sp[4 * 64] * g1.x * inv), q5 = __float2int_rn(sp[5 * 64] * g1.y * inv), q6 = __float2int_rn(sp[6 * 64] * g1.z * inv), q7 = __float2int_rn(sp[7 * 64] * g1.w * inv);
            v2u o; o.x = (unsigned)(q0 & 255) | ((unsigned)(q1 & 255) << 8) | ((unsigned)(q2 & 255) << 16) | ((unsigned)q3 << 24);
            o.y = (unsigned)(q4 & 255) | ((unsigned)(q5 & 255) << 8) | ((unsigned)(q6 & 255) << 16) | ((unsigned)q7 << 24);
            __builtin_nontemporal_store(o, (GAS v2u*)(t.blk ? (unsigned char*)t.WT + pg8::blk_byte((int)drow, (t.k0 + 8 * c) >> 1, t.K >> 1) : (unsigned char*)t.WT + drow * t.K + t.k0 + 8 * c));
        } else {
        float ev[8] = {sp[0 * 64] * g0.x, sp[1 * 64] * g0.y, sp[2 * 64] * g0.z, sp[3 * 64] * g0.w, sp[4 * 64] * g1.x, sp[5 * 64] * g1.y, sp[6 * 64] * g1.z, sp[7 * 64] * g1.w};
        if (t.rot) wht32(ev, lane);
        v4u o; o.x = pk2(ev[0], ev[1]); o.y = pk2(ev[2], ev[3]); o.z = pk2(ev[4], ev[5]); o.w = pk2(ev[6], ev[7]);
        if (t.amax) {
            unsigned m = 0u;
#pragma unroll
            for (int q = 0; q < 4; ++q) { const unsigned w = o[q] & 0x7fff7fffu, lo = w & 0xffffu, hi = w >> 16; m = m > lo ? m : lo; m = m > hi ? m : hi; }
            { unsigned v = (unsigned)__shfl_xor((int)m, 1); m = m > v ? m : v; v = (unsigned)__shfl_xor((int)m, 2); m = m > v ? m : v; v = (unsigned)__shfl_xor((int)m, 4); m = m > v ? m : v; }
            if (c == 0) (void)__hip_atomic_fetch_max(t.amax + drow, m << 16, __ATOMIC_RELAXED, __HIP_MEMORY_SCOPE_AGENT);
        }
        __builtin_nontemporal_store(o, (GAS v4u*)(t.blk ? (bf16*)((char*)t.WT + pg8::blk_byte((int)drow, t.k0 + 8 * c, t.K)) : t.WT + drow * t.K + t.k0 + 8 * c)); } }
    LDS_WAIT(); asm volatile("" ::: "memory");
}
struct Args { const float* in[23]; float* out; unsigned char* ws; int ph_lo, ph_hi; };
constexpr int P0_ITEMS_A = 64 * 128;
constexpr int P0_ITEMS_P1 = P0_ITEMS_A + 64 * 64 + 2 * 64 * 172 + 172 * 64 + 64 * 16 + 64 * 64, P0_ITEMS_P4 = P0_ITEMS_P1 + 64 * 64 + 64 * 172, P0_ITEMS_P6 = P0_ITEMS_P4 + 64 * 172;
constexpr int P0_ITEMS_ALL = 64 * 128 + 64 * 64 + 2 * 64 * 172 + 172 * 64 + 64 * 16 + 64 * 64 + 64 * 64 + 2 * 64 * 172 + 172 * 64;
__device__ __forceinline__ void p0_prologue(const Args& a, unsigned char* ws, LAS unsigned char* lds, int gw, int NGW, int it_lo, int it_hi, int misc, int wave, int lane) {
    LAS float* scr = (LAS float*)(lds + wave * 16384);
    constexpr int IT_1 = 64 * 128, IT_SQ = 64 * 64, IT_G = 64 * 172, IT_D = 172 * 64, IT_KV = 64 * 16;
    constexpr int NITEMS = IT_1 + IT_SQ + 2 * IT_G + IT_D + IT_KV + IT_SQ + IT_SQ + 2 * IT_G + IT_D;
    auto describe = [&](int it) -> TItem {
        TItem t; int r = it; t.gain = nullptr; t.cmax = nullptr; t.K = 4096; t.N = 4096; t.map = 0; t.coff = 0; t.blk = 1; t.amax = nullptr; t.rot = 0;
        if (r < IT_1) { t.W = a.in[5]; t.gain = a.in[4]; t.WT = (bf16*)(ws + WS_W1T); t.N = 8192; }
        else if ((r -= IT_1) < IT_SQ) { t.W = a.in[10]; t.WT = (bf16*)(ws + WS_W2T); }
        else if ((r -= IT_SQ) < IT_G) { t.W = a.in[20]; t.gain = a.in[19]; t.WT = (bf16*)(ws + WS_WGU0); t.N = DFF; t.map = 1; t.cmax = (const float*)(ws + CM_OFF); }
        else if ((r -= IT_G) < IT_G) { t.W = a.in[21]; t.gain = a.in[19]; t.WT = (bf16*)(ws + WS_WGU0); t.N = DFF; t.map = 2; t.cmax = (const float*)(ws + CM_OFF); }
        else if ((r -= IT_G) < IT_D) { t.W = a.in[22]; t.WT = (bf16*)(ws + WS_WD0); t.K = DFF; }
        else if ((r -= IT_D) < IT_KV) { t.W = a.in[12]; t.gain = a.in[11]; t.WT = (bf16*)(ws + WS_WQKV); t.N = 1024; t.map = 3; }
        else if ((r -= IT_KV) < IT_SQ) { t.W = a.in[15]; t.gain = a.in[14]; t.WT = (bf16*)(ws + WS_WQKV + WQ8_SHIFT); t.map = 3; t.coff = 1024; t.cmax = (const float*)(ws + CMQ_OFF); }
        else if ((r -= IT_SQ) < IT_SQ) { t.W = a.in[18]; t.WT = (bf16*)(ws + WS_WOT); t.cmax = (const float*)(ws + CMO_OFF); }
        else if ((r -= IT_SQ) < IT_G) { t.W = a.in[20] + (size_t)D * DFF; t.gain = a.in[19] + D; t.WT = (bf16*)(ws + WS_WGU1); t.N = DFF; t.map = 1; t.cmax = (const float*)(ws + CM_OFF + CM_STRIDE); }
        else if ((r -= IT_G) < IT_G) { t.W = a.in[21] + (size_t)D * DFF; t.gain = a.in[19] + D; t.WT = (bf16*)(ws + WS_WGU1); t.N = DFF; t.map = 2; t.cmax = (const float*)(ws + CM_OFF + CM_STRIDE); }
        else { r -= IT_G; t.W = a.in[22] + (size_t)D * DFF; t.WT = (bf16*)(ws + WS_WD1); t.K = DFF; t.rot = 1; t.amax = (unsigned*)(ws + CMD_OFF); }
        const int nblk = t.N >> 6, kb = r / nblk; t.k0 = 64 * kb; t.n0 = 64 * (r - kb * nblk);
        return t;
    };
    static_assert(NITEMS == P0_ITEMS_ALL && IT_1 == P0_ITEMS_A, "item counts");
    if (it_lo + gw < it_hi) {
        const int first = it_lo + gw, last = first + ((it_hi - 1 - first) / NGW) * NGW, count = (last - first) / NGW + 1;
        TRegs ra, rb; const float* dummy = a.in[4];
        TItem ta = describe(first), tb = describe(first + NGW <= last ? first + NGW : last);
        titem_load(ta, ra, dummy, lane); titem_load(tb, rb, dummy, lane);
        for (int j = 0; j < count; j += 2) {
            const int i2 = first + (j + 2) * NGW, i3 = first + (j + 3) * NGW;
            const TItem tc = describe(i2 <= last ? i2 : last), td = describe(i3 <= last ? i3 : last);
            { titem_lds_write(ra, scr, lane); const f32x4 g0 = ra.g0, g1 = ra.g1; float cm[8]; _Pragma("unroll") for (int q = 0; q < 8; ++q) cm[q] = ra.cm[q]; titem_load(tc, ra, dummy, lane); titem_emit(ta, g0, g1, cm, scr, lane); }
            { titem_lds_write(rb, scr, lane); const f32x4 g0 = rb.g0, g1 = rb.g1; float cm[8]; _Pragma("unroll") for (int q = 0; q < 8; ++q) cm[q] = rb.cm[q]; titem_load(td, rb, dummy, lane); titem_emit(tb, g0, g1, cm, scr, lane); }
            ta = tc; tb = td;
        }
        asm volatile("s_waitcnt vmcnt(0)" ::: "memory");
    }
    if (!misc) return;
    bf16* XB = (bf16*)(ws + WS_XB); u64* ssq_x = (u64*)(ws + ST_OFF);
    for (int m = gw; m < M; m += NGW) {
        const float* xrow = m < MP ? a.in[0] + (size_t)m * D : a.in[1] + (size_t)(m - MP) * D;
        const GAS f32x4* xr = (const GAS f32x4*)xrow + lane; GAS v2u* o8 = (GAS v2u*)(XB + (size_t)m * D) + lane; float ss = 0.f;
#pragma unroll 4
        for (int j = 0; j < 16; ++j) { const f32x4 v = xr[64 * j]; ss += (v.x * v.x + v.y * v.y) + (v.z * v.z + v.w * v.w); v2u o; o.x = pk2(v.x, v.y); o.y = pk2(v.z, v.w); o8[64 * j] = o; }
        ss = wave_sum(ss);
        if (lane == 0) ssq_x[m] = (u64)(ss * pg8::FIX_SCALE);
    }
    const int gt = gw * 64 + lane, NT = NGW * 64;
    bf16* KB = (bf16*)(ws + WS_KB); bf16* VB = (bf16*)(ws + WS_VB); bf16* WSB = (bf16*)(ws + WS_WSB);
    for (int i = gt; i < 65536; i += NT) {
        const int e = i * 8, b = e >> 16, t = (e >> 9) & 127, c = e & 511; const size_t dst = (size_t)(8192 + 160 * b + t) * 512 + c;
        { const f32x4 v0 = *(const f32x4*)(a.in[2] + e), v1 = *(const f32x4*)(a.in[2] + e + 4); v4u o; o.x = pk2(v0.x, v0.y); o.y = pk2(v0.z, v0.w); o.z = pk2(v1.x, v1.y); o.w = pk2(v1.z, v1.w); *(v4u*)(KB + dst) = o; }
        { const f32x4 v0 = *(const f32x4*)(a.in[3] + e), v1 = *(const f32x4*)(a.in[3] + e + 4); v4u o; o.x = pk2(v0.x, v0.y); o.y = pk2(v0.z, v0.w); o.z = pk2(v1.x, v1.y); o.w = pk2(v1.z, v1.w); *(v4u*)(VB + dst) = o; }
    }
    for (int i = gt; i < 16384; i += NT) {
        const int e = i * 8, ii = (e >> 7) & 127, j = e & 127; const bool keep = (ii >> 6) >= (j >> 6);
        const f32x4 v0 = *(const f32x4*)(a.in[8] + e), v1 = *(const f32x4*)(a.in[8] + e + 4); v4u o = {0u, 0u, 0u, 0u};
        if (keep) { o.x = pk2(v0.x, v0.y); o.y = pk2(v0.z, v0.w); o.z = pk2(v1.x, v1.y); o.w = pk2(v1.z, v1.w); }
        *(v4u*)(WSB + e) = o;
    }
}


__device__ __forceinline__ void absmax_pass(const Args& a, unsigned char* ws, int gw, int NGW, int lane) {
    constexpr int PER = 16 * 172, PERQ = 16 * 64, NIT = 4 * PER + 2 * PERQ;
    const int r = lane >> 4;
    for (int it = gw; it < NIT; it += NGW) {
        const bool iso = it >= 4 * PER + PERQ, isq = !iso && it >= 4 * PER, sq = iso || isq;
        const int mat = sq ? 0 : it / PER, rem = iso ? it - 4 * PER - PERQ : (isq ? it - 4 * PER : it - mat * PER), nblk = sq ? 64 : 172, kg = rem / nblk, nb = rem - kg * nblk, l = mat >> 1, up = mat & 1;
        const float* W = iso ? a.in[18] : (isq ? a.in[15] : (up ? a.in[21] : a.in[20]) + (size_t)l * D * DFF);
        const float* gain = iso ? a.in[14] : (isq ? a.in[14] : a.in[19] + l * D); const float gmul = iso ? 0.f : 1.f, gadd = iso ? 1.f : 0.f;
        unsigned* cmax = iso ? (unsigned*)(ws + CMO_OFF) : (isq ? (unsigned*)(ws + CMQ_OFF) : (unsigned*)(ws + CM_OFF + (size_t)l * CM_STRIDE));
        const int NW = sq ? D : DFF, amap = iso ? 0 : (isq ? 3 : 1 + up), acoff = isq ? 1024 : 0;
        const int k0 = 256 * kg, n0 = 64 * nb;
        const float* p = W + (size_t)(k0 + r) * NW + n0 + 4 * (lane & 15);
        f32x4 va[16], vb[16]; float ga[16], gb[16];
#define AM_LOAD(v_, g_, sb_) do { _Pragma("unroll") for (int i = 0; i < 16; ++i) { v_[i] = __builtin_nontemporal_load((const f32x4*)(p + (size_t)(64 * (sb_) + 4 * i) * NW)); g_[i] = gain[k0 + 64 * (sb_) + 4 * i + r] * gmul + gadd; } } while (0)
#define AM_MAX(v_, g_) do { _Pragma("unroll") for (int i = 0; i < 16; ++i) { m0 = fmaxf(m0, fabsf(v_[i].x * g_[i])); m1 = fmaxf(m1, fabsf(v_[i].y * g_[i])); m2 = fmaxf(m2, fabsf(v_[i].z * g_[i])); m3 = fmaxf(m3, fabsf(v_[i].w * g_[i])); } } while (0)
        float m0 = 0.f, m1 = 0.f, m2 = 0.f, m3 = 0.f;
        AM_LOAD(va, ga, 0); AM_LOAD(vb, gb, 1);
        AM_MAX(va, ga); AM_LOAD(va, ga, 2);
        AM_MAX(vb, gb); AM_LOAD(vb, gb, 3);
        AM_MAX(va, ga); AM_MAX(vb, gb);
#undef AM_LOAD
#undef AM_MAX
        m0 = fmaxf(m0, __shfl_xor(m0, 16)); m0 = fmaxf(m0, __shfl_xor(m0, 32)); m1 = fmaxf(m1, __shfl_xor(m1, 16)); m1 = fmaxf(m1, __shfl_xor(m1, 32));
        m2 = fmaxf(m2, __shfl_xor(m2, 16)); m2 = fmaxf(m2, __shfl_xor(m2, 32)); m3 = fmaxf(m3, __shfl_xor(m3, 16)); m3 = fmaxf(m3, __shfl_xor(m3, 32));
        if (lane < 16) {
            unsigned* cp = cmax + maprow(amap, n0 + 4 * lane + acoff);
            (void)__hip_atomic_fetch_max(cp + 0, __builtin_bit_cast(unsigned, m0), __ATOMIC_RELAXED, __HIP_MEMORY_SCOPE_AGENT);
            (void)__hip_atomic_fetch_max(cp + 1, __builtin_bit_cast(unsigned, m1), __ATOMIC_RELAXED, __HIP_MEMORY_SCOPE_AGENT);
            (void)__hip_atomic_fetch_max(cp + 2, __builtin_bit_cast(unsigned, m2), __ATOMIC_RELAXED, __HIP_MEMORY_SCOPE_AGENT);
            (void)__hip_atomic_fetch_max(cp + 3, __builtin_bit_cast(unsigned, m3), __ATOMIC_RELAXED, __HIP_MEMORY_SCOPE_AGENT);
        }
    }
}
template <int R>
__device__ __forceinline__ void quant_rows_n(const bf16* XB, const u64* ssq, unsigned char* A8, float* rowscale, int m0, int mstride, int lane) {
    v4u w[R][8]; unsigned mx[R];
#pragma unroll
    for (int r = 0; r < R; ++r) { const v4u* xr = (const v4u*)(XB + (size_t)(m0 + r * mstride) * D) + lane;
#pragma unroll
        for (int j = 0; j < 8; ++j) w[r][j] = xr[64 * j]; }
#pragma unroll
    for (int r = 0; r < R; ++r) { unsigned m = 0u;
#pragma unroll
        for (int j = 0; j < 8; ++j)
#pragma unroll
            for (int q = 0; q < 4; ++q) { const unsigned t = w[r][j][q] & 0x7fff7fffu; const unsigned lo = t & 0xffffu, hi = t >> 16; m = m > lo ? m : lo; m = m > hi ? m : hi; }
        mx[r] = m; }
#pragma unroll
    for (int o = 1; o < 64; o <<= 1)
#pragma unroll
        for (int r = 0; r < R; ++r) { const unsigned t = (unsigned)__shfl_xor((int)mx[r], o); mx[r] = mx[r] > t ? mx[r] : t; }
#pragma unroll
    for (int r = 0; r < R; ++r) { const int m = m0 + r * mstride;
        const float fmx = __builtin_bit_cast(float, mx[r] << 16), inv = fmx > 0.f ? 127.0f / fmx : 0.f;
        v2u* orow = (v2u*)(A8 + (size_t)m * D) + lane;
#pragma unroll
        for (int j = 0; j < 8; ++j) { unsigned b[8];
#pragma unroll
            for (int q = 0; q < 4; ++q) { b[2 * q] = (unsigned)__float2int_rn(bflo(w[r][j][q]) * inv) & 255u; b[2 * q + 1] = (unsigned)__float2int_rn(bfhi(w[r][j][q]) * inv) & 255u; }
            v2u o; o.x = b[0] | (b[1] << 8) | (b[2] << 16) | (b[3] << 24); o.y = b[4] | (b[5] << 8) | (b[6] << 16) | (b[7] << 24); orow[64 * j] = o; }
        if (lane == 0) rowscale[m] = fmx * (1.0f / 127.0f) * (ssq ? rsqrtf((float)ssq[m] * (pg8::FIX_INV * (1.0f / 4096.0f)) + 1e-6f) : 1.0f); }
}
__device__ __forceinline__ void quant_rows(const bf16* XB, const u64* ssq, unsigned char* A8, float* rowscale, int gw, int NGW, int lane) {
    int m = gw;
    for (; m + 3 * NGW < M; m += 4 * NGW) quant_rows_n<4>(XB, ssq, A8, rowscale, m, NGW, lane);
    for (; m < M; m += NGW) quant_rows_n<1>(XB, ssq, A8, rowscale, m, NGW, lane);
}
__device__ __forceinline__ void actq_rows(const bf16* ACT, unsigned char* ACT8, float* rowscale, int gw, int NGW, int lane) {
    for (int mp = 2 * gw; mp < M; mp += 2 * NGW)
#pragma unroll 1
    for (int m = mp; m < mp + 2; ++m) {
        v4u w[22];
#pragma unroll
        for (int i = 0; i < 22; ++i) { const int c = 64 * i + lane; const v4u z = {0u, 0u, 0u, 0u};
            w[i] = c < DFF / 8 ? *(const v4u*)((const char*)ACT + pg8::blk_byte(m, 8 * (c < DFF / 8 ? c : 0), DFF)) : z; }
        float mx = 0.f;
#pragma unroll
        for (int i = 0; i < 22; ++i) { float v[8] = {bflo(w[i].x), bfhi(w[i].x), bflo(w[i].y), bfhi(w[i].y), bflo(w[i].z), bfhi(w[i].z), bflo(w[i].w), bfhi(w[i].w)};
            wht32(v, lane);
#pragma unroll
            for (int k = 0; k < 4; ++k) { w[i][k] = pk2(v[2 * k], v[2 * k + 1]); mx = fmaxf(mx, fmaxf(fabsf(bflo(w[i][k])), fabsf(bfhi(w[i][k])))); } }
#pragma unroll
        for (int o = 1; o < 64; o <<= 1) mx = fmaxf(mx, __shfl_xor(mx, o));
        const float inv = mx > 0.f ? 127.0f / mx : 0.f;
#pragma unroll
        for (int i = 0; i < 22; ++i) { unsigned q[8];
#pragma unroll
            for (int k = 0; k < 4; ++k) { q[2 * k] = (unsigned)__float2int_rn(bflo(w[i][k]) * inv) & 255u; q[2 * k + 1] = (unsigned)__float2int_rn(bfhi(w[i][k]) * inv) & 255u; }
            v2u o; o.x = q[0] | (q[1] << 8) | (q[2] << 16) | (q[3] << 24); o.y = q[4] | (q[5] << 8) | (q[6] << 16) | (q[7] << 24);
            const int c = 64 * i + lane;
            if (c < DFF / 8) *(v2u*)(ACT8 + pg8::blk_byte(m, 4 * c, DFF / 2)) = o; }
        if (lane == 0) rowscale[m] = mx * (1.0f / (127.0f * 32.0f));
    }
}
__device__ __forceinline__ void requant_w(const unsigned char* src, const float* cmax, unsigned char* dst, int K, int nrows, int gw, int NGW, int lane) {
    const int nkt = K >> 6, NU = (nrows >> 4) * nkt;
    int R0, C0; pg8::stage_rc(lane * 16, R0, C0);
    for (int u0 = 4 * gw; u0 < NU; u0 += 4 * NGW) {
        v4u a[4], b[4]; float inv[4]; int r0[4], kt[4];
#pragma unroll
        for (int i = 0; i < 4; ++i) { const int u = u0 + i < NU ? u0 + i : NU - 1; const unsigned char* p = src + (size_t)u * 2048 + lane * 16;
            a[i] = __builtin_nontemporal_load((const v4u*)p); b[i] = __builtin_nontemporal_load((const v4u*)(p + 1024));
            const int within = u & 15, t2 = u >> 4; kt[i] = t2 % nkt; r0[i] = (t2 / nkt) * 256 + (within >> 3) * 128 + (within & 7) * 16 + R0;
            const float cm = cmax[r0[i]]; inv[i] = cm > 0.f ? 127.0f / cm : 0.f; }
#pragma unroll
        for (int i = 0; i < 4; ++i) { if (u0 + i >= NU) break;
#pragma unroll
            for (int h = 0; h < 2; ++h) { const v4u w = h ? b[i] : a[i]; unsigned q[8];
#pragma unroll
                for (int e = 0; e < 4; ++e) { q[2 * e] = (unsigned)__float2int_rn(bflo(w[e]) * inv[i]) & 255u; q[2 * e + 1] = (unsigned)__float2int_rn(bfhi(w[e]) * inv[i]) & 255u; }
                v2u o; o.x = q[0] | (q[1] << 8) | (q[2] << 16) | (q[3] << 24); o.y = q[4] | (q[5] << 8) | (q[6] << 16) | (q[7] << 24);
                __builtin_nontemporal_store(o, (GAS v2u*)(dst + pg8::blk_byte(r0[i], (kt[i] * 64 + C0 + 32 * h) >> 1, K >> 1))); } }
    }
}
__device__ __forceinline__ void sgu_phase(LAS unsigned char* lds, const bf16* UV, const bf16* WSB, const u64* lnsum, const u64* lnssq, const float* ln_g, const float* ln_b,
                                          const float* b_s, bf16* Z, float* out_sguv, int wave, int lane) {
    const int fr = lane & 15, fq = lane >> 4;
    LAS unsigned char* img = lds + wave * 17408;
    for (int uidx = blockIdx.x; uidx < 576; uidx += gridDim.x) {
        const bool samp = uidx >= 512;
        const int g = uidx & 7, chunk = samp ? ((uidx - 512) >> 3) : (uidx >> 3);
        const int row_base = samp ? MP + 32 * chunk : 128 * chunk, nrows = samp ? 32 : 128;
        const int cw = 512 * g + 64 * wave;
        {
            const int cp = lane & 7, c = cw + 8 * cp;
            const f32x4 g0 = *(const f32x4*)(ln_g + c), g1 = *(const f32x4*)(ln_g + c + 4), b0 = *(const f32x4*)(ln_b + c), b1 = *(const f32x4*)(ln_b + c + 4);
#pragma unroll 4
            for (int it = 0; it < nrows / 8; ++it) {
                const int j = it * 8 + (lane >> 3), row = row_base + j;
                const v4u raw = *(const v4u*)(UV + (size_t)row * NSGU + D + c);
                const float mean = (float)(long long)lnsum[row] * (FIX_INV / 4096.0f), ex2 = (float)lnssq[row] * (FIX_INV / 4096.0f);
                const float rstd = rsqrtf(fmaxf(ex2 - mean * mean, 0.f) + 1e-5f);
                f32x4 x0 = {bflo(raw.x), bfhi(raw.x), bflo(raw.y), bfhi(raw.y)}, x1 = {bflo(raw.z), bfhi(raw.z), bflo(raw.w), bfhi(raw.w)};
                x0 = (x0 - mean) * rstd * g0 + b0; x1 = (x1 - mean) * rstd * g1 + b1;
                if (samp) { float* op = out_sguv + (size_t)(row - MP) * D + c; *(f32x4*)op = x0; *(f32x4*)(op + 4) = x1; }
                LAS unsigned short* wp = (LAS unsigned short*)(img + (8 * cp) * 272 + j * 2);
#pragma unroll
                for (int i = 0; i < 4; ++i) { wp[i * 136] = (unsigned short)f2bf(x0[i]); wp[(4 + i) * 136] = (unsigned short)f2bf(x1[i]); }
            }
        }
        LDS_WAIT(); asm volatile("" ::: "memory");
        const int nmt = nrows >> 4, kmax = nrows >> 5;
        bf16x8 bfr[4][4];
#pragma unroll
        for (int nt = 0; nt < 4; ++nt)
#pragma unroll
            for (int ks = 0; ks < 4; ++ks) bfr[nt][ks] = (ks < kmax) ? *(const LAS bf16x8*)(img + (16 * nt + fr) * 272 + (32 * ks + 8 * fq) * 2) : (bf16x8){0, 0, 0, 0, 0, 0, 0, 0};
        const bf16* Wg = WSB + g * 16384;
#pragma unroll 2
        for (int mt = 0; mt < nmt; ++mt) {
            bf16x8 af[4];
#pragma unroll
            for (int ks = 0; ks < 4; ++ks) af[ks] = (ks < kmax) ? *(const bf16x8*)(Wg + (16 * mt + fr) * 128 + 32 * ks + 8 * fq) : (bf16x8){0, 0, 0, 0, 0, 0, 0, 0};
            f32x4 acc[4];
#pragma unroll
            for (int nt = 0; nt < 4; ++nt) acc[nt] = (f32x4){0.f, 0.f, 0.f, 0.f};
#pragma unroll
            for (int ks = 0; ks < 4; ++ks)
                if (ks < kmax) {
#pragma unroll
                    for (int nt = 0; nt < 4; ++nt) acc[nt] = __builtin_amdgcn_mfma_f32_16x16x32_bf16(bfr[nt][ks], af[ks], acc[nt], 0, 0, 0);
                }
            const int i = 16 * mt + fr; const float bias = b_s[g * 128 + i]; const size_t ro = (size_t)(row_base + i);
#pragma unroll
            for (int nt = 0; nt < 4; ++nt) {
                const int c = cw + 16 * nt + 4 * fq; const v2u uu = *(const v2u*)(UV + ro * NSGU + c);
                f32x4 z = {bflo(uu.x), bfhi(uu.x), bflo(uu.y), bfhi(uu.y)};
                { const pg8::f32x2 ga = pg8::gelu_pk((pg8::f32x2){z[0], z[1]}), gb = pg8::gelu_pk((pg8::f32x2){z[2], z[3]}); z = (f32x4){ga.x, ga.y, gb.x, gb.y}; }
                z = z * (acc[nt] + bias);
                v2u o; o.x = pk2(z[0], z[1]); o.y = pk2(z[2], z[3]); *(v2u*)(Z + ro * D + c) = o;
            }
        }
        LDS_WAIT(); asm volatile("" ::: "memory");
    }
}

__device__ __forceinline__ void attn_phase(LAS unsigned char* lds, const bf16* Q, const bf16* KB, const bf16* VB, const float* sinks, bf16* O, int tid, int wave, int lane) {
    const int fr = lane & 15, fq = lane >> 4;
    LAS unsigned char* Ks = lds; LAS unsigned char* Vt = lds + 27648;
    constexpr float LOG2E = 1.4426950408889634f;
    for (int uidx = blockIdx.x; uidx < 1088; uidx += gridDim.x) {
        int kvh, qbase, kbase, klo, khi, nmt;
        if (uidx < 1024) { kvh = uidx & 7; const int bc = uidx >> 3, c = bc & 63; qbase = bc * 64; kbase = qbase - 128; klo = c >= 2 ? 0 : (2 - c) * 64; khi = 192; nmt = 4; }
        else { const int s = uidx - 1024; kvh = s & 7; const int b = s >> 3; qbase = MP + 32 * b; kbase = MP + 160 * b; klo = 0; khi = 160; nmt = 2; }
        __syncthreads();
#pragma unroll
        for (int it = 0; it < 3; ++it) {
            const int p = tid + 512 * it, key = p >> 3, ch = p & 7;
            v4u kk = {0u, 0u, 0u, 0u}, vv = {0u, 0u, 0u, 0u};
            if (key >= klo && key < khi) { const size_t off = (size_t)(kbase + key) * 512 + kvh * 64 + ch * 8; kk = *(const v4u*)(KB + off); vv = *(const v4u*)(VB + off); }
            *(LAS v4u*)(Ks + key * 144 + ch * 16) = kk;
            LAS unsigned short* vp = (LAS unsigned short*)(Vt + (ch * 8) * 392 + key * 2);
            vp[0 * 196] = (unsigned short)(vv.x & 0xffffu); vp[1 * 196] = (unsigned short)(vv.x >> 16); vp[2 * 196] = (unsigned short)(vv.y & 0xffffu); vp[3 * 196] = (unsigned short)(vv.y >> 16);
            vp[4 * 196] = (unsigned short)(vv.z & 0xffffu); vp[5 * 196] = (unsigned short)(vv.z >> 16); vp[6 * 196] = (unsigned short)(vv.w & 0xffffu); vp[7 * 196] = (unsigned short)(vv.w >> 16);
        }
        __syncthreads();
        const int head = kvh * 8 + wave; const float sink = sinks[head];
        for (int mt = 0; mt < nmt; ++mt) {
            const int qrow = qbase + 16 * mt + fr;
            const bf16* qp = Q + (size_t)qrow * D + head * 64 + 8 * fq;
            const bf16x8 q0 = *(const bf16x8*)qp, q1 = *(const bf16x8*)(qp + 32);
            f32x4 s[12]; float mx = sink;
#pragma unroll
            for (int nt = 0; nt < 12; ++nt) {
                const LAS unsigned char* kp = Ks + (16 * nt + fr) * 144 + fq * 16;
                const bf16x8 k0 = *(const LAS bf16x8*)kp, k1 = *(const LAS bf16x8*)(kp + 64);
                f32x4 a = {0.f, 0.f, 0.f, 0.f};
                a = __builtin_amdgcn_mfma_f32_16x16x32_bf16(k0, q0, a, 0, 0, 0);
                a = __builtin_amdgcn_mfma_f32_16x16x32_bf16(k1, q1, a, 0, 0, 0);
                if (16 * nt < klo || 16 * nt >= khi) a = (f32x4){-1e30f, -1e30f, -1e30f, -1e30f};
                s[nt] = a; mx = fmaxf(mx, fmaxf(fmaxf(a[0], a[1]), fmaxf(a[2], a[3])));
            }
            mx = fmaxf(mx, __shfl_xor(mx, 16)); mx = fmaxf(mx, __shfl_xor(mx, 32));
            float l = 0.f;
#pragma unroll
            for (int nt = 0; nt < 12; ++nt) {
#pragma unroll
                for (int i = 0; i < 4; ++i) { const float e = __builtin_amdgcn_exp2f((s[nt][i] - mx) * LOG2E); s[nt][i] = e; l += e; }
            }
            l += __shfl_xor(l, 16); l += __shfl_xor(l, 32); l += __builtin_amdgcn_exp2f((sink - mx) * LOG2E);
            f32x4 o[4];
#pragma unroll
            for (int dt = 0; dt < 4; ++dt) o[dt] = (f32x4){0.f, 0.f, 0.f, 0.f};
#pragma unroll
            for (int s6 = 0; s6 < 6; ++s6) {
                const pg8::u32x4 pw = pg8::pack8(s[2 * s6], s[2 * s6 + 1]); const bf16x8 pf = __builtin_bit_cast(bf16x8, pw);
#pragma unroll
                for (int dt = 0; dt < 4; ++dt) {
                    const LAS unsigned char* vp = Vt + (16 * dt + fr) * 392 + (32 * s6 + 4 * fq) * 2;
                    const v2u lo = *(const LAS v2u*)vp, hi = *(const LAS v2u*)(vp + 32);
                    const v4u vw = {lo.x, lo.y, hi.x, hi.y};
                    o[dt] = __builtin_amdgcn_mfma_f32_16x16x32_bf16(__builtin_bit_cast(bf16x8, vw), pf, o[dt], 0, 0, 0);
                }
            }
            const float inv = 1.0f / l; bf16* op = O + (size_t)qrow * D + head * 64 + 4 * fq;
#pragma unroll
            for (int dt = 0; dt < 4; ++dt) { v2u w; w.x = pg8::cvt_pk_bf16(o[dt][0] * inv, o[dt][1] * inv); w.y = pg8::cvt_pk_bf16(o[dt][2] * inv, o[dt][3] * inv); *(v2u*)(op + 16 * dt) = w; }
        }
    }
}

template <class Epi>
__device__ __forceinline__ void tail_phase(LAS unsigned char* lds, const bf16* A, const bf16* Bt, int K, int nN, int pn_off, unsigned* qhead, const Epi& E, int tid, int wave, int lane, int ablk = 0, int bblk = 1) {
    constexpr int PITCH = 528, OPB = 64 * PITCH, BUFB = 2 * OPB;
    const int fr = lane & 15, fq = lane >> 4;
    const int nc = (K + 255) >> 8;
    LAS float* part = (LAS float*)(lds + wave * 17408);
    const int row_l = tid >> 3, cg = tid & 7;
    const int colA = Epi::TAIL_SPLIT ? 4 * cg : 8 * cg, colB = Epi::TAIL_SPLIT ? 32 + 4 * cg : 8 * cg + 4;
    const int lr = tid >> 5, lc = tid & 31;
    volatile LAS unsigned* tick = (volatile LAS unsigned*)(lds + MISC_OFF + 64);
    const int cnt = nN * 2;
    int xq = (int)(xb_xcc_id() & 7u), tries = 0;
    unsigned nextj = 0u;
    if (tid == 0) nextj = __hip_atomic_fetch_add(qhead + 16 * xq, 1u, __ATOMIC_RELAXED, __HIP_MEMORY_SCOPE_AGENT);
    for (;;) {
        if (tid == 0) tick[0] = nextj;
        __syncthreads();
        const int j = (int)tick[0];
        __syncthreads();
        if (j >= cnt) { if (++tries == 8) break; xq = (xq + 1) & 7; if (tid == 0) nextj = __hip_atomic_fetch_add(qhead + 16 * xq, 1u, __ATOMIC_RELAXED, __HIP_MEMORY_SCOPE_AGENT); continue; }
        tries = 0;
        if (tid == 0) nextj = __hip_atomic_fetch_add(qhead + 16 * xq, 1u, __ATOMIC_RELAXED, __HIP_MEMORY_SCOPE_AGENT);
        const int p = ((8 * (j >> 2) + xq) << 2) + (j & 3) + 16 * pn_off;
        const int rq = p & 3, q = (p >> 2) & 3, pn = p >> 4;
        typedef typename Epi::AccT AccT; AccT acc[4][4];
#pragma unroll
        for (int nb = 0; nb < 4; ++nb)
#pragma unroll
            for (int mb = 0; mb < 4; ++mb) acc[nb][mb] = (AccT){0, 0, 0, 0};
        const size_t a16 = ablk ? 1024 : (size_t)16 * K, achs = ablk ? 65536 : 256, b16 = bblk ? 1024 : (size_t)16 * K, b128 = bblk ? 8192 : (size_t)128 * K, bchs = bblk ? 65536 : 256;
        const bf16* ag = ablk ? (const bf16*)((const char*)A + pg8::blk_byte(MP + 64 * rq + lr, 8 * lc, K)) : A + (size_t)(MP + 64 * rq + lr) * K + 8 * lc;
        const bf16* bg = bblk ? (const bf16*)((const char*)Bt + pg8::blk_byte(256 * pn + 32 * q + (lr & 31), 8 * lc, K)) : Bt + (size_t)(256 * pn + 32 * q + (lr & 31)) * K + 8 * lc;
        v4u a0[4], b0[4], a1[4], b1[4];
#define TL_LOAD(ra, rb, c) do { const int cc_ = (c) < nc ? (c) : nc - 1; _Pragma("unroll") for (int i = 0; i < 4; ++i) { \
            const bool in_ = 256 * cc_ + 8 * lc < K; const v4u z_ = {0u, 0u, 0u, 0u}; const size_t ao_ = in_ ? achs * cc_ : 0, bo_ = in_ ? bchs * cc_ : 0; \
            ra[i] = *(const v4u*)(ag + a16 * i + ao_); rb[i] = *(const v4u*)(bg + b16 * (i & 1) + b128 * (i >> 1) + bo_); if (!in_) { ra[i] = z_; rb[i] = z_; } } } while (0)
#define TL_WRITE(ra, rb, b) do { LAS unsigned char* d_ = lds + (b) * BUFB + lr * PITCH + lc * 16; _Pragma("unroll") for (int i = 0; i < 4; ++i) { \
            *(LAS v4u*)(d_ + 16 * i * PITCH) = ra[i]; *(LAS v4u*)(d_ + OPB + 16 * i * PITCH) = rb[i]; } } while (0)
#define TL_BAR() do { asm volatile("s_waitcnt lgkmcnt(0)" ::: "memory"); __builtin_amdgcn_s_barrier(); asm volatile("" ::: "memory"); } while (0)
#define TL_STEP(c, la, lb, wa, wb) do { TL_LOAD(la, lb, (c) + 2); TL_BAR(); \
            const LAS unsigned char* fb = lds + ((c) & 1) * BUFB + fr * PITCH + (32 * wave + 8 * fq) * 2; bf16x8 fa[4], fbv[4]; \
            _Pragma("unroll") for (int i = 0; i < 4; ++i) { fa[i] = *(const LAS bf16x8*)(fb + 16 * i * PITCH); fbv[i] = *(const LAS bf16x8*)(fb + OPB + 16 * i * PITCH); } \
            _Pragma("unroll") for (int nb = 0; nb < 4; ++nb) _Pragma("unroll") for (int mb = 0; mb < 4; ++mb) acc[nb][mb] = pg8::mma16(fbv[nb], fa[mb], acc[nb][mb]); \
            TL_WRITE(wa, wb, ((c) + 1) & 1); } while (0)
        TL_LOAD(a0, b0, 0); TL_LOAD(a1, b1, 1); TL_WRITE(a0, b0, 0);
        int c = 0;
        for (; c + 1 < nc; c += 2) { TL_STEP(c, a0, b0, a1, b1); TL_STEP(c + 1, a1, b1, a0, b0); }
        if (c < nc) TL_STEP(c, a0, b0, a1, b1);
#undef TL_STEP
#undef TL_BAR
#undef TL_LOAD
#undef TL_WRITE
        asm volatile("s_waitcnt vmcnt(0)" ::: "memory"); __syncthreads();
#pragma unroll
        for (int nb = 0; nb < 4; ++nb)
#pragma unroll
            for (int mb = 0; mb < 4; ++mb) *(LAS pg8::f32x4*)(part + (16 * mb + fr) * 68 + 16 * nb + 4 * fq) = __builtin_convertvector(acc[nb][mb], pg8::f32x4);
        __syncthreads();
        pg8::f32x4 v0 = {0.f, 0.f, 0.f, 0.f}, v1 = {0.f, 0.f, 0.f, 0.f};
#pragma unroll
        for (int w = 0; w < 8; ++w) { const LAS float* t = (const LAS float*)(lds + w * 17408) + row_l * 68; v0 += *(const LAS pg8::f32x4*)(t + colA); v1 += *(const LAS pg8::f32x4*)(t + colB); }
        E.tail(MP + 64 * rq + row_l, cg, pn, q, v0, v1);
        __syncthreads();
    }
}

#ifndef CONV_SPREAD
#define CONV_SPREAD 0
#endif
#ifndef PROBE_PH
#define PROBE_PH (-1)
#endif
#ifndef PROBE_MUL
#define PROBE_MUL 3
#endif
#ifndef NCONV
#define NCONV 80
#endif
#ifndef NCONV4
#define NCONV4 16
#endif
#ifndef NCONV6
#define NCONV6 24
#endif
#ifndef SAMPLE_MAIN_GU
#define SAMPLE_MAIN_GU 64
#endif
__device__ __forceinline__ void pr_begin(int k, long long& t0) { if (PROBE_PH >= 0 && k == PROBE_PH) { __syncthreads(); t0 = (long long)wall_clock64(); } }
__device__ __forceinline__ void pr_end(int k, long long t0) {
    if (PROBE_PH >= 0 && k == PROBE_PH) { __syncthreads(); const long long t1 = (long long)wall_clock64(), te = t1 + (long long)PROBE_MUL * (t1 - t0);
        while ((long long)wall_clock64() < te) __builtin_amdgcn_s_sleep(16);
        __syncthreads(); }
}
__global__ void __launch_bounds__(NWAVES * 64, 2) yoco_fwd(Args args) {
    extern __shared__ __attribute__((aligned(16))) unsigned char lds_raw[];
    LAS unsigned char* lds = (LAS unsigned char*)lds_raw;
    const int tid = threadIdx.x, lane = tid & 63, wave = __builtin_amdgcn_readfirstlane(tid >> 6);
    const int G = gridDim.x, bx = blockIdx.x, vcu = (G % 8 == 0) ? (bx % 8) * (G / 8) + bx / 8 : bx;
    unsigned char* ws = args.ws;
    for (int u = tid; u < (LDS_BYTES - LDSCTL_OFF) / 4; u += NWAVES * 64) ((LAS unsigned*)(lds + LDSCTL_OFF))[u] = 0u;
    __syncthreads();
    volatile LAS unsigned* MISC = (volatile LAS unsigned*)(lds + MISC_OFF);
    XcdBarrier bar; bar.bar = (unsigned*)ws + CW_BAR; bar.x = 0; bar.st = nullptr;
    if (MK_ONE_LAUNCH) bar = xcd_barrier_post((unsigned*)ws + CW_BAR, MISC + 8);
    const int lo = args.ph_lo, hi = args.ph_hi;
    long long pr_t0 = 0;
#define IN(k) (pr_begin((k), pr_t0), lo <= (k) && (k) < hi)
#define SEAM(k) do { pr_end((k), pr_t0); if (MK_ONE_LAUNCH && IN((k) + 1)) xcd_barrier(bar); } while (0)
    bf16* const W1T = (bf16*)(ws + WS_W1T); bf16* const W2T = (bf16*)(ws + WS_W2T); bf16* const WGU0 = (bf16*)(ws + WS_WGU0); bf16* const WD0 = (bf16*)(ws + WS_WD0);
    bf16* const WQKV = (bf16*)(ws + WS_WQKV); bf16* const WOT = (bf16*)(ws + WS_WOT); bf16* const WGU1 = (bf16*)(ws + WS_WGU1); bf16* const WD1 = (bf16*)(ws + WS_WD1);
    bf16* const XB = (bf16*)(ws + WS_XB); bf16* const ACT = (bf16*)(ws + WS_ACT); bf16* const UV = (bf16*)(ws + WS_ACT);
    bf16* const ZQ = (bf16*)(ws + WS_ZQ); bf16* const OB = (bf16*)(ws + WS_O); bf16* const KB = (bf16*)(ws + WS_KB); bf16* const VB = (bf16*)(ws + WS_VB); bf16* const WSB = (bf16*)(ws + WS_WSB);
    unsigned char* const A8 = ws + WS_H; float* const rowscale = (float*)(ws + RS_OFF); const float* const cmax0 = (const float*)(ws + CM_OFF); const float* const cmax1 = (const float*)(ws + CM_OFF + CM_STRIDE);
    unsigned* const qheads = (unsigned*)ws + CW_Q;
    u64* const ssq_x = (u64*)(ws + ST_OFF); u64* const lnsum = (u64*)(ws + ST_OFF + ST_STRIDE); u64* const lnssq = (u64*)(ws + ST_OFF + 2 * ST_STRIDE);
    u64* const ssq_h1 = (u64*)(ws + ST_OFF + 3 * ST_STRIDE); u64* const ssq_h2 = (u64*)(ws + ST_OFF + 4 * ST_STRIDE); u64* const ssq_h3 = (u64*)(ws + ST_OFF + 5 * ST_STRIDE);

    const bool split = (G == 256) && (NCONV > 0);
    const int nconv = split ? NCONV : 0, ncomp = G - nconv, nconv4 = (split && CONV_SPREAD) ? NCONV4 : 0, nconv6 = (split && CONV_SPREAD) ? NCONV6 : 0;
    const int items_p1 = (split && CONV_SPREAD) ? P0_ITEMS_P1 : P0_ITEMS_ALL;
    if (IN(0)) { absmax_pass(args, ws, vcu * NWAVES + wave, G * NWAVES, lane); if (!split && MK_ONE_LAUNCH) xcd_barrier(bar);
                 p0_prologue(args, ws, lds, vcu * NWAVES + wave, G * NWAVES, 0, split ? P0_ITEMS_A : P0_ITEMS_ALL, 1, wave, lane); SEAM(0); }
    if (IN(1)) {
        if (bx >= ncomp) { p0_prologue(args, ws, lds, (bx - ncomp) * NWAVES + wave, nconv * NWAVES, P0_ITEMS_A, items_p1, 0, wave, lane); __syncthreads(); }
        pg8::Gemm g{XB, W1T, MP, NSGU, D, 0, 1}; pg8::SplitOrder S; S.init(MP, NSGU, G, bx); S.nblk = ncomp; S.nhalf = 16; S.nextra = 0;
        pg8::EpiSguIn E{UV, ssq_x, lnsum, lnssq};
        pg8::gemm_phase<pg8::EpiSguIn, pg8::SplitOrder, PG8_ALIGN, PG8_SP2>(lds, g, S, E);
        tail_phase(lds, XB, W1T, D, 32, 0, qheads + 0 * 128, E, tid, wave, lane);
        SEAM(1);
    }
    if (IN(2)) { sgu_phase(lds, UV, WSB, lnsum, lnssq, args.in[6], args.in[7], args.in[9], ZQ, args.out + pg8::OUT_SGUV, wave, lane); SEAM(2); }
    if (IN(3)) {
        pg8::Gemm g{ZQ, W2T, MP, D, D, 0, 1}; pg8::StaticOrder S; S.init(MP, D, G, bx);
        pg8::EpiRes<false, true, false> E{nullptr, nullptr, nullptr, XB, ssq_h1};
        pg8::gemm_phase<pg8::EpiRes<false, true, false>, pg8::StaticOrder, PG8_ALIGN, PG8_SP2>(lds, g, S, E);
        tail_phase(lds, ZQ, W2T, D, 16, 0, qheads + 1 * 128, E, tid, wave, lane);
        SEAM(3);
    }
    if (IN(4)) { quant_rows(XB, ssq_h1, A8, rowscale, vcu * NWAVES + wave, G * NWAVES, lane); SEAM(4); }
    if (IN(5)) {
        if (bx >= G - nconv4) { p0_prologue(args, ws, lds, (bx - (G - nconv4)) * NWAVES + wave, nconv4 * NWAVES, P0_ITEMS_P1, P0_ITEMS_P4, 0, wave, lane); __syncthreads(); }
        pg8::Gemm g{(const bf16*)A8, WGU0, M, NGU, D / 2, 0, 1}; pg8::SplitOrder S; S.init(MP, NGU, G, bx); S.nblk = G - nconv4; S.nhalf = 0; S.nextra = SAMPLE_MAIN_GU;
        pg8::EpiSwigluI8 E{ACT, rowscale, cmax0};
        pg8::gemm_phase<pg8::EpiSwigluI8, pg8::SplitOrder, PG8_ALIGN, PG8_SP2>(lds, g, S, E);
        tail_phase(lds, (const bf16*)A8, WGU0, D / 2, 86 - SAMPLE_MAIN_GU, SAMPLE_MAIN_GU, qheads + 2 * 128, E, tid, wave, lane);
        SEAM(5);
    }
    if (IN(6)) {
        pg8::Gemm g{ACT, WD0, MP, D, DFF, 1, 1}; pg8::StaticOrder S; S.init(MP, D, G, bx);
        pg8::EpiRes<false, true, false> E{nullptr, nullptr, nullptr, XB, ssq_h2};
        pg8::gemm_phase<pg8::EpiRes<false, true, false>, pg8::StaticOrder, PG8_ALIGN, PG8_SP2>(lds, g, S, E);
        tail_phase(lds, ACT, WD0, DFF, 16, 0, qheads + 3 * 128, E, tid, wave, lane, 1, 1);
        SEAM(6);
    }
    if (IN(7)) { quant_rows(XB, ssq_h2, A8, rowscale, vcu * NWAVES + wave, G * NWAVES, lane); SEAM(7); }
    if (IN(8)) {
        { pg8::Gemm g{XB, WQKV, MP, 1024, D, 0, 1}; pg8::SplitOrder S; S.init(MP, 1024, G, bx); S.nblk = (G == 256) ? 128 : G; S.nhalf = 0; S.nextra = 0;
          pg8::EpiQKV E{KB, VB, ZQ, args.out, ssq_h2, args.in[13], args.in[16], nullptr, nullptr};
          pg8::gemm_phase<pg8::EpiQKV, pg8::SplitOrder, PG8_ALIGN, PG8_SP2>(lds, g, S, E); }
        { pg8::Gemm g{(const bf16*)A8, (const bf16*)(ws + WS_WQKV + WQ8_SHIFT), MP, 4096, D / 2, 0, 1}; pg8::QOrder S; S.init(MP, 4096, G, bx);
          pg8::EpiQKVT<true> E{KB, VB, ZQ, args.out, ssq_h2, args.in[13], args.in[16], rowscale, (const float*)(ws + CMQ_OFF)};
          pg8::gemm_phase<pg8::EpiQKVT<true>, pg8::QOrder, PG8_ALIGN, PG8_SP2>(lds, g, S, E);
          tail_phase(lds, (const bf16*)A8, (const bf16*)(ws + WS_WQKV + WQ8_SHIFT), D / 2, 16, 4, qheads + 8 * 128, E, tid, wave, lane); }
        { pg8::EpiQKV E{KB, VB, ZQ, args.out, ssq_h2, args.in[13], args.in[16], nullptr, nullptr};
          tail_phase(lds, XB, WQKV, D, 4, 0, qheads + 4 * 128, E, tid, wave, lane); }
        SEAM(8);
    }
    if (IN(9)) { attn_phase(lds, ZQ, KB, VB, args.in[17], OB, tid, wave, lane); SEAM(9); }
    if (IN(10)) { quant_rows(OB, nullptr, A8, rowscale, vcu * NWAVES + wave, G * NWAVES, lane); SEAM(10); }
    if (IN(11)) {
        pg8::Gemm g{(const bf16*)A8, WOT, MP, D, D / 2, 0, 1}; pg8::StaticOrder S; S.init(MP, D, G, bx);
        pg8::EpiRes<false, true, false, true> E{nullptr, nullptr, nullptr, XB, ssq_h3, rowscale, (const float*)(ws + CMO_OFF)};
        pg8::gemm_phase<pg8::EpiRes<false, true, false, true>, pg8::StaticOrder, PG8_ALIGN, PG8_SP2>(lds, g, S, E);
        tail_phase(lds, (const bf16*)A8, WOT, D / 2, 16, 0, qheads + 5 * 128, E, tid, wave, lane);
        SEAM(11);
    }
    if (IN(12)) { quant_rows(XB, ssq_h3, A8, rowscale, vcu * NWAVES + wave, G * NWAVES, lane); SEAM(12); }
    if (IN(13)) {
        if (bx >= G - nconv4) { p0_prologue(args, ws, lds, (bx - (G - nconv4)) * NWAVES + wave, nconv4 * NWAVES, P0_ITEMS_P6, P0_ITEMS_ALL, 0, wave, lane); __syncthreads(); }
        pg8::Gemm g{(const bf16*)A8, WGU1, M, NGU, D / 2, 0, 1}; pg8::SplitOrder S; S.init(MP, NGU, G, bx); S.nblk = G - nconv4; S.nhalf = 0; S.nextra = SAMPLE_MAIN_GU;
        pg8::EpiSwigluI8 E{ACT, rowscale, cmax1};
        pg8::gemm_phase<pg8::EpiSwigluI8, pg8::SplitOrder, PG8_ALIGN, PG8_SP2>(lds, g, S, E);
        tail_phase(lds, (const bf16*)A8, WGU1, D / 2, 86 - SAMPLE_MAIN_GU, SAMPLE_MAIN_GU, qheads + 6 * 128, E, tid, wave, lane);
        SEAM(13);
    }
    if (IN(14)) { actq_rows(ACT, ws + WS_ACT8, rowscale, vcu * NWAVES + wave, G * NWAVES, lane);
                  requant_w((const unsigned char*)WD1, (const float*)(ws + CMD_OFF), ws + WS_WD8, DFF, D, vcu * NWAVES + wave, G * NWAVES, lane); SEAM(14); }
    if (IN(15)) {
        pg8::Gemm g{(const bf16*)(ws + WS_ACT8), (const bf16*)(ws + WS_WD8), MP, D, DFF / 2, 1, 1}; pg8::StaticOrder S; S.init(MP, D, G, bx);
        pg8::EpiRes<false, false, true, true> E{nullptr, nullptr, args.out, XB, nullptr, rowscale, (const float*)(ws + CMD_OFF)};
        pg8::gemm_phase<pg8::EpiRes<false, false, true, true>, pg8::StaticOrder, PG8_ALIGN, PG8_SP2>(lds, g, S, E);
        tail_phase(lds, (const bf16*)(ws + WS_ACT8), (const bf16*)(ws + WS_WD8), DFF / 2, 16, 0, qheads + 7 * 128, E, tid, wave, lane, 1, 1);
        pr_end(15, pr_t0);
    }
#undef IN
#undef SEAM
}

extern "C" void kernel_launch(void* const* d_in, const int* in_sizes, int n_in, void* d_out, int out_size, void* d_ws, size_t ws_size, hipStream_t stream) {
    static int grid = 0;
    if (grid == 0) {
        if (n_in != 23 || in_sizes[0] != MP * D || out_size != 36175872 || ws_size < WS_END) {
            fprintf(stderr, "kernel_launch: unexpected shapes (n_in %d, in0 %d, out %d, ws %zu); nothing launched\n", n_in, n_in > 0 ? in_sizes[0] : -1, out_size, ws_size); grid = -1; return; }
        int dev = 0, cus = 0, per_cu = 0;
        if (hipGetDevice(&dev) != hipSuccess || hipDeviceGetAttribute(&cus, hipDeviceAttributeMultiprocessorCount, dev) != hipSuccess) { fprintf(stderr, "kernel_launch: device query failed\n"); grid = -1; return; }
        if (hipFuncSetAttribute((const void*)yoco_fwd, hipFuncAttributeMaxDynamicSharedMemorySize, LDS_BYTES) != hipSuccess) { fprintf(stderr, "kernel_launch: hipFuncSetAttribute failed\n"); grid = -1; return; }
        if (hipOccupancyMaxActiveBlocksPerMultiprocessor(&per_cu, (const void*)yoco_fwd, NWAVES * 64, LDS_BYTES) != hipSuccess || per_cu < 1)
            fprintf(stderr, "kernel_launch: note: occupancy query reports %d workgroups per CU\n", per_cu);
        (void)hipGetLastError();
        grid = cus;
    }
    if (grid < 0) return;
    if (hipMemsetAsync((char*)d_ws + WS_CTL, 0, CTL_ZERO_BYTES, stream) != hipSuccess) { fprintf(stderr, "kernel_launch: memset failed\n"); return; }
    Args a{};
    for (int i = 0; i < 23; ++i) a.in[i] = (const float*)d_in[i];
    a.out = (float*)d_out; a.ws = (unsigned char*)d_ws;
#if MK_ONE_LAUNCH
    a.ph_lo = 0; a.ph_hi = NPHASES;
    hipLaunchKernelGGL(yoco_fwd, dim3(grid), dim3(NWAVES * 64), LDS_BYTES, stream, a);
#else
    for (int p = 0; p < NPHASES; ++p) { a.ph_lo = p; a.ph_hi = p + 1; hipLaunchKernelGGL(yoco_fwd, dim3(grid), dim3(NWAVES * 64), LDS_BYTES, stream, a); }
#endif
    const hipError_t le = hipPeekAtLastError();
    if (le != hipSuccess) fprintf(stderr, "kernel_launch: launch failed: %s\n", hipGetErrorName(le));
}
```

```cpp
#include <hip/hip_runtime.h>
#include <cstdio>
#include <cstdint>
#define MK_ONE_LAUNCH 1
namespace pg8 {
#define PG8_LAS __attribute__((address_space(3)))
typedef unsigned short bf16_t;
typedef short bf16x8 __attribute__((ext_vector_type(8)));
typedef float f32x4 __attribute__((ext_vector_type(4)));
typedef unsigned u32x4 __attribute__((ext_vector_type(4)));
constexpr int BM = 256, BK = 64, HALF = 128, HTB = HALF * BK * 2  , STAGE_BYTES = 8 * HTB, NXCD = 8, WGM = 8;

__host__ __device__ __forceinline__ int lds_byte(int r, int c) { const int st = (r >> 4) * 2 + (c >> 5), rr = r & 15, cc = c & 31, ob = rr * 64 + cc * 2; return st * 1024 + (ob ^ (((ob >> 9) & 1) << 5)); }
__host__ __device__ __forceinline__ void stage_rc(int b, int& R, int& C) { const int st = b / 1024, sb = b % 1024, swz = sb ^ (((sb >> 9) & 1) << 5); R = (st >> 1) * 16 + swz / 64; C = (st & 1) * 32 + (swz % 64) / 2; }
__host__ __device__ __forceinline__ int perm32(int rho) { const int n = rho >> 4, i = rho & 15; return 8 * (i >> 2) + 4 * n + (i & 3); }

struct Unit { int pm, pn; };
struct Gemm { const bf16_t* A; const bf16_t* Bt; int M, N, K; int ablk, bblk; };
__host__ __device__ __forceinline__ size_t blk_byte(int r, int k, int K) { return (size_t)(r >> 8) * K * 512 + (size_t)(k >> 6) * 32768 + ((r >> 7) & 1) * 16384 + lds_byte(r & 127, k & 63); }

struct StaticOrder {
    int nM, nN, nwg, G, c;
    __host__ __device__ void init(int M, int N, int G_, int c_) { nM = M / BM; nN = N / BM; nwg = nM * nN; G = G_; c = c_; }
    __host__ __device__ bool next(int i, Unit& u) const {
        const long L = (long)i * G + c; if (L >= nwg) return false;
        int wgid = (int)L; { const int q = nwg / NXCD, r = nwg % NXCD, xcd = wgid % NXCD, off = wgid / NXCD; wgid = (xcd < r ? xcd * (q + 1) : r * (q + 1) + (xcd - r) * q) + off; }
        const int nig = WGM * nN, gid = wgid / nig, fm = gid * WGM, gsz = (nM - fm) < WGM ? (nM - fm) : WGM;
        u.pm = fm + ((wgid % nig) % gsz); u.pn = (wgid % nig) / gsz; return true;
    }
    __device__ __forceinline__ void a_ready(const Unit&) const {}
    __device__ __forceinline__ void done(const Unit&) const {}
};

__device__ __forceinline__ unsigned cvt_pk_bf16(float lo, float hi) { unsigned r; asm volatile("v_cvt_pk_bf16_f32 %0, %1, %2" : "=v"(r) : "v"(lo), "v"(hi)); return r; }
typedef float f32x2 __attribute__((ext_vector_type(2)));
__device__ __forceinline__ f32x2 gelu_pk(f32x2 v) {
    const f32x2 av = __builtin_elementwise_abs(v), d = av * 0.2316418882f + 1.0f;
    f32x2 t; t.x = __builtin_amdgcn_rcpf(d.x); t.y = __builtin_amdgcn_rcpf(d.y);
    f32x2 q = t * 0.5307027145f + (-0.7265760135f); q = q * t + 0.7107068705f; q = q * t + (-0.142248368f); q = q * t + 0.127414796f; q = q * t;
    const f32x2 s = (v * v) * (-0.72134752044f);
    f32x2 e; e.x = __builtin_amdgcn_exp2f(s.x); e.y = __builtin_amdgcn_exp2f(s.y);
    const f32x2 m = v * (q * e), r = v - m;
    f32x2 o; o.x = v.x < 0.f ? m.x : r.x; o.y = v.y < 0.f ? m.y : r.y; return o;
}


struct SplitOrder : StaticOrder {
    int nblk; int nhalf; int nextra;
    __device__ bool next(int i, Unit& u) const {
        if (c >= nblk) return false;
        const long L = (long)i * nblk + c; if (L >= nwg + nextra) return false;
        if (L >= nwg) { u.pm = 32; u.pn = (int)(L - nwg); return true; }
        int wgid = (int)L; { const int q = nwg / NXCD, r = nwg % NXCD, xcd = wgid % NXCD, off = wgid / NXCD; wgid = (xcd < r ? xcd * (q + 1) : r * (q + 1) + (xcd - r) * q) + off; }
        const int nig = WGM * nN, gid = wgid / nig, fm = gid * WGM, gsz = (nM - fm) < WGM ? (nM - fm) : WGM;
        u.pm = fm + ((wgid % nig) % gsz); u.pn = (wgid % nig) / gsz; if (nhalf) u.pn = (u.pn & 1) * nhalf + (u.pn >> 1); return true;
    }
};
typedef unsigned long long u64;
constexpr float FIX_SCALE = 16777216.0f, FIX_INV = 1.0f / 16777216.0f;
__device__ __forceinline__ u64 f2fixu(float v) { return (u64)(v * FIX_SCALE); }
__device__ __forceinline__ u64 f2fixs(float v) { return (u64)(long long)(v * FIX_SCALE); }
__device__ __forceinline__ void fix_add(u64* p, u64 v) { (void)__hip_atomic_fetch_add(p, v, __ATOMIC_RELAXED, __HIP_MEMORY_SCOPE_AGENT); }
__device__ __forceinline__ float rstd_of(const u64* ssq, int row) { return rsqrtf((float)ssq[row] * (FIX_INV * (1.0f / 4096.0f)) + 1e-6f); }
__device__ __forceinline__ float sum4(const f32x4& v) { return (v[0] + v[1]) + (v[2] + v[3]); }
__device__ __forceinline__ float ssq4(const f32x4& v) { return (v[0] * v[0] + v[1] * v[1]) + (v[2] * v[2] + v[3] * v[3]); }
__device__ __forceinline__ u32x4 pack8(const f32x4& a, const f32x4& b) { u32x4 w; w.x = cvt_pk_bf16(a[0], a[1]); w.y = cvt_pk_bf16(a[2], a[3]); w.z = cvt_pk_bf16(b[0], b[1]); w.w = cvt_pk_bf16(b[2], b[3]); return w; }

template <bool I8> struct AccSel { typedef f32x4 T; };
template <> struct AccSel<true> { typedef int T __attribute__((ext_vector_type(4))); };
struct EpiSguIn {
    typedef f32x4 AccT;
    static constexpr bool PERM = true, AFTER_DRAIN = false;
    bf16_t* UV; const u64* ssq; u64* lnsum; u64* lnssq;
    __device__ __forceinline__ void operator()(const f32x4 (&acc)[2][2][4][2], const Unit& u, int wr, int wc, int fr, int fq) const {
        const int row0 = u.pm * BM + wr * 64 + fr, col0 = u.pn * BM + wc * 32 + 8 * fq;
        const bool isv = u.pn >= 16;
        float rs[2][4];
#pragma unroll
        for (int ai = 0; ai < 2; ++ai)
#pragma unroll
            for (int m = 0; m < 4; ++m) rs[ai][m] = rstd_of(ssq, row0 + ai * HALF + m * 16);
#pragma unroll
        for (int ai = 0; ai < 2; ++ai)
#pragma unroll
            for (int m = 0; m < 4; ++m) {
                const int row = row0 + ai * HALF + m * 16;
                float s1 = 0.f, s2 = 0.f;
                bf16_t* rowp = UV + (size_t)row * 8192 + col0;
#pragma unroll
                for (int bj = 0; bj < 2; ++bj) {
                    f32x4 v0 = acc[ai][bj][m][0] * rs[ai][m], v1 = acc[ai][bj][m][1] * rs[ai][m];
                    if (isv) {
                        const f32x2 a = gelu_pk((f32x2){v0[0], v0[1]}), b = gelu_pk((f32x2){v0[2], v0[3]}), c = gelu_pk((f32x2){v1[0], v1[1]}), d = gelu_pk((f32x2){v1[2], v1[3]});
                        v0 = (f32x4){a.x, a.y, b.x, b.y}; v1 = (f32x4){c.x, c.y, d.x, d.y};
                        s1 += sum4(v0) + sum4(v1); s2 += ssq4(v0) + ssq4(v1); }
                    *(u32x4*)(rowp + bj * HALF) = pack8(v0, v1);
                }
                if (isv) {
                    s1 += __shfl_xor(s1, 16); s1 += __shfl_xor(s1, 32); s2 += __shfl_xor(s2, 16); s2 += __shfl_xor(s2, 32);
                    if (fq == 0) { fix_add(lnsum + row, f2fixs(s1)); fix_add(lnssq + row, f2fixu(s2)); }
                }
            }
    }
    static constexpr bool TAIL_SPLIT = false;
    __device__ __forceinline__ void tail(int row, int cg, int pn, int q, f32x4 v0, f32x4 v1) const {
        const int col = pn * BM + (cg >> 2) * HALF + q * 32 + 8 * (cg & 3);
        const float rs = rstd_of(ssq, row);
        v0 = v0 * rs; v1 = v1 * rs;
        if (pn >= 16) { const f32x2 a = gelu_pk((f32x2){v0[0], v0[1]}), b = gelu_pk((f32x2){v0[2], v0[3]}), c = gelu_pk((f32x2){v1[0], v1[1]}), d = gelu_pk((f32x2){v1[2], v1[3]});
            v0 = (f32x4){a.x, a.y, b.x, b.y}; v1 = (f32x4){c.x, c.y, d.x, d.y}; }
        *(u32x4*)(UV + (size_t)row * 8192 + col) = pack8(v0, v1);
        if (pn >= 16) {
            float s1 = sum4(v0) + sum4(v1), s2 = ssq4(v0) + ssq4(v1);
            s1 += __shfl_xor(s1, 1); s1 += __shfl_xor(s1, 2); s1 += __shfl_xor(s1, 4); s2 += __shfl_xor(s2, 1); s2 += __shfl_xor(s2, 2); s2 += __shfl_xor(s2, 4);
            if (cg == 0) { fix_add(lnsum + row, f2fixs(s1)); fix_add(lnssq + row, f2fixu(s2)); }
        }
    }
};
template <bool RES_F32, bool XBOUT, bool OUT_F32, bool I8 = false> struct EpiRes {
    typedef typename AccSel<I8>::T AccT;
    static constexpr bool PERM = true, AFTER_DRAIN = false;
    const float* res; const float* res_hi; float* out; bf16_t* XB; u64* ssq_out; const float* rowscale; const float* cmo;
    __device__ __forceinline__ static f32x4 lo4(const u32x4& w) { return (f32x4){__builtin_bit_cast(float, w.x << 16), __builtin_bit_cast(float, w.x & 0xffff0000u), __builtin_bit_cast(float, w.y << 16), __builtin_bit_cast(float, w.y & 0xffff0000u)}; }
    __device__ __forceinline__ static f32x4 hi4(const u32x4& w) { return (f32x4){__builtin_bit_cast(float, w.z << 16), __builtin_bit_cast(float, w.z & 0xffff0000u), __builtin_bit_cast(float, w.w << 16), __builtin_bit_cast(float, w.w & 0xffff0000u)}; }
    __device__ __forceinline__ void operator()(const AccT (&acc)[2][2][4][2], const Unit& u, int wr, int wc, int fr, int fq) const {
        const int row0 = u.pm * BM + wr * 64 + fr, col0 = u.pn * BM + wc * 32 + 8 * fq;
        const float* rbase = u.pm < 32 ? res : res_hi;
#pragma unroll
        for (int ai = 0; ai < 2; ++ai) {
            f32x4 cw[2][2];
#pragma unroll
            for (int bj = 0; bj < 2; ++bj)
#pragma unroll
                for (int n = 0; n < 2; ++n) cw[bj][n] = I8 ? *(const f32x4*)(cmo + col0 + bj * HALF + 4 * n) * (1.0f / 127.0f) : (f32x4){1.f, 1.f, 1.f, 1.f};
            f32x4 r[RES_F32 ? 4 : 1][2][2]; u32x4 rw[4][2]; float rsv[4];
#pragma unroll
            for (int m = 0; m < 4; ++m) rsv[m] = I8 ? rowscale[row0 + ai * HALF + m * 16] : 1.0f;
#pragma unroll
            for (int m = 0; m < 4; ++m) { const size_t off = (size_t)(row0 + ai * HALF + m * 16) * 4096 + col0;
#pragma unroll
                for (int bj = 0; bj < 2; ++bj) {
                    if (RES_F32) { r[RES_F32 ? m : 0][bj][0] = *(const f32x4*)(rbase + off + bj * HALF); r[RES_F32 ? m : 0][bj][1] = *(const f32x4*)(rbase + off + bj * HALF + 4); }
                    else { rw[m][bj] = *(const u32x4*)(XB + off + bj * HALF); } } }
#pragma unroll
            for (int m = 0; m < 4; ++m) { const int row = row0 + ai * HALF + m * 16; const size_t off = (size_t)row * 4096 + col0; float ss = 0.f;
#pragma unroll
                for (int bj = 0; bj < 2; ++bj) { f32x4 o0, o1; const f32x4 ra0 = RES_F32 ? r[RES_F32 ? m : 0][bj][0] : lo4(rw[m][bj]), ra1 = RES_F32 ? r[RES_F32 ? m : 0][bj][1] : hi4(rw[m][bj]);
                    if constexpr (I8) { o0 = ra0 + __builtin_convertvector(acc[ai][bj][m][0], f32x4) * cw[bj][0] * rsv[m]; o1 = ra1 + __builtin_convertvector(acc[ai][bj][m][1], f32x4) * cw[bj][1] * rsv[m]; }
                    else { o0 = ra0 + acc[ai][bj][m][0]; o1 = ra1 + acc[ai][bj][m][1]; }
                    if (OUT_F32) { *(f32x4*)(out + off + bj * HALF) = o0; *(f32x4*)(out + off + bj * HALF + 4) = o1; }
                    if (XBOUT) { *(u32x4*)(XB + off + bj * HALF) = pack8(o0, o1); ss += ssq4(o0) + ssq4(o1); } }
                if (XBOUT) { ss += __shfl_xor(ss, 16); ss += __shfl_xor(ss, 32); if (fq == 0) fix_add(ssq_out + row, f2fixu(ss)); } }
            asm volatile("" ::: "memory");
        }
    }
    static constexpr bool TAIL_SPLIT = false;
    __device__ __forceinline__ void tail(int row, int cg, int pn, int q, f32x4 v0, f32x4 v1) const {
        const size_t off = (size_t)row * 4096 + pn * BM + (cg >> 2) * HALF + q * 32 + 8 * (cg & 3);
        if constexpr (I8) { const float rs = rowscale[row] * (1.0f / 127.0f); const float* cp = cmo + pn * BM + (cg >> 2) * HALF + q * 32 + 8 * (cg & 3); v0 = v0 * *(const f32x4*)cp * rs; v1 = v1 * *(const f32x4*)(cp + 4) * rs; }
        f32x4 r0, r1;
        if (RES_F32) { r0 = *(const f32x4*)(res_hi + off); r1 = *(const f32x4*)(res_hi + off + 4); }
        else { const u32x4 w = *(const u32x4*)(XB + off); r0 = lo4(w); r1 = hi4(w); }
        const f32x4 o0 = r0 + v0, o1 = r1 + v1;
        if (OUT_F32) { *(f32x4*)(out + off) = o0; *(f32x4*)(out + off + 4) = o1; }
        if (XBOUT) {
            *(u32x4*)(XB + off) = pack8(o0, o1);
            float ss = ssq4(o0) + ssq4(o1); ss += __shfl_xor(ss, 1); ss += __shfl_xor(ss, 2); ss += __shfl_xor(ss, 4);
            if (cg == 0) fix_add(ssq_out + row, f2fixu(ss));
        }
    }
};
struct EpiSwiglu {
    typedef f32x4 AccT;
    static constexpr bool PERM = true, AFTER_DRAIN = false;
    bf16_t* ACT; const u64* ssq;
    __device__ __forceinline__ void operator()(const f32x4 (&acc)[2][2][4][2], const Unit& u, int wr, int wc, int fr, int fq) const {
        const int row0 = u.pm * BM + wr * 64 + fr, col0 = u.pn * HALF + wc * 32 + 8 * fq;
        float rs[2][4];
#pragma unroll
        for (int ai = 0; ai < 2; ++ai)
#pragma unroll
            for (int m = 0; m < 4; ++m) rs[ai][m] = rstd_of(ssq, row0 + ai * HALF + m * 16);
#pragma unroll
        for (int ai = 0; ai < 2; ++ai)
#pragma unroll
            for (int m = 0; m < 4; ++m) {
                const int row = row0 + ai * HALF + m * 16; f32x4 o[2];
#pragma unroll
                for (int n = 0; n < 2; ++n) { const f32x4 g = acc[ai][0][m][n] * rs[ai][m], up = acc[ai][1][m][n] * rs[ai][m];
#pragma unroll
                    for (int j = 0; j < 4; ++j) o[n][j] = g[j] * __builtin_amdgcn_rcpf(1.0f + __builtin_amdgcn_exp2f(-1.44269504f * g[j])) * up[j]; }
                *(u32x4*)(ACT + (size_t)row * 11008 + col0) = pack8(o[0], o[1]);
            }
    }
    static constexpr bool TAIL_SPLIT = true;
    __device__ __forceinline__ void tail(int row, int cg, int pn, int q, f32x4 g, f32x4 up) const {
        const float rs = rstd_of(ssq, row);
        g = g * rs; up = up * rs; f32x4 o;
#pragma unroll
        for (int j = 0; j < 4; ++j) o[j] = g[j] * __builtin_amdgcn_rcpf(1.0f + __builtin_amdgcn_exp2f(-1.44269504f * g[j])) * up[j];
        typedef unsigned u32x2t __attribute__((ext_vector_type(2)));
        u32x2t w; w.x = cvt_pk_bf16(o[0], o[1]); w.y = cvt_pk_bf16(o[2], o[3]);
        *(u32x2t*)(ACT + (size_t)row * 11008 + pn * HALF + q * 32 + 4 * cg) = w;
    }
};

struct EpiSwigluI8 {
    typedef int i32x4 __attribute__((ext_vector_type(4)));
    typedef i32x4 AccT;
    static constexpr bool PERM = true, AFTER_DRAIN = false, TAIL_SPLIT = true;
    bf16_t* ACT; const float* rowscale; const float* colmax;
    __device__ __forceinline__ void operator()(const i32x4 (&acc)[2][2][4][2], const Unit& u, int wr, int wc, int fr, int fq) const {
        const int row0 = u.pm * BM + wr * 64 + fr, col0 = u.pn * HALF + wc * 32 + 8 * fq, bcol = u.pn * BM + wc * 32 + 8 * fq;
        f32x4 cw[2][2];
#pragma unroll
        for (int bj = 0; bj < 2; ++bj)
#pragma unroll
            for (int n = 0; n < 2; ++n) cw[bj][n] = *(const f32x4*)(colmax + bcol + bj * HALF + 4 * n) * (1.0f / 127.0f);
        float rs[2][4];
#pragma unroll
        for (int ai = 0; ai < 2; ++ai)
#pragma unroll
            for (int m = 0; m < 4; ++m) rs[ai][m] = rowscale[row0 + ai * HALF + m * 16];
#pragma unroll
        for (int ai = 0; ai < 2; ++ai)
#pragma unroll
            for (int m = 0; m < 4; ++m) {
                const int row = row0 + ai * HALF + m * 16; f32x4 o[2];
#pragma unroll
                for (int n = 0; n < 2; ++n) {
#pragma unroll
                    for (int j = 0; j < 4; ++j) { const float g = (float)acc[ai][0][m][n][j] * rs[ai][m] * cw[0][n][j], up = (float)acc[ai][1][m][n][j] * rs[ai][m] * cw[1][n][j];
                        o[n][j] = g * __builtin_amdgcn_rcpf(1.0f + __builtin_amdgcn_exp2f(-1.44269504f * g)) * up; } }
                *(u32x4*)((char*)ACT + blk_byte(row, col0, 11008)) = pack8(o[0], o[1]);
            }
    }
    __device__ __forceinline__ void tail(int row, int cg, int pn, int q, f32x4 g, f32x4 up) const {
        const float rs = rowscale[row] * (1.0f / 127.0f);
        const f32x4 cgv = *(const f32x4*)(colmax + pn * BM + q * 32 + 4 * cg), cuv = *(const f32x4*)(colmax + pn * BM + HALF + q * 32 + 4 * cg);
        g = g * cgv * rs; up = up * cuv * rs; f32x4 o;
#pragma unroll
        for (int j = 0; j < 4; ++j) o[j] = g[j] * __builtin_amdgcn_rcpf(1.0f + __builtin_amdgcn_exp2f(-1.44269504f * g[j])) * up[j];
        typedef unsigned u32x2t __attribute__((ext_vector_type(2)));
        u32x2t w; w.x = cvt_pk_bf16(o[0], o[1]); w.y = cvt_pk_bf16(o[2], o[3]);
        *(u32x2t*)((char*)ACT + blk_byte(row, pn * HALF + q * 32 + 4 * cg, 11008)) = w;
    }
};
constexpr size_t OUT_KP = 34603008, OUT_VP = 34734080, OUT_KS = 34865152, OUT_VS = 34996224, OUT_SGUV = 35127296;
template <bool I8> struct EpiQKVT {
    typedef int i32x4_t __attribute__((ext_vector_type(4)));
    typedef typename AccSel<I8>::T AccT;
    static constexpr bool PERM = true, AFTER_DRAIN = false;
    bf16_t *KB, *VB, *QB; float* out; const u64* ssq; const float* kg; const float* qg; const float* rowscale; const float* cmq;
    __device__ __forceinline__ void operator()(const AccT (&acc)[2][2][4][2], const Unit& u, int wr, int wc, int fr, int fq) const {
        const int row0 = u.pm * BM + wr * 64 + fr;
        const bool isk = u.pn < 2, isq = u.pn >= 4, isv = !isk && !isq;
        const int hidx = (isk ? u.pn : (isq ? u.pn - 4 : u.pn - 2)) * 4 + wc;
        bf16_t* const kvb = isk ? KB : VB; const size_t o_s = isk ? OUT_KS : OUT_VS, o_p = isk ? OUT_KP : OUT_VP;
        const float* gp = (u.pn < 2) ? kg : qg;
        f32x4 gv[2][2];
#pragma unroll
        for (int bj = 0; bj < 2; ++bj)
#pragma unroll
            for (int n = 0; n < 2; ++n) gv[bj][n] = *(const f32x4*)(gp + 32 * bj + 8 * fq + 4 * n);
        const float gs = isq ? 0.125f : 1.0f;
        float rs[2][4];
#pragma unroll
        for (int ai = 0; ai < 2; ++ai)
#pragma unroll
            for (int m = 0; m < 4; ++m) rs[ai][m] = I8 ? rowscale[row0 + ai * HALF + m * 16] : rstd_of(ssq, row0 + ai * HALF + m * 16);
        f32x4 cw[2][2];
#pragma unroll
        for (int bj = 0; bj < 2; ++bj)
#pragma unroll
            for (int n = 0; n < 2; ++n) cw[bj][n] = I8 ? *(const f32x4*)(cmq + u.pn * BM + bj * HALF + wc * 32 + 8 * fq + 4 * n) * (1.0f / 127.0f) : (f32x4){1.f, 1.f, 1.f, 1.f};
#pragma unroll
        for (int ai = 0; ai < 2; ++ai)
#pragma unroll
            for (int m = 0; m < 4; ++m) {
                const int row = row0 + ai * HALF + m * 16;
                f32x4 t[2][2]; float ss = 0.f;
#pragma unroll
                for (int bj = 0; bj < 2; ++bj)
#pragma unroll
                    for (int n = 0; n < 2; ++n) { if constexpr (I8) t[bj][n] = __builtin_convertvector(acc[ai][bj][m][n], f32x4) * cw[bj][n] * rs[ai][m]; else t[bj][n] = acc[ai][bj][m][n] * rs[ai][m]; ss += ssq4(t[bj][n]); }
                if (!isv) {
                    ss += __shfl_xor(ss, 16); ss += __shfl_xor(ss, 32);
                    const float r = rsqrtf(ss * (1.0f / 64.0f) + 1e-6f) * gs;
#pragma unroll
                    for (int bj = 0; bj < 2; ++bj)
#pragma unroll
                        for (int n = 0; n < 2; ++n) t[bj][n] = t[bj][n] * r * gv[bj][n];
                }
                if (isq) {
                    bf16_t* p = QB + (size_t)row * 4096 + hidx * 64 + 8 * fq;
#pragma unroll
                    for (int bj = 0; bj < 2; ++bj) *(u32x4*)(p + 32 * bj) = pack8(t[bj][0], t[bj][1]);
                } else {
                    const int kr = row < 8192 ? row : 8192 + 160 * ((row - 8192) >> 5) + 128 + ((row - 8192) & 31);
                    bf16_t* p = kvb + (size_t)kr * 512 + hidx * 64 + 8 * fq;
#pragma unroll
                    for (int bj = 0; bj < 2; ++bj) *(u32x4*)(p + 32 * bj) = pack8(t[bj][0], t[bj][1]);
                    float* op = nullptr;
                    if (row >= 8192) op = out + o_s + (size_t)(row - 8192) * 512 + hidx * 64 + 8 * fq;
                    else { const int tt = row & 4095; if (tt >= 3968) op = out + o_p + (size_t)((row >> 12) * 128 + tt - 3968) * 512 + hidx * 64 + 8 * fq; }
                    if (op) {
#pragma unroll
                        for (int bj = 0; bj < 2; ++bj) { *(f32x4*)(op + 32 * bj) = t[bj][0]; *(f32x4*)(op + 32 * bj + 4) = t[bj][1]; }
                    }
                }
            }
    }
    static constexpr bool TAIL_SPLIT = false;
    __device__ __forceinline__ void tail(int row, int cg, int pn, int q, f32x4 v0, f32x4 v1) const {
        const bool isk = pn < 2, isq = pn >= 4, isv = !isk && !isq;
        const int hidx = (isk ? pn : (isq ? pn - 4 : pn - 2)) * 4 + q;
        const float rs = I8 ? rowscale[row] * (1.0f / 127.0f) : rstd_of(ssq, row);
        v0 = v0 * rs; v1 = v1 * rs;
        if constexpr (I8) { const float* cp = cmq + pn * BM + ((8 * cg) >> 5) * HALF + q * 32 + ((8 * cg) & 31); v0 = v0 * *(const f32x4*)cp; v1 = v1 * *(const f32x4*)(cp + 4); }
        if (!isv) {
            const float* gp = isk ? kg : qg;
            const f32x4 g0 = *(const f32x4*)(gp + 8 * cg), g1 = *(const f32x4*)(gp + 8 * cg + 4);
            float ss = ssq4(v0) + ssq4(v1); ss += __shfl_xor(ss, 1); ss += __shfl_xor(ss, 2); ss += __shfl_xor(ss, 4);
            const float r = rsqrtf(ss * (1.0f / 64.0f) + 1e-6f) * (isq ? 0.125f : 1.0f);
            v0 = v0 * r * g0; v1 = v1 * r * g1;
        }
        if (isq) { *(u32x4*)(QB + (size_t)row * 4096 + hidx * 64 + 8 * cg) = pack8(v0, v1); }
        else {
            const int kr = 8192 + 160 * ((row - 8192) >> 5) + 128 + ((row - 8192) & 31);
            *(u32x4*)((isk ? KB : VB) + (size_t)kr * 512 + hidx * 64 + 8 * cg) = pack8(v0, v1);
            float* op = out + (isk ? OUT_KS : OUT_VS) + (size_t)(row - 8192) * 512 + hidx * 64 + 8 * cg;
            *(f32x4*)op = v0; *(f32x4*)(op + 4) = v1;
        }
    }
};
typedef EpiQKVT<false> EpiQKV;
struct QOrder : StaticOrder {
    __device__ bool next(int i, Unit& u) const {
        long L;
        if (G != 256) { L = (long)i * G + c; if (L >= nwg) return false; }
        else if (c >= 128) { if (i >= 3) return false; L = (long)i * 128 + (c - 128); } else { if (i >= 1) return false; L = 384 + c; }
        int wgid = (int)L; { const int q = nwg / NXCD, r = nwg % NXCD, xcd = wgid % NXCD, off = wgid / NXCD; wgid = (xcd < r ? xcd * (q + 1) : r * (q + 1) + (xcd - r) * q) + off; }
        const int nig = WGM * nN, gid = wgid / nig, fm = gid * WGM, gsz = (nM - fm) < WGM ? (nM - fm) : WGM;
        u.pm = fm + ((wgid % nig) % gsz); u.pn = 4 + (wgid % nig) / gsz; return true;
    }
};
typedef int i32x4 __attribute__((ext_vector_type(4)));
__device__ __forceinline__ f32x4 mma16(bf16x8 a, bf16x8 b, f32x4 c) { return __builtin_amdgcn_mfma_f32_16x16x32_bf16(a, b, c, 0, 0, 0); }
__device__ __forceinline__ i32x4 mma16(bf16x8 a, bf16x8 b, i32x4 c) { return __builtin_amdgcn_mfma_i32_16x16x64_i8(__builtin_bit_cast(i32x4, a), __builtin_bit_cast(i32x4, b), c, 0, 0, 0); }
template <class Epi, class Sched, bool ALIGN_EPI = false, bool SP2 = false>
__device__ __forceinline__ void gemm_phase(PG8_LAS unsigned char* lds, const Gemm g, const Sched& S, const Epi& E) {
    const int tid = threadIdx.x, wid = __builtin_amdgcn_readfirstlane(tid >> 6), lane = tid & 63, wr = wid >> 2, wc = wid & 3, fr = lane & 15, fq = lane >> 4;
    const int K = g.K, nt = K / BK;
    unsigned voffA[2], voffB[2];
#pragma unroll
    for (int i = 0; i < 2; ++i) { int R, C; stage_rc(tid * 16 + i * 8192, R, C); const int Rb = Epi::PERM ? ((R & ~31) + perm32(R & 31)) : R;
        voffA[i] = g.ablk ? (unsigned)lds_byte(R, C) : (unsigned)(R * K + C) * 2u; voffB[i] = g.bblk ? (unsigned)lds_byte(Rb, C) : (unsigned)(Rb * K + C) * 2u; }
    const size_t kA = g.ablk ? (size_t)32768 : (size_t)(BK * 2), kB = g.bblk ? (size_t)32768 : (size_t)(BK * 2);
    const size_t hA = g.ablk ? (size_t)16384 : (size_t)HALF * K * 2, hB = g.bblk ? (size_t)16384 : (size_t)HALF * K * 2;
    const size_t tstep = (size_t)2 * HALF * K * 2;
    const unsigned ldsw = (unsigned)wid * 1024u;
    const int aoff = lds_byte(wr * 64 + fr, fq * 8), boff = lds_byte(wc * 32 + fr, fq * 8);
#define PG8_SA(b, h) (((b) * 2 + (h)) * HTB)
#define PG8_SB(b, h) ((4 + (b) * 2 + (h)) * HTB)
#define PG8_STAGE(bufoff, gbase, voff) do { _Pragma("unroll") for (int _i = 0; _i < 2; ++_i) \
        __builtin_amdgcn_global_load_lds((const unsigned*)((const char*)(gbase) + (voff)[_i]), (PG8_LAS unsigned*)(lds + (bufoff) + ldsw + _i * 8192), 16, 0, 0); } while (0)
#define PG8_LDA(dst, b, h) do { _Pragma("unroll") for (int m = 0; m < 4; ++m) _Pragma("unroll") for (int k = 0; k < 2; ++k) dst[m][k] = *(const PG8_LAS bf16x8*)(lds + PG8_SA(b, h) + aoff + m * 2048 + k * 1024); } while (0)
#define PG8_LDB(dst, b, h) do { _Pragma("unroll") for (int n = 0; n < 2; ++n) _Pragma("unroll") for (int k = 0; k < 2; ++k) dst[n][k] = *(const PG8_LAS bf16x8*)(lds + PG8_SB(b, h) + boff + n * 2048 + k * 1024); } while (0)
#define PG8_MMA(ai, bj, At, Bt) do { __builtin_amdgcn_s_setprio(1); _Pragma("unroll") for (int m = 0; m < 4; ++m) _Pragma("unroll") for (int n = 0; n < 2; ++n) _Pragma("unroll") for (int k = 0; k < 2; ++k) \
        acc[ai][bj][m][n] = mma16(Bt[n][k], At[m][k], acc[ai][bj][m][n]); __builtin_amdgcn_s_setprio(0); } while (0)
#define PG8_WAIT_V(n) asm volatile("s_waitcnt vmcnt(" #n ")" ::: "memory")
#define PG8_WAIT_L(n) asm volatile("s_waitcnt lgkmcnt(" #n ")" ::: "memory")
#define PG8_BAR __builtin_amdgcn_s_barrier()
#define PG8_SCHED __builtin_amdgcn_sched_barrier(0)
    Unit cur, nxt; int ui = 0;
    if (!S.next(0, cur)) return;
    typedef typename Epi::AccT AccT;
    AccT acc[2][2][4][2];
#pragma unroll
    for (int a = 0; a < 2; ++a)
#pragma unroll
        for (int b = 0; b < 2; ++b)
#pragma unroll
            for (int m = 0; m < 4; ++m)
#pragma unroll
                for (int n = 0; n < 2; ++n) acc[a][b][m][n] = (AccT){0, 0, 0, 0};
    bf16x8 At[4][2], B0[2][2], B1[2][2];
    const char* cA = (const char*)g.A + (size_t)cur.pm * tstep; const char* cB = (const char*)g.Bt + (size_t)cur.pn * tstep;
    S.a_ready(cur);
    if constexpr (SP2) {
        PG8_STAGE(PG8_SB(0, 0), cB, voffB); PG8_STAGE(PG8_SB(0, 1), cB + hB, voffB); PG8_STAGE(PG8_SA(0, 0), cA, voffA); PG8_STAGE(PG8_SA(0, 1), cA + hA, voffA);
        if (wr == 1) PG8_BAR;
        PG8_WAIT_V(2); PG8_BAR;
        PG8_STAGE(PG8_SB(1, 0), cB + kB, voffB); PG8_STAGE(PG8_SA(1, 0), cA + kA, voffA); PG8_STAGE(PG8_SB(1, 1), cB + hB + kB, voffB);
        PG8_WAIT_V(6); PG8_BAR;
    } else {
        PG8_STAGE(PG8_SB(0, 0), cB, voffB); PG8_STAGE(PG8_SA(0, 0), cA, voffA); PG8_STAGE(PG8_SB(0, 1), cB + hB, voffB); PG8_STAGE(PG8_SA(0, 1), cA + hA, voffA);
        if (wr == 1) PG8_BAR;
        PG8_WAIT_V(4); PG8_BAR;
        PG8_STAGE(PG8_SB(1, 0), cB + kB, voffB); PG8_STAGE(PG8_SA(1, 0), cA + kA, voffA); PG8_STAGE(PG8_SB(1, 1), cB + hB + kB, voffB);
        PG8_WAIT_V(6); PG8_BAR;
    }
    for (;;) {
        const bool has_next = S.next(ui + 1, nxt);
        const char* nA = has_next ? (const char*)g.A + (size_t)nxt.pm * tstep : cA; const char* nB = has_next ? (const char*)g.Bt + (size_t)nxt.pn * tstep : cB;
        for (int t = 0; t < nt; t += 2) {
            const bool last = (t == nt - 2);
            const char* a1 = cA + (size_t)(t + 1) * kA;
            const char* a2 = last ? nA : cA + (size_t)(t + 2) * kA; const char* b2 = last ? nB : cB + (size_t)(t + 2) * kB;
            const char* a3 = a2 + kA; const char* b3 = b2 + kB;
            if (last && has_next) S.a_ready(nxt);
            if constexpr (SP2) {
            PG8_LDB(B0, 0, 0); PG8_LDB(B1, 0, 1); PG8_SCHED; PG8_LDA(At, 0, 0); PG8_STAGE(PG8_SA(1, 1), a1 + hA, voffA);
            PG8_WAIT_V(8); PG8_WAIT_L(0); PG8_BAR; PG8_MMA(0, 0, At, B0); PG8_MMA(0, 1, At, B1); PG8_BAR; PG8_SCHED;
            PG8_LDA(At, 0, 1); PG8_STAGE(PG8_SB(0, 0), b2, voffB); PG8_STAGE(PG8_SB(0, 1), b2 + hB, voffB); PG8_STAGE(PG8_SA(0, 0), a2, voffA);
            PG8_WAIT_V(8); PG8_WAIT_L(0); PG8_BAR; PG8_MMA(1, 0, At, B0); PG8_MMA(1, 1, At, B1); PG8_BAR; PG8_SCHED;
            PG8_LDB(B0, 1, 0); PG8_LDB(B1, 1, 1); PG8_SCHED; PG8_LDA(At, 1, 0); PG8_STAGE(PG8_SA(0, 1), a2 + hA, voffA);
            PG8_WAIT_V(8); PG8_WAIT_L(0); PG8_BAR; PG8_MMA(0, 0, At, B0); PG8_MMA(0, 1, At, B1); PG8_BAR; PG8_SCHED;
            PG8_LDA(At, 1, 1); PG8_STAGE(PG8_SB(1, 0), b3, voffB); PG8_STAGE(PG8_SB(1, 1), b3 + hB, voffB); PG8_STAGE(PG8_SA(1, 0), a3, voffA);
            PG8_WAIT_V(8); PG8_WAIT_L(0); PG8_BAR; PG8_MMA(1, 0, At, B0); PG8_MMA(1, 1, At, B1); PG8_BAR; PG8_SCHED;
            } else {
            PG8_LDB(B0, 0, 0); PG8_SCHED; PG8_LDA(At, 0, 0); PG8_STAGE(PG8_SA(1, 1), a1 + hA, voffA);
            PG8_WAIT_L(8); PG8_BAR; PG8_WAIT_L(0); PG8_MMA(0, 0, At, B0); PG8_BAR; PG8_SCHED;
            PG8_LDB(B1, 0, 1); PG8_STAGE(PG8_SB(0, 0), b2, voffB);
            PG8_BAR; PG8_WAIT_L(0); PG8_MMA(0, 1, At, B1); PG8_BAR;
            PG8_LDA(At, 0, 1); PG8_STAGE(PG8_SA(0, 0), a2, voffA);
            PG8_BAR; PG8_WAIT_L(0); PG8_MMA(1, 0, At, B0); PG8_BAR; PG8_SCHED;
            PG8_STAGE(PG8_SB(0, 1), b2 + hB, voffB);
            PG8_WAIT_V(6); PG8_BAR; PG8_MMA(1, 1, At, B1); PG8_BAR;
            PG8_LDB(B0, 1, 0); PG8_SCHED; PG8_LDA(At, 1, 0); PG8_STAGE(PG8_SA(0, 1), a2 + hA, voffA);
            PG8_WAIT_L(8); PG8_BAR; PG8_WAIT_L(0); PG8_MMA(0, 0, At, B0); PG8_BAR; PG8_SCHED;
            PG8_LDB(B1, 1, 1); PG8_STAGE(PG8_SB(1, 0), b3, voffB);
            PG8_BAR; PG8_WAIT_L(0); PG8_MMA(0, 1, At, B1); PG8_BAR;
            PG8_LDA(At, 1, 1); PG8_STAGE(PG8_SA(1, 0), a3, voffA);
            PG8_BAR; PG8_WAIT_L(0); PG8_MMA(1, 0, At, B0); PG8_BAR; PG8_SCHED;
            PG8_STAGE(PG8_SB(1, 1), b3 + hB, voffB);
            PG8_WAIT_V(6); PG8_BAR; PG8_MMA(1, 1, At, B1); PG8_BAR;
            }
        }
        if constexpr (ALIGN_EPI) { if (wr == 0) PG8_BAR; }
        if constexpr (!Epi::AFTER_DRAIN) { E(acc, cur, wr, wc, fr, fq); S.done(cur); }
        if (!has_next) break;
#pragma unroll
        for (int a = 0; a < 2; ++a)
#pragma unroll
            for (int b = 0; b < 2; ++b)
#pragma unroll
                for (int m = 0; m < 4; ++m)
#pragma unroll
                    for (int n = 0; n < 2; ++n) acc[a][b][m][n] = (AccT){0, 0, 0, 0};
        cur = nxt; cA = nA; cB = nB; ++ui;
        if constexpr (ALIGN_EPI) { if (wr == 1) PG8_BAR; }
    }
    PG8_WAIT_V(0);
    if constexpr (!ALIGN_EPI) { if (wr == 0) PG8_BAR; }
    PG8_BAR;
    if constexpr (Epi::AFTER_DRAIN) { E.fused(acc, cur, wr, wc, fr, fq, lds, wid, lane); S.done(cur); }
#undef PG8_SA
#undef PG8_SB
#undef PG8_STAGE
#undef PG8_LDA
#undef PG8_LDB
#undef PG8_MMA
#undef PG8_WAIT_V
#undef PG8_WAIT_L
#undef PG8_BAR
#undef PG8_SCHED
}
}

#ifndef PG8_SP2
#define PG8_SP2 true
#endif
#ifndef PG8_ALIGN
#define PG8_ALIGN true
#endif
#ifndef MK_ONE_LAUNCH
#define MK_ONE_LAUNCH 1
#endif
constexpr int NWAVES = 8, NPHASES = 17;
constexpr int D = 4096, MP = 8192, MS = 256, M = MP + MS, DFF = 11008, NGU = 2 * DFF, NQKV = 5120, NSGU = 8192;
constexpr int KV_ROWS = 8192 + 8 * 160;
constexpr size_t MiB = 1u << 20;
constexpr size_t WS_CTL = 0, CTL_ZERO_BYTES = 1 * MiB;
constexpr int CW_BAR = 4096, CW_Q = 8192;
constexpr size_t ST_OFF = 65536, ST_STRIDE = 67584;
static_assert(ST_STRIDE == (size_t)M * 8 && ST_OFF + 6 * ST_STRIDE <= CTL_ZERO_BYTES, "stat arrays inside the memset region");
constexpr size_t CM_OFF = 524288, CM_STRIDE = 88064;
constexpr size_t RS_OFF = 720896;
constexpr size_t CMQ_OFF = 786432;
static_assert(ST_OFF + 6 * ST_STRIDE <= CM_OFF && CM_OFF + 2 * CM_STRIDE <= RS_OFF && RS_OFF + (size_t)M * 4 <= CMQ_OFF && CMQ_OFF + 5120 * 4 <= CTL_ZERO_BYTES, "control region map");
constexpr size_t CMO_OFF = 819200;
static_assert(CMQ_OFF + 5120 * 4 <= CMO_OFF && CMO_OFF + 4096 * 4 <= CTL_ZERO_BYTES, "control region map");
constexpr size_t CMD_OFF = 851968;
static_assert(CMO_OFF + 4096 * 4 <= CMD_OFF && CMD_OFF + 2 * 4096 * 4 <= CTL_ZERO_BYTES, "control region map");
constexpr size_t WS_ACT8 = (size_t)788 << 20;
constexpr size_t WS_WD8_0 = (size_t)184 << 20, WS_WD8_1 = (size_t)514 << 20;
constexpr size_t WQ8_SHIFT = 4u << 20;
constexpr size_t WS_WSB = 1 * MiB;
constexpr size_t WS_W1T = 2 * MiB, WS_W2T = 66 * MiB, WS_WGU0 = 98 * MiB, WS_WD0 = 270 * MiB, WS_WQKV = 356 * MiB, WS_WOT = 396 * MiB, WS_WGU1 = 428 * MiB, WS_WD1 = 600 * MiB;
constexpr size_t WS_XB = 686 * MiB, WS_H = 752 * MiB  , WS_ACT = 884 * MiB, WS_ZQ = 1062 * MiB, WS_O = 1128 * MiB, WS_KB = 1194 * MiB, WS_VB = 1204 * MiB, WS_END = 1214 * MiB;
static_assert(WS_W1T + (size_t)NSGU * D * 2 <= WS_W2T && WS_W2T + (size_t)D * D * 2 <= WS_WGU0 && WS_WGU0 + (size_t)NGU * D * 2 <= WS_WD0 && WS_WD0 + (size_t)D * DFF * 2 <= WS_WQKV &&
              WS_WQKV + (size_t)NQKV * D * 2 <= WS_WOT && WS_WOT + (size_t)D * D * 2 <= WS_WGU1 && WS_WGU1 + (size_t)NGU * D * 2 <= WS_WD1 && WS_WD1 + (size_t)D * DFF * 2 <= WS_XB, "weight map");
static_assert(WS_XB + (size_t)M * D * 2 <= WS_H && WS_H + (size_t)M * D * 4 <= WS_ACT && WS_ACT + (size_t)M * DFF * 2 <= WS_ZQ && WS_ACT + (size_t)M * NSGU * 2 <= WS_ZQ &&
              WS_ZQ + (size_t)M * D * 2 <= WS_O && WS_O + (size_t)M * D * 2 <= WS_KB && WS_KB + (size_t)KV_ROWS * 512 * 2 <= WS_VB && WS_VB + (size_t)KV_ROWS * 512 * 2 <= WS_END, "activation map");
constexpr int SCR_BYTES = 139264;
constexpr int LDSCTL_OFF = SCR_BYTES, MISC_OFF = LDSCTL_OFF + 320;
constexpr int LDS_BYTES = 147456;
static_assert(MISC_OFF + 128 <= LDS_BYTES && pg8::STAGE_BYTES <= SCR_BYTES, "LDS map");

#define GAS __attribute__((address_space(1)))
#define LAS __attribute__((address_space(3)))
typedef unsigned short bf16;
typedef unsigned v4u __attribute__((ext_vector_type(4)));
typedef unsigned v2u __attribute__((ext_vector_type(2)));
typedef float f32x4 __attribute__((ext_vector_type(4)));
typedef short bf16x8 __attribute__((ext_vector_type(8)));
typedef unsigned long long u64;
#define LDS_WAIT() asm volatile("s_waitcnt lgkmcnt(0)" ::: "memory")
#define VM_WAIT() asm volatile("s_waitcnt vmcnt(0)" ::: "memory")
__device__ __forceinline__ unsigned f2bf(float f) { unsigned u = __builtin_bit_cast(unsigned, f); return (u + 0x7fffu + ((u >> 16) & 1u)) >> 16; }
typedef float f32x2_t __attribute__((ext_vector_type(2)));
typedef __bf16 bf16x2_t __attribute__((ext_vector_type(2)));
__device__ __forceinline__ unsigned pk2(float lo, float hi) { const f32x2_t v = {lo, hi}; const bf16x2_t b = __builtin_convertvector(v, bf16x2_t); return __builtin_bit_cast(unsigned, b); }
__device__ __forceinline__ float bflo(unsigned w) { return __builtin_bit_cast(float, w << 16); }
__device__ __forceinline__ float bfhi(unsigned w) { return __builtin_bit_cast(float, w & 0xffff0000u); }

#define XB_TMO      128
#define XB_XCNT(j)  (256  + 64 * (j))
#define XB_XSUB(j)  (1280 + 64 * (j))
#define XB_XGEN(j)  (2304 + 64 * (j))
#define XB_TOP      3328
#define XB_TOPGEN   3392
#define XCD_BAR_WORDS 3456
#define XB_SPIN_CAP (1u << 18)

__device__ __forceinline__ unsigned xb_ld(unsigned* p)              { return __hip_atomic_load(p, __ATOMIC_RELAXED, __HIP_MEMORY_SCOPE_AGENT); }
__device__ __forceinline__ unsigned xb_add(unsigned* p, unsigned v) { return __hip_atomic_fetch_add(p, v, __ATOMIC_RELAXED, __HIP_MEMORY_SCOPE_AGENT); }
__device__ __forceinline__ unsigned xb_xcc_id() { return (unsigned)__builtin_amdgcn_s_getreg((3 << 11) | 20) & 0xFu; }
#define XB_SPIN(cond, bar) do { unsigned _sp = 0; while (cond) { __builtin_amdgcn_s_sleep(1); \
    if ((++_sp & 255u) == 0u) { if (xb_ld(&(bar)[XB_TMO])) break; if (_sp > XB_SPIN_CAP) { atomicAdd(&(bar)[XB_TMO], 1u); break; } } } } while (0)

struct XcdBarrier {
    unsigned* bar; unsigned x;
    volatile LAS unsigned* st;
};

__device__ __forceinline__ XcdBarrier xcd_barrier_post(unsigned* bar, volatile LAS unsigned* st) {
    XcdBarrier b; b.bar = bar; b.x = xb_xcc_id(); b.st = st;
    if (threadIdx.x == 0) (void)xb_add(&bar[XB_XCNT(b.x)], 1u);
    return b;
}
__device__ __forceinline__ void xcd_barrier_complete(unsigned* bar, unsigned x, unsigned& nloc, unsigned& nx) {
    const unsigned G = gridDim.x * gridDim.y * gridDim.z;
    unsigned sum, cnt, mine, sp = 0u;
    for (;;) {
        sum = 0u; cnt = 0u; mine = 0u;
#pragma unroll
        for (unsigned j = 0; j < 16; ++j) { const unsigned c = xb_ld(&bar[XB_XCNT(j)]); sum += c; cnt += (c > 0u) ? 1u : 0u; mine = (j == x) ? c : mine; }
        if (sum == G) break;
        __builtin_amdgcn_s_sleep(1);
        if ((++sp & 255u) == 0u) { if (xb_ld(&bar[XB_TMO])) break; if (sp > XB_SPIN_CAP) { atomicAdd(&bar[XB_TMO], 1u); break; } }
    }
    nloc = mine > 0u ? mine : 1u; nx = cnt > 0u ? cnt : 1u;
}

__device__ __forceinline__ void xcd_barrier(const XcdBarrier& b) {
    asm volatile("s_waitcnt vmcnt(0)" ::: "memory");
    __syncthreads();
    if (threadIdx.x == 0) {
        unsigned* bar = b.bar;
        __builtin_amdgcn_s_waitcnt(0);
        unsigned nloc = b.st[0], nx = b.st[1];
        if (nloc == 0u) { xcd_barrier_complete(bar, b.x, nloc, nx); b.st[0] = nloc; b.st[1] = nx; }
        const unsigned old = xb_add(&bar[XB_XSUB(b.x)], 1u);
        const unsigned gen = old / nloc;
        if (old + 1u == (gen + 1u) * nloc) {
            __builtin_amdgcn_fence(__ATOMIC_RELEASE, "agent");
            asm volatile("s_waitcnt vmcnt(0)" ::: "memory");
            const unsigned og = xb_add(&bar[XB_TOP], 1u);
            const unsigned tg = og / nx;
            if (og + 1u == (tg + 1u) * nx) xb_add(&bar[XB_TOPGEN], 1u);
            else XB_SPIN(xb_ld(&bar[XB_TOPGEN]) == tg, bar);
            __builtin_amdgcn_fence(__ATOMIC_ACQUIRE, "agent");
            xb_add(&bar[XB_XGEN(b.x)], 1u);
            asm volatile("s_waitcnt vmcnt(0)" ::: "memory");
        } else {
            XB_SPIN(xb_ld(&bar[XB_XGEN(b.x)]) == gen, bar);
            __builtin_amdgcn_fence(__ATOMIC_ACQUIRE, "agent");
            asm volatile("s_waitcnt vmcnt(0)" ::: "memory");
        }
    }
    __syncthreads();
}


using pg8::FIX_INV;
__device__ __forceinline__ float wave_sum(float v) {
#pragma unroll
    for (int o = 1; o < 64; o <<= 1) v += __shfl_xor(v, o);
    return v;
}
__device__ __forceinline__ int maprow(int map, int n) {
    const int r12 = ((n >> 7) << 8) + (n & 127) + (map == 2 ? 128 : 0);
    const int r3 = (n & ~255) + (((n >> 5) & 1) << 7) + (((n >> 6) & 3) << 5) + (n & 31);
    return map == 0 ? n : (map == 3 ? r3 : r12);
}
struct TItem { const float* W; const float* gain; bf16* WT; const float* cmax; unsigned* amax; int K, N, map, coff, k0, n0, blk, rot; };
#define WHT_BF(a_, b_) do { const float t_ = a_; a_ = t_ + b_; b_ = t_ - b_; } while (0)
__device__ __forceinline__ void wht32(float (&v)[8], int lane) {
    WHT_BF(v[0], v[1]); WHT_BF(v[2], v[3]); WHT_BF(v[4], v[5]); WHT_BF(v[6], v[7]);
    WHT_BF(v[0], v[2]); WHT_BF(v[1], v[3]); WHT_BF(v[4], v[6]); WHT_BF(v[5], v[7]);
    WHT_BF(v[0], v[4]); WHT_BF(v[1], v[5]); WHT_BF(v[2], v[6]); WHT_BF(v[3], v[7]);
#pragma unroll
    for (int mask = 1; mask <= 2; mask <<= 1)
#pragma unroll
        for (int i = 0; i < 8; ++i) { const float pv = __shfl_xor(v[i], mask); v[i] = (lane & mask) ? pv - v[i] : v[i] + pv; }
}
struct TRegs { f32x4 v[16]; f32x4 g0, g1; float cm[8]; };
__device__ __forceinline__ void titem_load(const TItem& t, TRegs& R, const float* dummy, int lane) {
    const float* p = t.W + (size_t)(t.k0 + (lane >> 4)) * t.N + t.n0 + 4 * (lane & 15);
#pragma unroll
    for (int i = 0; i < 16; ++i) R.v[i] = __builtin_nontemporal_load((const f32x4*)(p + (size_t)(4 * i) * t.N));
    const float* gp = (t.gain ? t.gain + t.k0 : dummy + (t.k0 & 4095)) + 8 * (lane & 7);
    R.g0 = *(const f32x4*)gp; R.g1 = *(const f32x4*)(gp + 4);
    const float* cp = t.cmax ? t.cmax : dummy;
#pragma unroll
    for (int j = 0; j < 8; ++j) R.cm[j] = cp[t.cmax ? maprow(t.map, t.n0 + 8 * j + (lane >> 3) + t.coff) : j];
}
__device__ __forceinline__ void titem_lds_write(const TRegs& R, LAS float* scr, int lane) {
#pragma unroll
    for (int i = 0; i < 16; ++i) { const int kk = 4 * i + (lane >> 4), c4 = (lane & 15) ^ (((kk >> 3) & 3) << 1); *(LAS f32x4*)(scr + kk * 64 + 4 * c4) = R.v[i]; }
}
__device__ __forceinline__ void titem_emit(const TItem& t, f32x4 g0, f32x4 g1, const float (&cm)[8], LAS float* scr, int lane) {
    LDS_WAIT(); asm volatile("" ::: "memory");
    const int c = lane & 7, nn = lane >> 3;
    const bool hg = t.gain != nullptr; const f32x4 one = {1.f, 1.f, 1.f, 1.f};
    g0 = hg ? g0 : one; g1 = hg ? g1 : one;
    const int sw = (c & 3) << 1;
#pragma unroll
    for (int j = 0; j < 8; ++j) { const int n = 8 * j + nn; const LAS float* sp = scr + (8 * c) * 64 + ((((n >> 2) ^ sw) << 2) | (n & 3));
        const size_t drow = (size_t)maprow(t.map, t.n0 + n + t.coff);
        if (t.cmax) {
            const float inv = cm[j] > 0.f ? 127.0f / cm[j] : 0.f;
            const int q0 = __float2int_rn(sp[0 * 64] * g0.x * inv), q1 = __float2int_rn(sp[1 * 64] * g0.y * inv), q2 = __float2int_rn(sp[2 * 64] * g0.z * inv), q3 = __float2int_rn(sp[3 * 64] * g0.w * inv);
            const int q4 = __float2int_rn(sp[4 * 64] * g1.x * inv), q5 = __float2int_rn(sp[5 * 64] * g1.y * inv), q6 = __float2int_rn(sp[6 * 64] * g1.z * inv), q7 = __float2int_rn(sp[7 * 64] * g1.w * inv);
            v2u o; o.x = (unsigned)(q0 & 255) | ((unsigned)(q1 & 255) << 8) | ((unsigned)(q2 & 255) << 16) | ((unsigned)q3 << 24);
            o.y = (unsigned)(q4 & 255) | ((unsigned)(q5 & 255) << 8) | ((unsigned)(q6 & 255) << 16) | ((unsigned)q7 << 24);
            __builtin_nontemporal_store(o, (GAS v2u*)(t.blk ? (unsigned char*)t.WT + pg8::blk_byte((int)drow, (t.k0 + 8 * c) >> 1, t.K >> 1) : (unsigned char*)t.WT + drow * t.K + t.k0 + 8 * c));
        } else {
        float ev[8] = {sp[0 * 64] * g0.x, sp[1 * 64] * g0.y, sp[2 * 64] * g0.z, sp[3 * 64] * g0.w, sp[4 * 64] * g1.x, sp[5 * 64] * g1.y, sp[6 * 64] * g1.z, sp[7 * 64] * g1.w};
        if (t.rot) wht32(ev, lane);
        v4u o; o.x = pk2(ev[0], ev[1]); o.y = pk2(ev[2], ev[3]); o.z = pk2(ev[4], ev[5]); o.w = pk2(ev[6], ev[7]);
        if (t.amax) {
            unsigned m = 0u;
#pragma unroll
            for (int q = 0; q < 4; ++q) { const unsigned w = o[q] & 0x7fff7fffu, lo = w & 0xffffu, hi = w >> 16; m = m > lo ? m : lo; m = m > hi ? m : hi; }
            { unsigned v = (unsigned)__shfl_xor((int)m, 1); m = m > v ? m : v; v = (unsigned)__shfl_xor((int)m, 2); m = m > v ? m : v; v = (unsigned)__shfl_xor((int)m, 4); m = m > v ? m : v; }
            if (c == 0) (void)__hip_atomic_fetch_max(t.amax + drow, m << 16, __ATOMIC_RELAXED, __HIP_MEMORY_SCOPE_AGENT);
        }
        __builtin_nontemporal_store(o, (GAS v4u*)(t.blk ? (bf16*)((char*)t.WT + pg8::blk_byte((int)drow, t.k0 + 8 * c, t.K)) : t.WT + drow * t.K + t.k0 + 8 * c)); } }
    LDS_WAIT(); asm volatile("" ::: "memory");
}
struct Args { const float* in[23]; float* out; unsigned char* ws; int ph_lo, ph_hi; };
constexpr int P0_ITEMS_A = 64 * 128;
constexpr int P0_ITEMS_P1 = P0_ITEMS_A + 64 * 64 + 2 * 64 * 172 + 172 * 64 + 64 * 16 + 64 * 64, P0_ITEMS_P4 = P0_ITEMS_P1 + 64 * 64 + 64 * 172, P0_ITEMS_P6 = P0_ITEMS_P4 + 64 * 172;
constexpr int P0_ITEMS_ALL = 64 * 128 + 64 * 64 + 2 * 64 * 172 + 172 * 64 + 64 * 16 + 64 * 64 + 64 * 64 + 2 * 64 * 172 + 172 * 64;
__device__ __forceinline__ void p0_prologue(const Args& a, unsigned char* ws, LAS unsigned char* lds, int gw, int NGW, int it_lo, int it_hi, int misc, int wave, int lane) {
    LAS float* scr = (LAS float*)(lds + wave * 16384);
    constexpr int IT_1 = 64 * 128, IT_SQ = 64 * 64, IT_G = 64 * 172, IT_D = 172 * 64, IT_KV = 64 * 16;
    constexpr int NITEMS = IT_1 + IT_SQ + 2 * IT_G + IT_D + IT_KV + IT_SQ + IT_SQ + 2 * IT_G + IT_D;
    auto describe = [&](int it) -> TItem {
        TItem t; int r = it; t.gain = nullptr; t.cmax = nullptr; t.K = 4096; t.N = 4096; t.map = 0; t.coff = 0; t.blk = 1; t.amax = nullptr; t.rot = 0;
        if (r < IT_1) { t.W = a.in[5]; t.gain = a.in[4]; t.WT = (bf16*)(ws + WS_W1T); t.N = 8192; }
        else if ((r -= IT_1) < IT_SQ) { t.W = a.in[10]; t.WT = (bf16*)(ws + WS_W2T); }
        else if ((r -= IT_SQ) < IT_G) { t.W = a.in[20]; t.gain = a.in[19]; t.WT = (bf16*)(ws + WS_WGU0); t.N = DFF; t.map = 1; t.cmax = (const float*)(ws + CM_OFF); }
        else if ((r -= IT_G) < IT_G) { t.W = a.in[21]; t.gain = a.in[19]; t.WT = (bf16*)(ws + WS_WGU0); t.N = DFF; t.map = 2; t.cmax = (const float*)(ws + CM_OFF); }
        else if ((r -= IT_G) < IT_D) { t.W = a.in[22]; t.WT = (bf16*)(ws + WS_WD0); t.K = DFF; t.rot = 1; t.amax = (unsigned*)(ws + CMD_OFF); }
        else if ((r -= IT_D) < IT_KV) { t.W = a.in[12]; t.gain = a.in[11]; t.WT = (bf16*)(ws + WS_WQKV); t.N = 1024; t.map = 3; }
        else if ((r -= IT_KV) < IT_SQ) { t.W = a.in[15]; t.gain = a.in[14]; t.WT = (bf16*)(ws + WS_WQKV + WQ8_SHIFT); t.map = 3; t.coff = 1024; t.cmax = (const float*)(ws + CMQ_OFF); }
        else if ((r -= IT_SQ) < IT_SQ) { t.W = a.in[18]; t.WT = (bf16*)(ws + WS_WOT); t.cmax = (const float*)(ws + CMO_OFF); }
        else if ((r -= IT_SQ) < IT_G) { t.W = a.in[20] + (size_t)D * DFF; t.gain = a.in[19] + D; t.WT = (bf16*)(ws + WS_WGU1); t.N = DFF; t.map = 1; t.cmax = (const float*)(ws + CM_OFF + CM_STRIDE); }
        else if ((r -= IT_G) < IT_G) { t.W = a.in[21] + (size_t)D * DFF; t.gain = a.in[19] + D; t.WT = (bf16*)(ws + WS_WGU1); t.N = DFF; t.map = 2; t.cmax = (const float*)(ws + CM_OFF + CM_STRIDE); }
        else { r -= IT_G; t.W = a.in[22] + (size_t)D * DFF; t.WT = (bf16*)(ws + WS_WD1); t.K = DFF; t.rot = 1; t.amax = (unsigned*)(ws + CMD_OFF + 16384); }
        const int nblk = t.N >> 6, kb = r / nblk; t.k0 = 64 * kb; t.n0 = 64 * (r - kb * nblk);
        return t;
    };
    static_assert(NITEMS == P0_ITEMS_ALL && IT_1 == P0_ITEMS_A, "item counts");
    if (it_lo + gw < it_hi) {
        const int first = it_lo + gw, last = first + ((it_hi - 1 - first) / NGW) * NGW, count = (last - first) / NGW + 1;
        TRegs ra, rb; const float* dummy = a.in[4];
        TItem ta = describe(first), tb = describe(first + NGW <= last ? first + NGW : last);
        titem_load(ta, ra, dummy, lane); titem_load(tb, rb, dummy, lane);
        for (int j = 0; j < count; j += 2) {
            const int i2 = first + (j + 2) * NGW, i3 = first + (j + 3) * NGW;
            const TItem tc = describe(i2 <= last ? i2 : last), td = describe(i3 <= last ? i3 : last);
            { titem_lds_write(ra, scr, lane); const f32x4 g0 = ra.g0, g1 = ra.g1; float cm[8]; _Pragma("unroll") for (int q = 0; q < 8; ++q) cm[q] = ra.cm[q]; titem_load(tc, ra, dummy, lane); titem_emit(ta, g0, g1, cm, scr, lane); }
            { titem_lds_write(rb, scr, lane); const f32x4 g0 = rb.g0, g1 = rb.g1; float cm[8]; _Pragma("unroll") for (int q = 0; q < 8; ++q) cm[q] = rb.cm[q]; titem_load(td, rb, dummy, lane); titem_emit(tb, g0, g1, cm, scr, lane); }
            ta = tc; tb = td;
        }
        asm volatile("s_waitcnt vmcnt(0)" ::: "memory");
    }
    if (!misc) return;
    bf16* XB = (bf16*)(ws + WS_XB); u64* ssq_x = (u64*)(ws + ST_OFF);
    for (int m = gw; m < M; m += NGW) {
        const float* xrow = m < MP ? a.in[0] + (size_t)m * D : a.in[1] + (size_t)(m - MP) * D;
        const GAS f32x4* xr = (const GAS f32x4*)xrow + lane; GAS v2u* o8 = (GAS v2u*)(XB + (size_t)m * D) + lane; float ss = 0.f;
#pragma unroll 4
        for (int j = 0; j < 16; ++j) { const f32x4 v = xr[64 * j]; ss += (v.x * v.x + v.y * v.y) + (v.z * v.z + v.w * v.w); v2u o; o.x = pk2(v.x, v.y); o.y = pk2(v.z, v.w); o8[64 * j] = o; }
        ss = wave_sum(ss);
        if (lane == 0) ssq_x[m] = (u64)(ss * pg8::FIX_SCALE);
    }
    const int gt = gw * 64 + lane, NT = NGW * 64;
    bf16* KB = (bf16*)(ws + WS_KB); bf16* VB = (bf16*)(ws + WS_VB); bf16* WSB = (bf16*)(ws + WS_WSB);
    for (int i = gt; i < 65536; i += NT) {
        const int e = i * 8, b = e >> 16, t = (e >> 9) & 127, c = e & 511; const size_t dst = (size_t)(8192 + 160 * b + t) * 512 + c;
        { const f32x4 v0 = *(const f32x4*)(a.in[2] + e), v1 = *(const f32x4*)(a.in[2] + e + 4); v4u o; o.x = pk2(v0.x, v0.y); o.y = pk2(v0.z, v0.w); o.z = pk2(v1.x, v1.y); o.w = pk2(v1.z, v1.w); *(v4u*)(KB + dst) = o; }
        { const f32x4 v0 = *(const f32x4*)(a.in[3] + e), v1 = *(const f32x4*)(a.in[3] + e + 4); v4u o; o.x = pk2(v0.x, v0.y); o.y = pk2(v0.z, v0.w); o.z = pk2(v1.x, v1.y); o.w = pk2(v1.z, v1.w); *(v4u*)(VB + dst) = o; }
    }
    for (int i = gt; i < 16384; i += NT) {
        const int e = i * 8, ii = (e >> 7) & 127, j = e & 127; const bool keep = (ii >> 6) >= (j >> 6);
        const f32x4 v0 = *(const f32x4*)(a.in[8] + e), v1 = *(const f32x4*)(a.in[8] + e + 4); v4u o = {0u, 0u, 0u, 0u};
        if (keep) { o.x = pk2(v0.x, v0.y); o.y = pk2(v0.z, v0.w); o.z = pk2(v1.x, v1.y); o.w = pk2(v1.z, v1.w); }
        *(v4u*)(WSB + e) = o;
    }
}


__device__ __forceinline__ void absmax_pass(const Args& a, unsigned char* ws, int gw, int NGW, int lane) {
    constexpr int PER = 16 * 172, PERQ = 16 * 64, NIT = 4 * PER + 2 * PERQ;
    const int r = lane >> 4;
    for (int it = gw; it < NIT; it += NGW) {
        const bool iso = it >= 4 * PER + PERQ, isq = !iso && it >= 4 * PER, sq = iso || isq;
        const int mat = sq ? 0 : it / PER, rem = iso ? it - 4 * PER - PERQ : (isq ? it - 4 * PER : it - mat * PER), nblk = sq ? 64 : 172, kg = rem / nblk, nb = rem - kg * nblk, l = mat >> 1, up = mat & 1;
        const float* W = iso ? a.in[18] : (isq ? a.in[15] : (up ? a.in[21] : a.in[20]) + (size_t)l * D * DFF);
        const float* gain = iso ? a.in[14] : (isq ? a.in[14] : a.in[19] + l * D); const float gmul = iso ? 0.f : 1.f, gadd = iso ? 1.f : 0.f;
        unsigned* cmax = iso ? (unsigned*)(ws + CMO_OFF) : (isq ? (unsigned*)(ws + CMQ_OFF) : (unsigned*)(ws + CM_OFF + (size_t)l * CM_STRIDE));
        const int NW = sq ? D : DFF, amap = iso ? 0 : (isq ? 3 : 1 + up), acoff = isq ? 1024 : 0;
        const int k0 = 256 * kg, n0 = 64 * nb;
        const float* p = W + (size_t)(k0 + r) * NW + n0 + 4 * (lane & 15);
        f32x4 va[16], vb[16]; float ga[16], gb[16];
#define AM_LOAD(v_, g_, sb_) do { _Pragma("unroll") for (int i = 0; i < 16; ++i) { v_[i] = __builtin_nontemporal_load((const f32x4*)(p + (size_t)(64 * (sb_) + 4 * i) * NW)); g_[i] = gain[k0 + 64 * (sb_) + 4 * i + r] * gmul + gadd; } } while (0)
#define AM_MAX(v_, g_) do { _Pragma("unroll") for (int i = 0; i < 16; ++i) { m0 = fmaxf(m0, fabsf(v_[i].x * g_[i])); m1 = fmaxf(m1, fabsf(v_[i].y * g_[i])); m2 = fmaxf(m2, fabsf(v_[i].z * g_[i])); m3 = fmaxf(m3, fabsf(v_[i].w * g_[i])); } } while (0)
        float m0 = 0.f, m1 = 0.f, m2 = 0.f, m3 = 0.f;
        AM_LOAD(va, ga, 0); AM_LOAD(vb, gb, 1);
        AM_MAX(va, ga); AM_LOAD(va, ga, 2);
        AM_MAX(vb, gb); AM_LOAD(vb, gb, 3);
        AM_MAX(va, ga); AM_MAX(vb, gb);
#undef AM_LOAD
#undef AM_MAX
        m0 = fmaxf(m0, __shfl_xor(m0, 16)); m0 = fmaxf(m0, __shfl_xor(m0, 32)); m1 = fmaxf(m1, __shfl_xor(m1, 16)); m1 = fmaxf(m1, __shfl_xor(m1, 32));
        m2 = fmaxf(m2, __shfl_xor(m2, 16)); m2 = fmaxf(m2, __shfl_xor(m2, 32)); m3 = fmaxf(m3, __shfl_xor(m3, 16)); m3 = fmaxf(m3, __shfl_xor(m3, 32));
        if (lane < 16) {
            unsigned* cp = cmax + maprow(amap, n0 + 4 * lane + acoff);
            (void)__hip_atomic_fetch_max(cp + 0, __builtin_bit_cast(unsigned, m0), __ATOMIC_RELAXED, __HIP_MEMORY_SCOPE_AGENT);
            (void)__hip_atomic_fetch_max(cp + 1, __builtin_bit_cast(unsigned, m1), __ATOMIC_RELAXED, __HIP_MEMORY_SCOPE_AGENT);
            (void)__hip_atomic_fetch_max(cp + 2, __builtin_bit_cast(unsigned, m2), __ATOMIC_RELAXED, __HIP_MEMORY_SCOPE_AGENT);
            (void)__hip_atomic_fetch_max(cp + 3, __builtin_bit_cast(unsigned, m3), __ATOMIC_RELAXED, __HIP_MEMORY_SCOPE_AGENT);
        }
    }
}
template <int R>
__device__ __forceinline__ void quant_rows_n(const bf16* XB, const u64* ssq, unsigned char* A8, float* rowscale, int m0, int mstride, int lane) {
    v4u w[R][8]; unsigned mx[R];
#pragma unroll
    for (int r = 0; r < R; ++r) { const v4u* xr = (const v4u*)(XB + (size_t)(m0 + r * mstride) * D) + lane;
#pragma unroll
        for (int j = 0; j < 8; ++j) w[r][j] = xr[64 * j]; }
#pragma unroll
    for (int r = 0; r < R; ++r) { unsigned m = 0u;
#pragma unroll
        for (int j = 0; j < 8; ++j)
#pragma unroll
            for (int q = 0; q < 4; ++q) { const unsigned t = w[r][j][q] & 0x7fff7fffu; const unsigned lo = t & 0xffffu, hi = t >> 16; m = m > lo ? m : lo; m = m > hi ? m : hi; }
        mx[r] = m; }
#pragma unroll
    for (int o = 1; o < 64; o <<= 1)
#pragma unroll
        for (int r = 0; r < R; ++r) { const unsigned t = (unsigned)__shfl_xor((int)mx[r], o); mx[r] = mx[r] > t ? mx[r] : t; }
#pragma unroll
    for (int r = 0; r < R; ++r) { const int m = m0 + r * mstride;
        const float fmx = __builtin_bit_cast(float, mx[r] << 16), inv = fmx > 0.f ? 127.0f / fmx : 0.f;
        v2u* orow = (v2u*)(A8 + (size_t)m * D) + lane;
#pragma unroll
        for (int j = 0; j < 8; ++j) { unsigned b[8];
#pragma unroll
            for (int q = 0; q < 4; ++q) { b[2 * q] = (unsigned)__float2int_rn(bflo(w[r][j][q]) * inv) & 255u; b[2 * q + 1] = (unsigned)__float2int_rn(bfhi(w[r][j][q]) * inv) & 255u; }
            v2u o; o.x = b[0] | (b[1] << 8) | (b[2] << 16) | (b[3] << 24); o.y = b[4] | (b[5] << 8) | (b[6] << 16) | (b[7] << 24); orow[64 * j] = o; }
        if (lane == 0) rowscale[m] = fmx * (1.0f / 127.0f) * (ssq ? rsqrtf((float)ssq[m] * (pg8::FIX_INV * (1.0f / 4096.0f)) + 1e-6f) : 1.0f); }
}
__device__ __forceinline__ void quant_rows(const bf16* XB, const u64* ssq, unsigned char* A8, float* rowscale, int gw, int NGW, int lane) {
    int m = gw;
    for (; m + 3 * NGW < M; m += 4 * NGW) quant_rows_n<4>(XB, ssq, A8, rowscale, m, NGW, lane);
    for (; m < M; m += NGW) quant_rows_n<1>(XB, ssq, A8, rowscale, m, NGW, lane);
}
__device__ __forceinline__ void actq_rows(const bf16* ACT, unsigned char* ACT8, float* rowscale, int gw, int NGW, int lane) {
    for (int mp = 2 * gw; mp < M; mp += 2 * NGW)
#pragma unroll 1
    for (int m = mp; m < mp + 2; ++m) {
        v4u w[22];
#pragma unroll
        for (int i = 0; i < 22; ++i) { const int c = 64 * i + lane; const v4u z = {0u, 0u, 0u, 0u};
            w[i] = c < DFF / 8 ? *(const v4u*)((const char*)ACT + pg8::blk_byte(m, 8 * (c < DFF / 8 ? c : 0), DFF)) : z; }
        float mx = 0.f;
#pragma unroll
        for (int i = 0; i < 22; ++i) { float v[8] = {bflo(w[i].x), bfhi(w[i].x), bflo(w[i].y), bfhi(w[i].y), bflo(w[i].z), bfhi(w[i].z), bflo(w[i].w), bfhi(w[i].w)};
            wht32(v, lane);
#pragma unroll
            for (int k = 0; k < 4; ++k) { w[i][k] = pk2(v[2 * k], v[2 * k + 1]); mx = fmaxf(mx, fmaxf(fabsf(bflo(w[i][k])), fabsf(bfhi(w[i][k])))); } }
#pragma unroll
        for (int o = 1; o < 64; o <<= 1) mx = fmaxf(mx, __shfl_xor(mx, o));
        const float inv = mx > 0.f ? 127.0f / mx : 0.f;
#pragma unroll
        for (int i = 0; i < 22; ++i) { unsigned q[8];
#pragma unroll
            for (int k = 0; k < 4; ++k) { q[2 * k] = (unsigned)__float2int_rn(bflo(w[i][k]) * inv) & 255u; q[2 * k + 1] = (unsigned)__float2int_rn(bfhi(w[i][k]) * inv) & 255u; }
            v2u o; o.x = q[0] | (q[1] << 8) | (q[2] << 16) | (q[3] << 24); o.y = q[4] | (q[5] << 8) | (q[6] << 16) | (q[7] << 24);
            const int c = 64 * i + lane;
            if (c < DFF / 8) *(v2u*)(ACT8 + pg8::blk_byte(m, 4 * c, DFF / 2)) = o; }
        if (lane == 0) rowscale[m] = mx * (1.0f / (127.0f * 32.0f));
    }
}
__device__ __forceinline__ void requant_w(const unsigned char* src, const float* cmax, unsigned char* dst, int K, int nrows, int gw, int NGW, int lane) {
    const int nkt = K >> 6, NU = (nrows >> 4) * nkt;
    int R0, C0; pg8::stage_rc(lane * 16, R0, C0);
    for (int u0 = 4 * gw; u0 < NU; u0 += 4 * NGW) {
        v4u a[4], b[4]; float inv[4]; int r0[4], kt[4];
#pragma unroll
        for (int i = 0; i < 4; ++i) { const int u = u0 + i < NU ? u0 + i : NU - 1; const unsigned char* p = src + (size_t)u * 2048 + lane * 16;
            a[i] = __builtin_nontemporal_load((const v4u*)p); b[i] = __builtin_nontemporal_load((const v4u*)(p + 1024));
            const int within = u & 15, t2 = u >> 4; kt[i] = t2 % nkt; r0[i] = (t2 / nkt) * 256 + (within >> 3) * 128 + (within & 7) * 16 + R0;
            const float cm = cmax[r0[i]]; inv[i] = cm > 0.f ? 127.0f / cm : 0.f; }
#pragma unroll
        for (int i = 0; i < 4; ++i) { if (u0 + i >= NU) break;
#pragma unroll
            for (int h = 0; h < 2; ++h) { const v4u w = h ? b[i] : a[i]; unsigned q[8];
#pragma unroll
                for (int e = 0; e < 4; ++e) { q[2 * e] = (unsigned)__float2int_rn(bflo(w[e]) * inv[i]) & 255u; q[2 * e + 1] = (unsigned)__float2int_rn(bfhi(w[e]) * inv[i]) & 255u; }
                v2u o; o.x = q[0] | (q[1] << 8) | (q[2] << 16) | (q[3] << 24); o.y = q[4] | (q[5] << 8) | (q[6] << 16) | (q[7] << 24);
                __builtin_nontemporal_store(o, (GAS v2u*)(dst + pg8::blk_byte(r0[i], (kt[i] * 64 + C0 + 32 * h) >> 1, K >> 1))); } }
    }
}
__device__ __forceinline__ void sgu_phase(LAS unsigned char* lds, const bf16* UV, const bf16* WSB, const u64* lnsum, const u64* lnssq, const float* ln_g, const float* ln_b,
                                          const float* b_s, bf16* Z, float* out_sguv, int wave, int lane) {
    const int fr = lane & 15, fq = lane >> 4;
    LAS unsigned char* img = lds + wave * 17408;
    for (int uidx = blockIdx.x; uidx < 576; uidx += gridDim.x) {
        const bool samp = uidx >= 512;
        const int g = uidx & 7, chunk = samp ? ((uidx - 512) >> 3) : (uidx >> 3);
        const int row_base = samp ? MP + 32 * chunk : 128 * chunk, nrows = samp ? 32 : 128;
        const int cw = 512 * g + 64 * wave;
        {
            const int cp = lane & 7, c = cw + 8 * cp;
            const f32x4 g0 = *(const f32x4*)(ln_g + c), g1 = *(const f32x4*)(ln_g + c + 4), b0 = *(const f32x4*)(ln_b + c), b1 = *(const f32x4*)(ln_b + c + 4);
#pragma unroll 4
            for (int it = 0; it < nrows / 8; ++it) {
                const int j = it * 8 + (lane >> 3), row = row_base + j;
                const v4u raw = *(const v4u*)(UV + (size_t)row * NSGU + D + c);
                const float mean = (float)(long long)lnsum[row] * (FIX_INV / 4096.0f), ex2 = (float)lnssq[row] * (FIX_INV / 4096.0f);
                const float rstd = rsqrtf(fmaxf(ex2 - mean * mean, 0.f) + 1e-5f);
                f32x4 x0 = {bflo(raw.x), bfhi(raw.x), bflo(raw.y), bfhi(raw.y)}, x1 = {bflo(raw.z), bfhi(raw.z), bflo(raw.w), bfhi(raw.w)};
                x0 = (x0 - mean) * rstd * g0 + b0; x1 = (x1 - mean) * rstd * g1 + b1;
                if (samp) { float* op = out_sguv + (size_t)(row - MP) * D + c; *(f32x4*)op = x0; *(f32x4*)(op + 4) = x1; }
                LAS unsigned short* wp = (LAS unsigned short*)(img + (8 * cp) * 272 + j * 2);
#pragma unroll
                for (int i = 0; i < 4; ++i) { wp[i * 136] = (unsigned short)f2bf(x0[i]); wp[(4 + i) * 136] = (unsigned short)f2bf(x1[i]); }
            }
        }
        LDS_WAIT(); asm volatile("" ::: "memory");
        const int nmt = nrows >> 4, kmax = nrows >> 5;
        bf16x8 bfr[4][4];
#pragma unroll
        for (int nt = 0; nt < 4; ++nt)
#pragma unroll
            for (int ks = 0; ks < 4; ++ks) bfr[nt][ks] = (ks < kmax) ? *(const LAS bf16x8*)(img + (16 * nt + fr) * 272 + (32 * ks + 8 * fq) * 2) : (bf16x8){0, 0, 0, 0, 0, 0, 0, 0};
        const bf16* Wg = WSB + g * 16384;
#pragma unroll 2
        for (int mt = 0; mt < nmt; ++mt) {
            bf16x8 af[4];
#pragma unroll
            for (int ks = 0; ks < 4; ++ks) af[ks] = (ks < kmax) ? *(const bf16x8*)(Wg + (16 * mt + fr) * 128 + 32 * ks + 8 * fq) : (bf16x8){0, 0, 0, 0, 0, 0, 0, 0};
            f32x4 acc[4];
#pragma unroll
            for (int nt = 0; nt < 4; ++nt) acc[nt] = (f32x4){0.f, 0.f, 0.f, 0.f};
#pragma unroll
            for (int ks = 0; ks < 4; ++ks)
                if (ks < kmax) {
#pragma unroll
                    for (int nt = 0; nt < 4; ++nt) acc[nt] = __builtin_amdgcn_mfma_f32_16x16x32_bf16(bfr[nt][ks], af[ks], acc[nt], 0, 0, 0);
                }
            const int i = 16 * mt + fr; const float bias = b_s[g * 128 + i]; const size_t ro = (size_t)(row_base + i);
#pragma unroll
            for (int nt = 0; nt < 4; ++nt) {
                const int c = cw + 16 * nt + 4 * fq; const v2u uu = *(const v2u*)(UV + ro * NSGU + c);
                f32x4 z = {bflo(uu.x), bfhi(uu.x), bflo(uu.y), bfhi(uu.y)};
                { const pg8::f32x2 ga = pg8::gelu_pk((pg8::f32x2){z[0], z[1]}), gb = pg8::gelu_pk((pg8::f32x2){z[2], z[3]}); z = (f32x4){ga.x, ga.y, gb.x, gb.y}; }
                z = z * (acc[nt] + bias);
                v2u o; o.x = pk2(z[0], z[1]); o.y = pk2(z[2], z[3]); *(v2u*)(Z + ro * D + c) = o;
            }
        }
        LDS_WAIT(); asm volatile("" ::: "memory");
    }
}

__device__ __forceinline__ void attn_phase(LAS unsigned char* lds, const bf16* Q, const bf16* KB, const bf16* VB, const float* sinks, bf16* O, int tid, int wave, int lane) {
    const int fr = lane & 15, fq = lane >> 4;
    LAS unsigned char* Ks = lds; LAS unsigned char* Vt = lds + 27648;
    constexpr float LOG2E = 1.4426950408889634f;
    for (int uidx = blockIdx.x; uidx < 1088; uidx += gridDim.x) {
        int kvh, qbase, kbase, klo, khi, nmt;
        if (uidx < 1024) { kvh = uidx & 7; const int bc = uidx >> 3, c = bc & 63; qbase = bc * 64; kbase = qbase - 128; klo = c >= 2 ? 0 : (2 - c) * 64; khi = 192; nmt = 4; }
        else { const int s = uidx - 1024; kvh = s & 7; const int b = s >> 3; qbase = MP + 32 * b; kbase = MP + 160 * b; klo = 0; khi = 160; nmt = 2; }
        __syncthreads();
#pragma unroll
        for (int it = 0; it < 3; ++it) {
            const int p = tid + 512 * it, key = p >> 3, ch = p & 7;
            v4u kk = {0u, 0u, 0u, 0u}, vv = {0u, 0u, 0u, 0u};
            if (key >= klo && key < khi) { const size_t off = (size_t)(kbase + key) * 512 + kvh * 64 + ch * 8; kk = *(const v4u*)(KB + off); vv = *(const v4u*)(VB + off); }
            *(LAS v4u*)(Ks + key * 144 + ch * 16) = kk;
            LAS unsigned short* vp = (LAS unsigned short*)(Vt + (ch * 8) * 392 + key * 2);
            vp[0 * 196] = (unsigned short)(vv.x & 0xffffu); vp[1 * 196] = (unsigned short)(vv.x >> 16); vp[2 * 196] = (unsigned short)(vv.y & 0xffffu); vp[3 * 196] = (unsigned short)(vv.y >> 16);
            vp[4 * 196] = (unsigned short)(vv.z & 0xffffu); vp[5 * 196] = (unsigned short)(vv.z >> 16); vp[6 * 196] = (unsigned short)(vv.w & 0xffffu); vp[7 * 196] = (unsigned short)(vv.w >> 16);
        }
        __syncthreads();
        const int head = kvh * 8 + wave; const float sink = sinks[head];
        for (int mt = 0; mt < nmt; ++mt) {
            const int qrow = qbase + 16 * mt + fr;
            const bf16* qp = Q + (size_t)qrow * D + head * 64 + 8 * fq;
            const bf16x8 q0 = *(const bf16x8*)qp, q1 = *(const bf16x8*)(qp + 32);
            f32x4 s[12]; float mx = sink;
#pragma unroll
            for (int nt = 0; nt < 12; ++nt) {
                const LAS unsigned char* kp = Ks + (16 * nt + fr) * 144 + fq * 16;
                const bf16x8 k0 = *(const LAS bf16x8*)kp, k1 = *(const LAS bf16x8*)(kp + 64);
                f32x4 a = {0.f, 0.f, 0.f, 0.f};
                a = __builtin_amdgcn_mfma_f32_16x16x32_bf16(k0, q0, a, 0, 0, 0);
                a = __builtin_amdgcn_mfma_f32_16x16x32_bf16(k1, q1, a, 0, 0, 0);
                if (16 * nt < klo || 16 * nt >= khi) a = (f32x4){-1e30f, -1e30f, -1e30f, -1e30f};
                s[nt] = a; mx = fmaxf(mx, fmaxf(fmaxf(a[0], a[1]), fmaxf(a[2], a[3])));
            }
            mx = fmaxf(mx, __shfl_xor(mx, 16)); mx = fmaxf(mx, __shfl_xor(mx, 32));
            float l = 0.f;
#pragma unroll
            for (int nt = 0; nt < 12; ++nt) {
#pragma unroll
                for (int i = 0; i < 4; ++i) { const float e = __builtin_amdgcn_exp2f((s[nt][i] - mx) * LOG2E); s[nt][i] = e; l += e; }
            }
            l += __shfl_xor(l, 16); l += __shfl_xor(l, 32); l += __builtin_amdgcn_exp2f((sink - mx) * LOG2E);
            f32x4 o[4];
#pragma unroll
            for (int dt = 0; dt < 4; ++dt) o[dt] = (f32x4){0.f, 0.f, 0.f, 0.f};
#pragma unroll
            for (int s6 = 0; s6 < 6; ++s6) {
                const pg8::u32x4 pw = pg8::pack8(s[2 * s6], s[2 * s6 + 1]); const bf16x8 pf = __builtin_bit_cast(bf16x8, pw);
#pragma unroll
                for (int dt = 0; dt < 4; ++dt) {
                    const LAS unsigned char* vp = Vt + (16 * dt + fr) * 392 + (32 * s6 + 4 * fq) * 2;
                    const v2u lo = *(const LAS v2u*)vp, hi = *(const LAS v2u*)(vp + 32);
                    const v4u vw = {lo.x, lo.y, hi.x, hi.y};
                    o[dt] = __builtin_amdgcn_mfma_f32_16x16x32_bf16(__builtin_bit_cast(bf16x8, vw), pf, o[dt], 0, 0, 0);
                }
            }
            const float inv = 1.0f / l; bf16* op = O + (size_t)qrow * D + head * 64 + 4 * fq;
#pragma unroll
            for (int dt = 0; dt < 4; ++dt) { v2u w; w.x = pg8::cvt_pk_bf16(o[dt][0] * inv, o[dt][1] * inv); w.y = pg8::cvt_pk_bf16(o[dt][2] * inv, o[dt][3] * inv); *(v2u*)(op + 16 * dt) = w; }
        }
    }
}

template <class Epi>
__device__ __forceinline__ void tail_phase(LAS unsigned char* lds, const bf16* A, const bf16* Bt, int K, int nN, int pn_off, unsigned* qhead, const Epi& E, int tid, int wave, int lane, int ablk = 0, int bblk = 1) {
    constexpr int PITCH = 528, OPB = 64 * PITCH, BUFB = 2 * OPB;
    const int fr = lane & 15, fq = lane >> 4;
    const int nc = (K + 255) >> 8;
    LAS float* part = (LAS float*)(lds + wave * 17408);
    const int row_l = tid >> 3, cg = tid & 7;
    const int colA = Epi::TAIL_SPLIT ? 4 * cg : 8 * cg, colB = Epi::TAIL_SPLIT ? 32 + 4 * cg : 8 * cg + 4;
    const int lr = tid >> 5, lc = tid & 31;
    volatile LAS unsigned* tick = (volatile LAS unsigned*)(lds + MISC_OFF + 64);
    const int cnt = nN * 2;
    int xq = (int)(xb_xcc_id() & 7u), tries = 0;
    unsigned nextj = 0u;
    if (tid == 0) nextj = __hip_atomic_fetch_add(qhead + 16 * xq, 1u, __ATOMIC_RELAXED, __HIP_MEMORY_SCOPE_AGENT);
    for (;;) {
        if (tid == 0) tick[0] = nextj;
        __syncthreads();
        const int j = (int)tick[0];
        __syncthreads();
        if (j >= cnt) { if (++tries == 8) break; xq = (xq + 1) & 7; if (tid == 0) nextj = __hip_atomic_fetch_add(qhead + 16 * xq, 1u, __ATOMIC_RELAXED, __HIP_MEMORY_SCOPE_AGENT); continue; }
        tries = 0;
        if (tid == 0) nextj = __hip_atomic_fetch_add(qhead + 16 * xq, 1u, __ATOMIC_RELAXED, __HIP_MEMORY_SCOPE_AGENT);
        const int p = ((8 * (j >> 2) + xq) << 2) + (j & 3) + 16 * pn_off;
        const int rq = p & 3, q = (p >> 2) & 3, pn = p >> 4;
        typedef typename Epi::AccT AccT; AccT acc[4][4];
#pragma unroll
        for (int nb = 0; nb < 4; ++nb)
#pragma unroll
            for (int mb = 0; mb < 4; ++mb) acc[nb][mb] = (AccT){0, 0, 0, 0};
        const size_t a16 = ablk ? 1024 : (size_t)16 * K, achs = ablk ? 65536 : 256, b16 = bblk ? 1024 : (size_t)16 * K, b128 = bblk ? 8192 : (size_t)128 * K, bchs = bblk ? 65536 : 256;
        const bf16* ag = ablk ? (const bf16*)((const char*)A + pg8::blk_byte(MP + 64 * rq + lr, 8 * lc, K)) : A + (size_t)(MP + 64 * rq + lr) * K + 8 * lc;
        const bf16* bg = bblk ? (const bf16*)((const char*)Bt + pg8::blk_byte(256 * pn + 32 * q + (lr & 31), 8 * lc, K)) : Bt + (size_t)(256 * pn + 32 * q + (lr & 31)) * K + 8 * lc;
        v4u a0[4], b0[4], a1[4], b1[4];
#define TL_LOAD(ra, rb, c) do { const int cc_ = (c) < nc ? (c) : nc - 1; _Pragma("unroll") for (int i = 0; i < 4; ++i) { \
            const bool in_ = 256 * cc_ + 8 * lc < K; const v4u z_ = {0u, 0u, 0u, 0u}; const size_t ao_ = in_ ? achs * cc_ : 0, bo_ = in_ ? bchs * cc_ : 0; \
            ra[i] = *(const v4u*)(ag + a16 * i + ao_); rb[i] = *(const v4u*)(bg + b16 * (i & 1) + b128 * (i >> 1) + bo_); if (!in_) { ra[i] = z_; rb[i] = z_; } } } while (0)
#define TL_WRITE(ra, rb, b) do { LAS unsigned char* d_ = lds + (b) * BUFB + lr * PITCH + lc * 16; _Pragma("unroll") for (int i = 0; i < 4; ++i) { \
            *(LAS v4u*)(d_ + 16 * i * PITCH) = ra[i]; *(LAS v4u*)(d_ + OPB + 16 * i * PITCH) = rb[i]; } } while (0)
#define TL_BAR() do { asm volatile("s_waitcnt lgkmcnt(0)" ::: "memory"); __builtin_amdgcn_s_barrier(); asm volatile("" ::: "memory"); } while (0)
#define TL_STEP(c, la, lb, wa, wb) do { TL_LOAD(la, lb, (c) + 2); TL_BAR(); \
            const LAS unsigned char* fb = lds + ((c) & 1) * BUFB + fr * PITCH + (32 * wave + 8 * fq) * 2; bf16x8 fa[4], fbv[4]; \
            _Pragma("unroll") for (int i = 0; i < 4; ++i) { fa[i] = *(const LAS bf16x8*)(fb + 16 * i * PITCH); fbv[i] = *(const LAS bf16x8*)(fb + OPB + 16 * i * PITCH); } \
            _Pragma("unroll") for (int nb = 0; nb < 4; ++nb) _Pragma("unroll") for (int mb = 0; mb < 4; ++mb) acc[nb][mb] = pg8::mma16(fbv[nb], fa[mb], acc[nb][mb]); \
            TL_WRITE(wa, wb, ((c) + 1) & 1); } while (0)
        TL_LOAD(a0, b0, 0); TL_LOAD(a1, b1, 1); TL_WRITE(a0, b0, 0);
        int c = 0;
        for (; c + 1 < nc; c += 2) { TL_STEP(c, a0, b0, a1, b1); TL_STEP(c + 1, a1, b1, a0, b0); }
        if (c < nc) TL_STEP(c, a0, b0, a1, b1);
#undef TL_STEP
#undef TL_BAR
#undef TL_LOAD
#undef TL_WRITE
        asm volatile("s_waitcnt vmcnt(0)" ::: "memory"); __syncthreads();
#pragma unroll
        for (int nb = 0; nb < 4; ++nb)
#pragma unroll
            for (int mb = 0; mb < 4; ++mb) *(LAS pg8::f32x4*)(part + (16 * mb + fr) * 68 + 16 * nb + 4 * fq) = __builtin_convertvector(acc[nb][mb], pg8::f32x4);
        __syncthreads();
        pg8::f32x4 v0 = {0.f, 0.f, 0.f, 0.f}, v1 = {0.f, 0.f, 0.f, 0.f};
#pragma unroll
        for (int w = 0; w < 8; ++w) { const LAS float* t = (const LAS float*)(lds + w * 17408) + row_l * 68; v0 += *(const LAS pg8::f32x4*)(t + colA); v1 += *(const LAS pg8::f32x4*)(t + colB); }
        E.tail(MP + 64 * rq + row_l, cg, pn, q, v0, v1);
        __syncthreads();
    }
}

#ifndef CONV_SPREAD
#define CONV_SPREAD 0
#endif
#ifndef PROBE_PH
#define PROBE_PH (-1)
#endif
#ifndef PROBE_MUL
#define PROBE_MUL 3
#endif
#ifndef NCONV
#define NCONV 80
#endif
#ifndef NCONV4
#define NCONV4 16
#endif
#ifndef NCONV6
#define NCONV6 24
#endif
#ifndef SAMPLE_MAIN_GU
#define SAMPLE_MAIN_GU 64
#endif
__device__ __forceinline__ void pr_begin(int k, long long& t0) { if (PROBE_PH >= 0 && k == PROBE_PH) { __syncthreads(); t0 = (long long)wall_clock64(); } }
__device__ __forceinline__ void pr_end(int k, long long t0) {
    if (PROBE_PH >= 0 && k == PROBE_PH) { __syncthreads(); const long long t1 = (long long)wall_clock64(), te = t1 + (long long)PROBE_MUL * (t1 - t0);
        while ((long long)wall_clock64() < te) __builtin_amdgcn_s_sleep(16);
        __syncthreads(); }
}
__global__ void __launch_bounds__(NWAVES * 64, 2) yoco_fwd(Args args) {
    extern __shared__ __attribute__((aligned(16))) unsigned char lds_raw[];
    LAS unsigned char* lds = (LAS unsigned char*)lds_raw;
    const int tid = threadIdx.x, lane = tid & 63, wave = __builtin_amdgcn_readfirstlane(tid >> 6);
    const int G = gridDim.x, bx = blockIdx.x, vcu = (G % 8 == 0) ? (bx % 8) * (G / 8) + bx / 8 : bx;
    unsigned char* ws = args.ws;
    for (int u = tid; u < (LDS_BYTES - LDSCTL_OFF) / 4; u += NWAVES * 64) ((LAS unsigned*)(lds + LDSCTL_OFF))[u] = 0u;
    __syncthreads();
    volatile LAS unsigned* MISC = (volatile LAS unsigned*)(lds + MISC_OFF);
    XcdBarrier bar; bar.bar = (unsigned*)ws + CW_BAR; bar.x = 0; bar.st = nullptr;
    if (MK_ONE_LAUNCH) bar = xcd_barrier_post((unsigned*)ws + CW_BAR, MISC + 8);
    const int lo = args.ph_lo, hi = args.ph_hi;
    long long pr_t0 = 0;
#define IN(k) (pr_begin((k), pr_t0), lo <= (k) && (k) < hi)
#define SEAM(k) do { pr_end((k), pr_t0); if (MK_ONE_LAUNCH && IN((k) + 1)) xcd_barrier(bar); } while (0)
    bf16* const W1T = (bf16*)(ws + WS_W1T); bf16* const W2T = (bf16*)(ws + WS_W2T); bf16* const WGU0 = (bf16*)(ws + WS_WGU0); bf16* const WD0 = (bf16*)(ws + WS_WD0);
    bf16* const WQKV = (bf16*)(ws + WS_WQKV); bf16* const WOT = (bf16*)(ws + WS_WOT); bf16* const WGU1 = (bf16*)(ws + WS_WGU1); bf16* const WD1 = (bf16*)(ws + WS_WD1);
    bf16* const XB = (bf16*)(ws + WS_XB); bf16* const ACT = (bf16*)(ws + WS_ACT); bf16* const UV = (bf16*)(ws + WS_ACT);
    bf16* const ZQ = (bf16*)(ws + WS_ZQ); bf16* const OB = (bf16*)(ws + WS_O); bf16* const KB = (bf16*)(ws + WS_KB); bf16* const VB = (bf16*)(ws + WS_VB); bf16* const WSB = (bf16*)(ws + WS_WSB);
    unsigned char* const A8 = ws + WS_H; float* const rowscale = (float*)(ws + RS_OFF); const float* const cmax0 = (const float*)(ws + CM_OFF); const float* const cmax1 = (const float*)(ws + CM_OFF + CM_STRIDE);
    unsigned* const qheads = (unsigned*)ws + CW_Q;
    u64* const ssq_x = (u64*)(ws + ST_OFF); u64* const lnsum = (u64*)(ws + ST_OFF + ST_STRIDE); u64* const lnssq = (u64*)(ws + ST_OFF + 2 * ST_STRIDE);
    u64* const ssq_h1 = (u64*)(ws + ST_OFF + 3 * ST_STRIDE); u64* const ssq_h2 = (u64*)(ws + ST_OFF + 4 * ST_STRIDE); u64* const ssq_h3 = (u64*)(ws + ST_OFF + 5 * ST_STRIDE);

    const bool split = (G == 256) && (NCONV > 0);
    const int nconv = split ? NCONV : 0, ncomp = G - nconv, nconv4 = (split && CONV_SPREAD) ? NCONV4 : 0, nconv6 = (split && CONV_SPREAD) ? NCONV6 : 0;
    const int items_p1 = (split && CONV_SPREAD) ? P0_ITEMS_P1 : P0_ITEMS_ALL;
    if (IN(0)) { absmax_pass(args, ws, vcu * NWAVES + wave, G * NWAVES, lane); if (!split && MK_ONE_LAUNCH) xcd_barrier(bar);
                 p0_prologue(args, ws, lds, vcu * NWAVES + wave, G * NWAVES, 0, split ? P0_ITEMS_A : P0_ITEMS_ALL, 1, wave, lane); SEAM(0); }
    if (IN(1)) {
        if (bx >= ncomp) { p0_prologue(args, ws, lds, (bx - ncomp) * NWAVES + wave, nconv * NWAVES, P0_ITEMS_A, items_p1, 0, wave, lane); __syncthreads(); }
        pg8::Gemm g{XB, W1T, MP, NSGU, D, 0, 1}; pg8::SplitOrder S; S.init(MP, NSGU, G, bx); S.nblk = ncomp; S.nhalf = 16; S.nextra = 0;
        pg8::EpiSguIn E{UV, ssq_x, lnsum, lnssq};
        pg8::gemm_phase<pg8::EpiSguIn, pg8::SplitOrder, PG8_ALIGN, PG8_SP2>(lds, g, S, E);
        tail_phase(lds, XB, W1T, D, 32, 0, qheads + 0 * 128, E, tid, wave, lane);
        SEAM(1);
    }
    if (IN(2)) { sgu_phase(lds, UV, WSB, lnsum, lnssq, args.in[6], args.in[7], args.in[9], ZQ, args.out + pg8::OUT_SGUV, wave, lane); SEAM(2); }
    if (IN(3)) {
        pg8::Gemm g{ZQ, W2T, MP, D, D, 0, 1}; pg8::StaticOrder S; S.init(MP, D, G, bx);
        pg8::EpiRes<false, true, false> E{nullptr, nullptr, nullptr, XB, ssq_h1};
        pg8::gemm_phase<pg8::EpiRes<false, true, false>, pg8::StaticOrder, PG8_ALIGN, PG8_SP2>(lds, g, S, E);
        tail_phase(lds, ZQ, W2T, D, 16, 0, qheads + 1 * 128, E, tid, wave, lane);
        SEAM(3);
    }
    if (IN(4)) { quant_rows(XB, ssq_h1, A8, rowscale, vcu * NWAVES + wave, G * NWAVES, lane); SEAM(4); }
    if (IN(5)) {
        if (bx >= G - nconv4) { p0_prologue(args, ws, lds, (bx - (G - nconv4)) * NWAVES + wave, nconv4 * NWAVES, P0_ITEMS_P1, P0_ITEMS_P4, 0, wave, lane); __syncthreads(); }
        pg8::Gemm g{(const bf16*)A8, WGU0, M, NGU, D / 2, 0, 1}; pg8::SplitOrder S; S.init(MP, NGU, G, bx); S.nblk = G - nconv4; S.nhalf = 0; S.nextra = SAMPLE_MAIN_GU;
        pg8::EpiSwigluI8 E{ACT, rowscale, cmax0};
        pg8::gemm_phase<pg8::EpiSwigluI8, pg8::SplitOrder, PG8_ALIGN, PG8_SP2>(lds, g, S, E);
        tail_phase(lds, (const bf16*)A8, WGU0, D / 2, 86 - SAMPLE_MAIN_GU, SAMPLE_MAIN_GU, qheads + 2 * 128, E, tid, wave, lane);
        SEAM(5);
    }
    if (IN(6)) { actq_rows(ACT, ws + WS_ACT8, rowscale, vcu * NWAVES + wave, G * NWAVES, lane);
                 requant_w((const unsigned char*)WD0, (const float*)(ws + CMD_OFF), ws + WS_WD8_0, DFF, D, vcu * NWAVES + wave, G * NWAVES, lane); SEAM(6); }
    if (IN(7)) {
        pg8::Gemm g{(const bf16*)(ws + WS_ACT8), (const bf16*)(ws + WS_WD8_0), MP, D, DFF / 2, 1, 1}; pg8::StaticOrder S; S.init(MP, D, G, bx);
        pg8::EpiRes<false, true, false, true> E{nullptr, nullptr, nullptr, XB, ssq_h2, rowscale, (const float*)(ws + CMD_OFF)};
        pg8::gemm_phase<pg8::EpiRes<false, true, false, true>, pg8::StaticOrder, PG8_ALIGN, PG8_SP2>(lds, g, S, E);
        tail_phase(lds, (const bf16*)(ws + WS_ACT8), (const bf16*)(ws + WS_WD8_0), DFF / 2, 16, 0, qheads + 3 * 128, E, tid, wave, lane, 1, 1);
        SEAM(7);
    }
    if (IN(8)) { quant_rows(XB, ssq_h2, A8, rowscale, vcu * NWAVES + wave, G * NWAVES, lane); SEAM(8); }
    if (IN(9)) {
        { pg8::Gemm g{XB, WQKV, MP, 1024, D, 0, 1}; pg8::SplitOrder S; S.init(MP, 1024, G, bx); S.nblk = (G == 256) ? 128 : G; S.nhalf = 0; S.nextra = 0;
          pg8::EpiQKV E{KB, VB, ZQ, args.out, ssq_h2, args.in[13], args.in[16], nullptr, nullptr};
          pg8::gemm_phase<pg8::EpiQKV, pg8::SplitOrder, PG8_ALIGN, PG8_SP2>(lds, g, S, E); }
        { pg8::Gemm g{(const bf16*)A8, (const bf16*)(ws + WS_WQKV + WQ8_SHIFT), MP, 4096, D / 2, 0, 1}; pg8::QOrder S; S.init(MP, 4096, G, bx);
          pg8::EpiQKVT<true> E{KB, VB, ZQ, args.out, ssq_h2, args.in[13], args.in[16], rowscale, (const float*)(ws + CMQ_OFF)};
          pg8::gemm_phase<pg8::EpiQKVT<true>, pg8::QOrder, PG8_ALIGN, PG8_SP2>(lds, g, S, E);
          tail_phase(lds, (const bf16*)A8, (const bf16*)(ws + WS_WQKV + WQ8_SHIFT), D / 2, 16, 4, qheads + 8 * 128, E, tid, wave, lane); }
        { pg8::EpiQKV E{KB, VB, ZQ, args.out, ssq_h2, args.in[13], args.in[16], nullptr, nullptr};
          tail_phase(lds, XB, WQKV, D, 4, 0, qheads + 4 * 128, E, tid, wave, lane); }
        SEAM(9);
    }
    if (IN(10)) { attn_phase(lds, ZQ, KB, VB, args.in[17], OB, tid, wave, lane); SEAM(10); }
    if (IN(11)) { quant_rows(OB, nullptr, A8, rowscale, vcu * NWAVES + wave, G * NWAVES, lane); SEAM(11); }
    if (IN(12)) {
        pg8::Gemm g{(const bf16*)A8, WOT, MP, D, D / 2, 0, 1}; pg8::StaticOrder S; S.init(MP, D, G, bx);
        pg8::EpiRes<false, true, false, true> E{nullptr, nullptr, nullptr, XB, ssq_h3, rowscale, (const float*)(ws + CMO_OFF)};
        pg8::gemm_phase<pg8::EpiRes<false, true, false, true>, pg8::StaticOrder, PG8_ALIGN, PG8_SP2>(lds, g, S, E);
        tail_phase(lds, (const bf16*)A8, WOT, D / 2, 16, 0, qheads + 5 * 128, E, tid, wave, lane);
        SEAM(12);
    }
    if (IN(13)) { quant_rows(XB, ssq_h3, A8, rowscale, vcu * NWAVES + wave, G * NWAVES, lane); SEAM(13); }
    if (IN(14)) {
        if (bx >= G - nconv4) { p0_prologue(args, ws, lds, (bx - (G - nconv4)) * NWAVES + wave, nconv4 * NWAVES, P0_ITEMS_P6, P0_ITEMS_ALL, 0, wave, lane); __syncthreads(); }
        pg8::Gemm g{(const bf16*)A8, WGU1, M, NGU, D / 2, 0, 1}; pg8::SplitOrder S; S.init(MP, NGU, G, bx); S.nblk = G - nconv4; S.nhalf = 0; S.nextra = SAMPLE_MAIN_GU;
        pg8::EpiSwigluI8 E{ACT, rowscale, cmax1};
        pg8::gemm_phase<pg8::EpiSwigluI8, pg8::SplitOrder, PG8_ALIGN, PG8_SP2>(lds, g, S, E);
        tail_phase(lds, (const bf16*)A8, WGU1, D / 2, 86 - SAMPLE_MAIN_GU, SAMPLE_MAIN_GU, qheads + 6 * 128, E, tid, wave, lane);
        SEAM(14);
    }
    if (IN(15)) { actq_rows(ACT, ws + WS_ACT8, rowscale, vcu * NWAVES + wave, G * NWAVES, lane);
                  requant_w((const unsigned char*)WD1, (const float*)(ws + CMD_OFF + 16384), ws + WS_WD8_1, DFF, D, vcu * NWAVES + wave, G * NWAVES, lane); SEAM(15); }
    if (IN(16)) {
        pg8::Gemm g{(const bf16*)(ws + WS_ACT8), (const bf16*)(ws + WS_WD8_1), MP, D, DFF / 2, 1, 1}; pg8::StaticOrder S; S.init(MP, D, G, bx);
        pg8::EpiRes<false, false, true, true> E{nullptr, nullptr, args.out, XB, nullptr, rowscale, (const float*)(ws + CMD_OFF + 16384)};
        pg8::gemm_phase<pg8::EpiRes<false, false, true, true>, pg8::StaticOrder, PG8_ALIGN, PG8_SP2>(lds, g, S, E);
        tail_phase(lds, (const bf16*)(ws + WS_ACT8), (const bf16*)(ws + WS_WD8_1), DFF / 2, 16, 0, qheads + 7 * 128, E, tid, wave, lane, 1, 1);
        pr_end(16, pr_t0);
    }
#undef IN
#undef SEAM
}

extern "C" void kernel_launch(void* const* d_in, const int* in_sizes, int n_in, void* d_out, int out_size, void* d_ws, size_t ws_size, hipStream_t stream) {
    static int grid = 0;
    if (grid == 0) {
        if (n_in != 23 || in_sizes[0] != MP * D || out_size != 36175872 || ws_size < WS_END) {
            fprintf(stderr, "kernel_launch: unexpected shapes (n_in %d, in0 %d, out %d, ws %zu); nothing launched\n", n_in, n_in > 0 ? in_sizes[0] : -1, out_size, ws_size); grid = -1; return; }
        int dev = 0, cus = 0, per_cu = 0;
        if (hipGetDevice(&dev) != hipSuccess || hipDeviceGetAttribute(&cus, hipDeviceAttributeMultiprocessorCount, dev) != hipSuccess) { fprintf(stderr, "kernel_launch: device query failed\n"); grid = -1; return; }
        if (hipFuncSetAttribute((const void*)yoco_fwd, hipFuncAttributeMaxDynamicSharedMemorySize, LDS_BYTES) != hipSuccess) { fprintf(stderr, "kernel_launch: hipFuncSetAttribute failed\n"); grid = -1; return; }
        if (hipOccupancyMaxActiveBlocksPerMultiprocessor(&per_cu, (const void*)yoco_fwd, NWAVES * 64, LDS_BYTES) != hipSuccess || per_cu < 1)
            fprintf(stderr, "kernel_launch: note: occupancy query reports %d workgroups per CU\n", per_cu);
        (void)hipGetLastError();
        grid = cus;
    }
    if (grid < 0) return;
    if (hipMemsetAsync((char*)d_ws + WS_CTL, 0, CTL_ZERO_BYTES, stream) != hipSuccess) { fprintf(stderr, "kernel_launch: memset failed\n"); return; }
    Args a{};
    for (int i = 0; i < 23; ++i) a.in[i] = (const float*)d_in[i];
    a.out = (float*)d_out; a.ws = (unsigned char*)d_ws;
#if MK_ONE_LAUNCH
    a.ph_lo = 0; a.ph_hi = NPHASES;
    hipLaunchKernelGGL(yoco_fwd, dim3(grid), dim3(NWAVES * 64), LDS_BYTES, stream, a);
#else
    for (int p = 0; p < NPHASES; ++p) { a.ph_lo = p; a.ph_hi = p + 1; hipLaunchKernelGGL(yoco_fwd, dim3(grid), dim3(NWAVES * 64), LDS_BYTES, stream, a); }
#endif
    const hipError_t le = hipPeekAtLastError();
    if (le != hipSuccess) fprintf(stderr, "kernel_launch: launch failed: %s\n", hipGetErrorName(le));
}
```
